# Optimizing an MI355X kernel written in HIP

```python
import jax, jax.numpy as jnp
from jax import lax
import numpy as np

D_MODEL = 1024
BATCH = 16
SEQ = 2048
DEPTH = 2

HEAD_DIM = 64
Q_BLOCK = 128
NEG_INF = -1e30
MLA_HEADS = 8
MLA_Q_RANK = 512
MLA_KV_RANK = 256
MLA_NOPE = 64
MLA_ROPE = 32
MLA_V = 64
ROPE_THETA = 10000.0
DIL_PATTERNS = ((128, 1), (512, 4), (2048, 16))
DIL_GROUPS = 3
DIL_HPG = 4
DIL_HEADS = DIL_GROUPS * DIL_HPG
WIN_HEADS = 8
WIN_KV_HEADS = 2
WIN_RADIUS = 128
WIN_BLOCK = 128
MLA_COLS = MLA_Q_RANK + MLA_KV_RANK + MLA_ROPE
DIL_COLS = 3 * DIL_HEADS * HEAD_DIM
WIN_COLS = (WIN_HEADS + 2 * WIN_KV_HEADS) * HEAD_DIM
GATE_COLS = 3 * D_MODEL
IN_COLS = MLA_COLS + DIL_COLS + WIN_COLS + GATE_COLS
MLA_OUT = MLA_HEADS * MLA_V
DIL_OUT = DIL_HPG * HEAD_DIM
WIN_OUT = WIN_HEADS * HEAD_DIM
N_EXPERT_GROUPS = 4
EXPERTS_PER_GROUP = 8
N_EXPERTS = N_EXPERT_GROUPS * EXPERTS_PER_GROUP
TOP_K = 2
D_EXPERT = 384
MOE_BLOCK = 128

kernel_name = 'hybrid_mla_dilated_window_hmoe_encoder'


def rms_norm(x, g, eps=1e-6):
    xf = x.astype(jnp.float32)
    y = xf * lax.rsqrt(jnp.mean(xf * xf, axis=-1, keepdims=True) + eps)
    return (y * g.astype(jnp.float32)).astype(x.dtype)


def alibi_slopes(n):
    return 2.0 ** (-8.0 * jnp.arange(1, n + 1, dtype=jnp.float32) / n)


def apply_rope(x, pos):
    half = x.shape[-1] // 2
    inv_freq = ROPE_THETA ** (-jnp.arange(half, dtype=jnp.float32) / half)
    ang = pos.astype(jnp.float32)[..., None] * inv_freq
    ang = ang.reshape(ang.shape[:2] + (1,) * (x.ndim - 3) + (half,))
    cos, sin = jnp.cos(ang), jnp.sin(ang)
    xf = x.astype(jnp.float32)
    x1, x2 = xf[..., :half], xf[..., half:]
    return jnp.concatenate([x1 * cos - x2 * sin, x1 * sin + x2 * cos], axis=-1).astype(x.dtype)


def to_blocks(t, block):
    B, S = t.shape[:2]
    return jnp.moveaxis(t.reshape(B, S // block, block, *t.shape[2:]), 1, 0)


def from_blocks(o):
    o = jnp.moveaxis(o, 0, 1)
    return o.reshape(o.shape[0], o.shape[1] * o.shape[2], -1)


def mla_mixer(c_q, c_kv, k_rope, pos, g_cq, w_uq, g_ckv, w_ukv, g_q, g_k):
    B, S, _ = c_q.shape
    q = (rms_norm(c_q, g_cq) @ w_uq).reshape(B, S, MLA_HEADS, MLA_NOPE + MLA_ROPE)
    kv = (rms_norm(c_kv, g_ckv) @ w_ukv).reshape(B, S, MLA_HEADS, MLA_NOPE + MLA_V)
    q_nope = rms_norm(q[..., :MLA_NOPE], g_q[:MLA_NOPE])
    q_rope = apply_rope(rms_norm(q[..., MLA_NOPE:], g_q[MLA_NOPE:]), pos)
    k_nope = rms_norm(kv[..., :MLA_NOPE], g_k[:MLA_NOPE])
    v = kv[..., MLA_NOPE:]
    k_rope = apply_rope(rms_norm(k_rope, g_k[MLA_NOPE:]), pos)
    scale = (MLA_NOPE + MLA_ROPE) ** -0.5

    def attend(blk):
        qn, qr = blk
        s = (jnp.einsum('bqhd,bkhd->bhqk', qn, k_nope)
             + jnp.einsum('bqhd,bkd->bhqk', qr, k_rope)).astype(jnp.float32) * scale
        p = jax.nn.softmax(s, axis=-1)
        return jnp.einsum('bhqk,bkhd->bqhd', p.astype(v.dtype), v)

    o = lax.map(attend, (to_blocks(q_nope, Q_BLOCK), to_blocks(q_rope, Q_BLOCK)))
    return from_blocks(o)


def dilated_group(q, k, v, pos, window, dil, slope):
    B, S = q.shape[:2]
    n_side = (window // 2) // dil
    offsets = jnp.arange(-n_side, n_side + 1, dtype=jnp.int32) * dil
    starts = jnp.arange(S // Q_BLOCK, dtype=jnp.int32) * Q_BLOCK
    scale = HEAD_DIM ** -0.5

    def attend(args):
        qb, start = args
        q_idx = start + jnp.arange(Q_BLOCK, dtype=jnp.int32)
        k_idx = q_idx[:, None] + offsets[None, :]
        valid = (k_idx >= 0) & (k_idx < S)
        k_idx = jnp.clip(k_idx, 0, S - 1)
        kb = jnp.take(k, k_idx, axis=1)
        vb = jnp.take(v, k_idx, axis=1)
        pos_q = lax.dynamic_slice_in_dim(pos, start, Q_BLOCK, axis=1)
        pos_k = jnp.take(pos, k_idx, axis=1)
        dist = jnp.abs(pos_q[:, :, None] - pos_k).astype(jnp.float32)
        s = jnp.einsum('bqhd,bqjhd->bhqj', qb, kb).astype(jnp.float32) * scale
        s = s - slope[None, :, None, None] * dist[:, None]
        s = jnp.where(valid[None, None], s, NEG_INF)
        lse = jax.nn.logsumexp(s, axis=-1)
        p = jnp.exp(s - lse[..., None])
        o = jnp.einsum('bhqj,bqjhd->bqhd', p.astype(vb.dtype), vb)
        return o, lse

    return lax.map(attend, (to_blocks(q, Q_BLOCK), starts))


def dilated_mixer(qkv, pos, g_q, g_k):
    B, S, _ = qkv.shape
    qkv = qkv.reshape(B, S, 3, DIL_GROUPS, DIL_HPG, HEAD_DIM)
    q = rms_norm(qkv[:, :, 0], g_q)
    k = rms_norm(qkv[:, :, 1], g_k)
    v = qkv[:, :, 2]
    slopes = alibi_slopes(DIL_HEADS).reshape(DIL_GROUPS, DIL_HPG)
    outs, lses = [], []
    for gi, (window, dil) in enumerate(DIL_PATTERNS):
        o, lse = dilated_group(q[:, :, gi], k[:, :, gi], v[:, :, gi], pos, window, dil, slopes[gi])
        outs.append(o)
        lses.append(lse)
    outs = jnp.stack(outs)
    w = jax.nn.softmax(jnp.stack(lses), axis=0)
    o = jnp.einsum('gnbhq,gnbqhd->nbqhd', w.astype(outs.dtype), outs)
    return from_blocks(o)


def window_mixer(qkv, pos, g_q, g_k, sink):
    B, S, _ = qkv.shape
    rep = WIN_HEADS // WIN_KV_HEADS
    nq, nk = WIN_HEADS * HEAD_DIM, WIN_KV_HEADS * HEAD_DIM
    q = rms_norm(qkv[..., :nq].reshape(B, S, WIN_KV_HEADS, rep, HEAD_DIM), g_q)
    k = rms_norm(qkv[..., nq:nq + nk].reshape(B, S, WIN_KV_HEADS, HEAD_DIM), g_k)
    v = qkv[..., nq + nk:].reshape(B, S, WIN_KV_HEADS, HEAD_DIM)
    pad = ((0, 0), (WIN_BLOCK, WIN_BLOCK), (0, 0), (0, 0))
    kp, vp = jnp.pad(k, pad), jnp.pad(v, pad)
    pp = jnp.pad(pos, ((0, 0), (WIN_BLOCK, WIN_BLOCK)))
    slopes = alibi_slopes(WIN_HEADS).reshape(WIN_KV_HEADS, rep)
    sink_l = sink.astype(jnp.float32).reshape(1, WIN_KV_HEADS, rep, 1, 1)
    starts = jnp.arange(S // WIN_BLOCK, dtype=jnp.int32) * WIN_BLOCK
    scale = HEAD_DIM ** -0.5
    band = 3 * WIN_BLOCK

    def attend(args):
        qb, start = args
        kb = lax.dynamic_slice_in_dim(kp, start, band, axis=1)
        vb = lax.dynamic_slice_in_dim(vp, start, band, axis=1)
        pos_k = lax.dynamic_slice_in_dim(pp, start, band, axis=1)
        pos_q = lax.dynamic_slice_in_dim(pos, start, WIN_BLOCK, axis=1)
        q_idx = start + jnp.arange(WIN_BLOCK, dtype=jnp.int32)
        k_idx = start - WIN_BLOCK + jnp.arange(band, dtype=jnp.int32)
        valid = ((jnp.abs(q_idx[:, None] - k_idx[None, :]) <= WIN_RADIUS)
                 & (k_idx >= 0)[None, :] & (k_idx < S)[None, :])
        dist = jnp.abs(pos_q[:, :, None] - pos_k[:, None, :]).astype(jnp.float32)
        s = jnp.einsum('bqgrd,bkgd->bgrqk', qb, kb).astype(jnp.float32) * scale
        s = s - slopes[None, :, :, None, None] * dist[:, None, None]
        s = jnp.where(valid, s, NEG_INF)
        m = jnp.maximum(jnp.max(s, axis=-1, keepdims=True), sink_l)
        e = jnp.exp(s - m)
        p = e / (jnp.sum(e, axis=-1, keepdims=True) + jnp.exp(sink_l - m))
        return jnp.einsum('bgrqk,bkgd->bqgrd', p.astype(vb.dtype), vb)

    o = lax.map(attend, (to_blocks(q, WIN_BLOCK), starts))
    return from_blocks(o)


def hybrid_mixer(h, pos, w_in, g_cq, w_uq, g_ckv, w_ukv, g_q_mla, g_k_mla, g_q_dil, g_k_dil,
                 g_q_win, g_k_win, sink_win, w_br_mla, w_br_dil, w_br_win, w_out):
    cols = h @ w_in
    sizes = [MLA_Q_RANK, MLA_KV_RANK, MLA_ROPE, DIL_COLS, WIN_COLS]
    bounds, acc = [], 0
    for sz in sizes:
        acc += sz
        bounds.append(acc)
    c_q, c_kv, k_rope, dil_qkv, win_qkv, gate_cols = jnp.split(cols, bounds, axis=-1)
    g_mla, g_dil, g_win = jnp.split(jax.nn.sigmoid(gate_cols), 3, axis=-1)
    y_mla = mla_mixer(c_q, c_kv, k_rope, pos, g_cq, w_uq, g_ckv, w_ukv, g_q_mla, g_k_mla) @ w_br_mla
    y_dil = dilated_mixer(dil_qkv, pos, g_q_dil, g_k_dil) @ w_br_dil
    y_win = window_mixer(win_qkv, pos, g_q_win, g_k_win, sink_win) @ w_br_win
    return (g_mla * y_mla + g_dil * y_dil + g_win * y_win) @ w_out


def hier_moe(h, w_gr, b_gr, w_er, b_er, w1, w3, w2):
    B, S, D = h.shape
    t = h.reshape(-1, D)
    T = t.shape[0]
    g_prob = jax.nn.softmax((t @ w_gr).astype(jnp.float32) + b_gr.astype(jnp.float32), axis=-1)
    g_w, g_idx = lax.top_k(g_prob, 1)
    e_logits = ((t @ w_er).astype(jnp.float32) + b_er.astype(jnp.float32)).reshape(
        T, N_EXPERT_GROUPS, EXPERTS_PER_GROUP)
    e_logits = jnp.take_along_axis(e_logits, g_idx[:, :, None], axis=1)[:, 0]
    e_w, e_idx = lax.top_k(jax.nn.softmax(e_logits, axis=-1), TOP_K)
    gate = g_w * e_w / jnp.sum(e_w, axis=-1, keepdims=True)
    expert = g_idx * EXPERTS_PER_GROUP + e_idx
    flat_e, flat_gate = expert.reshape(-1), gate.reshape(-1)
    n_assign = flat_e.shape[0]
    order = jnp.argsort(flat_e)
    sorted_e = flat_e[order]
    token = order // TOP_K
    counts = jnp.bincount(flat_e, length=N_EXPERTS)
    padded = (counts + MOE_BLOCK - 1) // MOE_BLOCK * MOE_BLOCK
    start_sorted = jnp.cumsum(counts) - counts
    start_padded = jnp.cumsum(padded) - padded
    dest = start_padded[sorted_e] + jnp.arange(n_assign) - start_sorted[sorted_e]
    n_blocks = -(-n_assign // MOE_BLOCK) + N_EXPERTS
    rows = jnp.zeros((n_blocks * MOE_BLOCK, D), t.dtype).at[dest].set(t[token])
    block_start = jnp.arange(n_blocks) * MOE_BLOCK
    block_expert = jnp.minimum(
        jnp.sum(block_start[:, None] >= (start_padded + padded)[None, :], axis=1), N_EXPERTS - 1)

    def expert_ffn(args):
        xb, e = args
        return (jax.nn.silu(xb @ w1[e]) * (xb @ w3[e])) @ w2[e]

    y = lax.map(expert_ffn, (rows.reshape(n_blocks, MOE_BLOCK, D), block_expert)).reshape(-1, D)
    y = y[dest] * flat_gate[order][:, None].astype(y.dtype)
    return jnp.zeros_like(t).at[token].add(y).reshape(B, S, D)


def setup_inputs(seed: int = 0) -> dict:
    key = jax.random.key(seed)
    ks = iter(jax.random.split(key, 40))
    L, D = DEPTH, D_MODEL

    def nrm(shape, fan_in, s=1.0):
        return (s * fan_in ** -0.5) * jax.random.normal(next(ks), shape, jnp.float32)

    def gain(shape):
        return 1.0 + 0.05 * jax.random.normal(next(ks), shape, jnp.float32)

    x = jax.random.normal(next(ks), (BATCH, SEQ, D), jnp.float32)
    c = jax.random.normal(next(ks), (BATCH, D), jnp.float32)
    pos = (jnp.arange(SEQ, dtype=jnp.int32)[None, :]
           + jax.random.randint(next(ks), (BATCH, 1), 0, SEQ, dtype=jnp.int32))
    return {
        'x': x, 'c': c, 'pos': pos,
        'w_ada': nrm((L, D, 6 * D), D, 0.5),
        'b_ada': 0.02 * jax.random.normal(next(ks), (L, 6 * D), jnp.float32),
        'g_norm1': gain((L, D)),
        'w_in': nrm((L, D, IN_COLS), D),
        'g_cq': gain((L, MLA_Q_RANK)),
        'w_uq': nrm((L, MLA_Q_RANK, MLA_HEADS * (MLA_NOPE + MLA_ROPE)), MLA_Q_RANK),
        'g_ckv': gain((L, MLA_KV_RANK)),
        'w_ukv': nrm((L, MLA_KV_RANK, MLA_HEADS * (MLA_NOPE + MLA_V)), MLA_KV_RANK),
        'g_q_mla': gain((L, MLA_NOPE + MLA_ROPE)),
        'g_k_mla': gain((L, MLA_NOPE + MLA_ROPE)),
        'g_q_dil': gain((L, HEAD_DIM)),
        'g_k_dil': gain((L, HEAD_DIM)),
        'g_q_win': gain((L, HEAD_DIM)),
        'g_k_win': gain((L, HEAD_DIM)),
        'sink_win': 0.5 * jax.random.normal(next(ks), (L, WIN_HEADS), jnp.float32),
        'w_br_mla': nrm((L, MLA_OUT, D), MLA_OUT),
        'w_br_dil': nrm((L, DIL_OUT, D), DIL_OUT),
        'w_br_win': nrm((L, WIN_OUT, D), WIN_OUT),
        'w_out': nrm((L, D, D), D),
        'g_norm2': gain((L, D)),
        'w_gr': nrm((L, D, N_EXPERT_GROUPS), D),
        'b_gr': 0.01 * jax.random.normal(next(ks), (L, N_EXPERT_GROUPS), jnp.float32),
        'w_er': nrm((L, D, N_EXPERTS), D),
        'b_er': 0.01 * jax.random.normal(next(ks), (L, N_EXPERTS), jnp.float32),
        'w1': nrm((L, N_EXPERTS, D, D_EXPERT), D),
        'w3': nrm((L, N_EXPERTS, D, D_EXPERT), D),
        'w2': nrm((L, N_EXPERTS, D_EXPERT, D), D_EXPERT),
    }


def reference(x, c, pos, w_ada, b_ada, g_norm1, w_in, g_cq, w_uq, g_ckv, w_ukv, g_q_mla, g_k_mla,
              g_q_dil, g_k_dil, g_q_win, g_k_win, sink_win, w_br_mla, w_br_dil, w_br_win, w_out,
              g_norm2, w_gr, b_gr, w_er, b_er, w1, w3, w2):
    cond = jax.nn.silu(c)
    for l in range(DEPTH):
        mod = cond @ w_ada[l] + b_ada[l]
        sh1, sc1, gt1, sh2, sc2, gt2 = jnp.split(mod[:, None, :], 6, axis=-1)
        h = rms_norm(x, g_norm1[l]) * (1 + sc1) + sh1
        x = x + gt1 * hybrid_mixer(h, pos, w_in[l], g_cq[l], w_uq[l], g_ckv[l], w_ukv[l],
                                   g_q_mla[l], g_k_mla[l], g_q_dil[l], g_k_dil[l],
                                   g_q_win[l], g_k_win[l], sink_win[l],
                                   w_br_mla[l], w_br_dil[l], w_br_win[l], w_out[l])
        h = rms_norm(x, g_norm2[l]) * (1 + sc2) + sh2
        x = x + gt2 * hier_moe(h, w_gr[l], b_gr[l], w_er[l], b_er[l], w1[l], w3[l], w2[l])
    return x
```

```cpp
#include <hip/hip_runtime.h>
#include <hip/hip_cooperative_groups.h>
#include <cstdio>
#include <cstdint>
namespace cg = cooperative_groups;

namespace pg8 {
#define PG8_LAS __attribute__((address_space(3)))
typedef unsigned short bf16_t;
typedef short bf16x8 __attribute__((ext_vector_type(8)));
typedef float f32x4 __attribute__((ext_vector_type(4)));
typedef unsigned u32x4 __attribute__((ext_vector_type(4)));
typedef unsigned u32x2 __attribute__((ext_vector_type(2)));
constexpr int BM = 256, BK = 64, HALF = 128, HTB = HALF * BK * 2  , STAGE_BYTES = 8 * HTB, NXCD = 8, WGM = 8;

__host__ __device__ __forceinline__ int lds_byte(int r, int c) { const int st = (r >> 4) * 2 + (c >> 5), rr = r & 15, cc = c & 31, ob = rr * 64 + cc * 2; return st * 1024 + (ob ^ (((ob >> 9) & 1) << 5)); }
__host__ __device__ __forceinline__ void stage_rc(int b, int& R, int& C) { const int st = b / 1024, sb = b % 1024, swz = sb ^ (((sb >> 9) & 1) << 5); R = (st >> 1) * 16 + swz / 64; C = (st & 1) * 32 + (swz % 64) / 2; }
__host__ __device__ __forceinline__ int perm32(int rho) { const int n = rho >> 4, i = rho & 15; return 8 * (i >> 2) + 4 * n + (i & 3); }

struct Unit { int pm, pn, kind; };
struct Gemm { const bf16_t* A; const bf16_t* Bt; int lda, ldb, K; int wv; };

template <class T_> __device__ __forceinline__ T_ sel3(int k, T_ a, T_ b, T_ c) { return k == 0 ? a : (k == 1 ? b : c); }
struct GemmM { const bf16_t* gA; const bf16_t* gB; const bf16_t *A0, *A1, *A2; const bf16_t *B0, *B1, *B2; int lda0, lda1, lda2, K0, K1, K2; int wv;
    __device__ __forceinline__ int lda(int k) const { return (k & 1) ? sel3(k >> 1, lda0, lda1, lda2) : 1024; }
    __device__ __forceinline__ int ldb(int k) const { return (k & 1) ? sel3(k >> 1, K0, K1, K2) : 1024; }
    __device__ __forceinline__ int K(int k) const { return (k & 1) ? sel3(k >> 1, K0, K1, K2) : 1024; }
    __device__ __forceinline__ const bf16_t* Ap(int k) const { return (k & 1) ? sel3(k >> 1, A0, A1, A2) : gA; }
    __device__ __forceinline__ const bf16_t* Bp(int k) const { return (k & 1) ? sel3(k >> 1, B0, B1, B2) : gB + (size_t)(k >> 1) * 1024 * 1024; }
};
struct StaticOrder {
    int nM, nN, nwg, G, c;
    __device__ void init(int M, int N, int G_, int c_) { nM = M / BM; nN = N / BM; nwg = nM * nN; G = G_; c = c_; }
    __device__ bool next(int i, Unit& u) const {
        const long L = (long)i * G + c; if (L >= nwg) return false;
        int wgid = (int)L; { const int q = nwg / NXCD, r = nwg % NXCD, xcd = wgid % NXCD, off = wgid / NXCD; wgid = (xcd < r ? xcd * (q + 1) : r * (q + 1) + (xcd - r) * q) + off; }
        const int nig = WGM * nN, gid = wgid / nig, fm = gid * WGM, gsz = (nM - fm) < WGM ? (nM - fm) : WGM;
        u.pm = fm + ((wgid % nig) % gsz); u.pn = (wgid % nig) / gsz; return true;
    }
    __device__ __forceinline__ void a_ready(const Unit&) const {}
    __device__ __forceinline__ void done(const Unit&) const {}
};

typedef float f32x2_t __attribute__((ext_vector_type(2))); typedef __bf16 bf16x2_t __attribute__((ext_vector_type(2)));
__device__ __forceinline__ unsigned cvt_pk_bf16(float lo, float hi) { f32x2_t v = {lo, hi}; bf16x2_t b = __builtin_convertvector(v, bf16x2_t); return __builtin_bit_cast(unsigned, b); }

__device__ __forceinline__ int hw_lane() { int l; asm volatile("v_mbcnt_lo_u32_b32 %0, -1, 0\n\tv_mbcnt_hi_u32_b32 %0, -1, %0" : "=v"(l)); return l; }
__device__ __forceinline__ float fast_sigmoid(float x) { return __builtin_amdgcn_rcpf(1.0f + __builtin_amdgcn_exp2f(-1.4426950408889634f * x)); }
__device__ __forceinline__ float bf_lo(unsigned w) { return __uint_as_float(w << 16); }
__device__ __forceinline__ float bf_hi(unsigned w) { return __uint_as_float(w & 0xffff0000u); }

template <int ACT> struct EpiStore {
    static constexpr bool PERM = true, AFTER_DRAIN = false, PREFETCH = false;
    bf16_t* O; int ldc; bf16_t* O2; int ldc2; int split_pn; int pn_mod;
    __device__ __forceinline__ void operator()(const f32x4 (&acc)[2][2][4][2], const Unit& u, int wr, int wc, int, int) const {
        const int ln_ = hw_lane(), fr = ln_ & 15, fq = ln_ >> 4;
        const int row0 = u.pm * BM + wr * 64 + fr;
        bf16_t* base = O; int ld = ldc; int pn = pn_mod ? (u.pn % pn_mod) : u.pn;
        if (pn >= split_pn) { base = O2; ld = ldc2; pn -= split_pn; }
        const int col0 = pn * BM + wc * 32 + 8 * fq;
#pragma unroll
        for (int ai = 0; ai < 2; ++ai)
#pragma unroll
            for (int m = 0; m < 4; ++m) { bf16_t* rowp = base + (size_t)(row0 + ai * HALF + m * 16) * ld + col0;
#pragma unroll
                for (int bj = 0; bj < 2; ++bj) { f32x4 v0 = acc[ai][bj][m][0], v1 = acc[ai][bj][m][1];
                    if (ACT == 1) {
#pragma unroll
                        for (int e = 0; e < 4; ++e) { v0[e] = fast_sigmoid(v0[e]); v1[e] = fast_sigmoid(v1[e]); } }
                    u32x4 w; w.x = cvt_pk_bf16(v0[0], v0[1]); w.y = cvt_pk_bf16(v0[2], v0[3]); w.z = cvt_pk_bf16(v1[0], v1[1]); w.w = cvt_pk_bf16(v1[2], v1[3]);
                    *(u32x4*)(rowp + bj * HALF) = w; } }
    }
};
template <bool XF32> struct EpiResidual {
    static constexpr bool PERM = true, AFTER_DRAIN = false, PREFETCH = false;
    const float* xf; const bf16_t* xb; bf16_t* out; const float* gate;
    __device__ __forceinline__ void operator()(const f32x4 (&acc)[2][2][4][2], const Unit& u, int wr, int wc, int, int) const {
        const int ln_ = hw_lane(), fr = ln_ & 15, fq = ln_ >> 4;
        const int row0 = u.pm * BM + wr * 64 + fr, col0 = u.pn * BM + wc * 32 + 8 * fq;
        const float* gp = gate + (size_t)((u.pm * BM) >> 11) * 6144 + col0;
        f32x4 gv[2][2];
#pragma unroll
        for (int bj = 0; bj < 2; ++bj)
#pragma unroll
            for (int n = 0; n < 2; ++n) gv[bj][n] = *(const f32x4*)(gp + bj * HALF + n * 4);
#pragma unroll
        for (int ai = 0; ai < 2; ++ai) {
            f32x4 xv[4][2][2];
#pragma unroll
            for (int m = 0; m < 4; ++m) { const size_t off = (size_t)(row0 + ai * HALF + m * 16) * 1024 + col0;
#pragma unroll
                for (int bj = 0; bj < 2; ++bj) {
                    if (XF32) { xv[m][bj][0] = *(const f32x4*)(xf + off + bj * HALF); xv[m][bj][1] = *(const f32x4*)(xf + off + bj * HALF + 4); }
                    else { const u32x4 w = *(const u32x4*)(xb + off + bj * HALF); xv[m][bj][0] = (f32x4){bf_lo(w.x), bf_hi(w.x), bf_lo(w.y), bf_hi(w.y)}; xv[m][bj][1] = (f32x4){bf_lo(w.z), bf_hi(w.z), bf_lo(w.w), bf_hi(w.w)}; } } }
#pragma unroll
            for (int m = 0; m < 4; ++m) { const size_t off = (size_t)(row0 + ai * HALF + m * 16) * 1024 + col0;
#pragma unroll
                for (int bj = 0; bj < 2; ++bj) { const f32x4 v0 = xv[m][bj][0] + gv[bj][0] * acc[ai][bj][m][0], v1 = xv[m][bj][1] + gv[bj][1] * acc[ai][bj][m][1];
                    u32x4 w; w.x = cvt_pk_bf16(v0[0], v0[1]); w.y = cvt_pk_bf16(v0[2], v0[3]); w.z = cvt_pk_bf16(v1[0], v1[1]); w.w = cvt_pk_bf16(v1[2], v1[3]);
                    *(u32x4*)(out + off + bj * HALF) = w; } } }
    }
};
struct EpiSwiGLU {
    static constexpr bool PERM = true, AFTER_DRAIN = false, PREFETCH = false;
    bf16_t* O;
    __device__ __forceinline__ void operator()(const f32x4 (&acc)[2][2][4][2], const Unit& u, int wr, int wc, int, int) const {
        const int ln_ = hw_lane(), fr = ln_ & 15, fq = ln_ >> 4;
        const int row0 = u.pm * BM + wr * 64 + fr, col0 = (u.pn % 3) * HALF + wc * 32 + 8 * fq;
#pragma unroll
        for (int ai = 0; ai < 2; ++ai)
#pragma unroll
            for (int m = 0; m < 4; ++m) { float o[8];
#pragma unroll
                for (int n = 0; n < 2; ++n)
#pragma unroll
                    for (int e = 0; e < 4; ++e) { const float a = acc[ai][0][m][n][e], b = acc[ai][1][m][n][e]; o[n * 4 + e] = a * fast_sigmoid(a) * b; }
                u32x4 w; w.x = cvt_pk_bf16(o[0], o[1]); w.y = cvt_pk_bf16(o[2], o[3]); w.z = cvt_pk_bf16(o[4], o[5]); w.w = cvt_pk_bf16(o[6], o[7]);
                *(u32x4*)(O + (size_t)(row0 + ai * HALF + m * 16) * 384 + col0) = w; }
    }
};

struct EpiGateBranch {
    static constexpr bool PERM = true, AFTER_DRAIN = false, PREFETCH = false;
    unsigned char* G; bf16_t* Mo; int ldm;
    __device__ __forceinline__ void operator()(const f32x4 (&acc)[2][2][4][2], const Unit& u, int wr, int wc, int, int) const {
        const int ln_ = hw_lane(), fr = ln_ & 15, fq = ln_ >> 4;
        const int row0 = u.pm * BM + wr * 64 + fr, col0 = u.pn * BM + wc * 32 + 8 * fq;
        if ((u.kind & 1) == 0) {
#pragma unroll
            for (int ai = 0; ai < 2; ++ai)
#pragma unroll
                for (int m = 0; m < 4; ++m) { unsigned char* rowp = G + (size_t)(row0 + ai * HALF + m * 16) * 1024 + col0;
#pragma unroll
                    for (int bj = 0; bj < 2; ++bj) { unsigned q[8];
#pragma unroll
                        for (int e = 0; e < 4; ++e) { q[e] = (unsigned)(fast_sigmoid(acc[ai][bj][m][0][e]) * 255.0f + 0.5f); q[4 + e] = (unsigned)(fast_sigmoid(acc[ai][bj][m][1][e]) * 255.0f + 0.5f); }
                        u32x2 w; w.x = q[0] | (q[1] << 8) | (q[2] << 16) | (q[3] << 24); w.y = q[4] | (q[5] << 8) | (q[6] << 16) | (q[7] << 24);
                        *(u32x2*)(rowp + bj * HALF) = w; } }
        } else {
            const bool accum = u.kind != 1;
#pragma unroll
            for (int ai = 0; ai < 2; ++ai) {
                u32x2 gq[4][2]; u32x4 pm[4][2];
#pragma unroll
                for (int m = 0; m < 4; ++m) { const size_t r = (size_t)(row0 + ai * HALF + m * 16);
#pragma unroll
                    for (int bj = 0; bj < 2; ++bj) { gq[m][bj] = *(const u32x2*)(G + r * 1024 + col0 + bj * HALF);
                        if (accum) pm[m][bj] = *(const u32x4*)(Mo + r * ldm + col0 + bj * HALF); else pm[m][bj] = (u32x4){0u, 0u, 0u, 0u}; } }
#pragma unroll
                for (int m = 0; m < 4; ++m) { const size_t r = (size_t)(row0 + ai * HALF + m * 16);
#pragma unroll
                    for (int bj = 0; bj < 2; ++bj) { const f32x4 v0 = acc[ai][bj][m][0], v1 = acc[ai][bj][m][1]; const u32x2 g = gq[m][bj]; const u32x4 p = pm[m][bj];
                        constexpr float q_ = 1.0f / 255.0f; float o[8];
                        o[0] = v0[0] * (float)(g.x & 255u) * q_ + bf_lo(p.x); o[1] = v0[1] * (float)((g.x >> 8) & 255u) * q_ + bf_hi(p.x); o[2] = v0[2] * (float)((g.x >> 16) & 255u) * q_ + bf_lo(p.y); o[3] = v0[3] * (float)(g.x >> 24) * q_ + bf_hi(p.y);
                        o[4] = v1[0] * (float)(g.y & 255u) * q_ + bf_lo(p.z); o[5] = v1[1] * (float)((g.y >> 8) & 255u) * q_ + bf_hi(p.z); o[6] = v1[2] * (float)((g.y >> 16) & 255u) * q_ + bf_lo(p.w); o[7] = v1[3] * (float)(g.y >> 24) * q_ + bf_hi(p.w);
                        u32x4 w; w.x = cvt_pk_bf16(o[0], o[1]); w.y = cvt_pk_bf16(o[2], o[3]); w.z = cvt_pk_bf16(o[4], o[5]); w.w = cvt_pk_bf16(o[6], o[7]);
                        *(u32x4*)(Mo + r * ldm + col0 + bj * HALF) = w; } } }
        }
    }
};
template <int NK> struct MultiOrder {
    StaticOrder S;
    __device__ __forceinline__ bool next(int i, Unit& u) const { const int ti = i / NK; if (!S.next(ti, u)) return false; u.kind = i - ti * NK; return true; }
    __device__ __forceinline__ void a_ready(const Unit&) const {}
    __device__ __forceinline__ void done(const Unit&) const {}
};
__device__ __forceinline__ float shfl_x(float v, int m, int ln) { return __builtin_bit_cast(float, __builtin_amdgcn_ds_bpermute((ln ^ m) << 2, __builtin_bit_cast(int, v))); }
__device__ __forceinline__ void fast_sincos(float ang, float& sn, float& cs) { float rv = ang * 0.15915494309189535f; rv = rv - floorf(rv); sn = __builtin_amdgcn_sinf(rv); cs = __builtin_amdgcn_cosf(rv); }
__device__ __forceinline__ float inv_freq16(int i) { return __builtin_amdgcn_exp2f(-(float)i * (13.287712379549449f / 16.0f)); }
struct HeadRow { float t[2][2][4]; };
struct EpiProj {
    static constexpr bool PERM = true, AFTER_DRAIN = false, PREFETCH = false;
    bf16_t* QKV; bf16_t* CLAT; float* SSQ; const int* pos; const float *g_q_dil, *g_k_dil, *g_q_win, *g_k_win, *g_kr; float qscale;
    __device__ __forceinline__ void operator()(const f32x4 (&acc)[2][2][4][2], const Unit& u, int wr, int wc, int, int) const {
        const int ln = hw_lane(), fr = ln & 15, fq = ln >> 4;
        const int row0 = u.pm * BM + wr * 64 + fr;
        if (u.pn < 12) {
            const int hq = 4 * u.pn + wc;
            const float* g = nullptr; float post = 1.0f;
            if (hq < 12) { g = g_q_dil; post = qscale; } else if (hq < 24) g = g_k_dil; else if (hq >= 36 && hq < 44) { g = g_q_win; post = qscale; } else if (hq >= 44 && hq < 46) g = g_k_win;
            f32x4 gv[2][2];
#pragma unroll
            for (int bj = 0; bj < 2; ++bj)
#pragma unroll
                for (int n = 0; n < 2; ++n) gv[bj][n] = g ? *(const f32x4*)(g + 32 * bj + 8 * fq + 4 * n) : (f32x4){1.f, 1.f, 1.f, 1.f};
#pragma unroll
            for (int ai = 0; ai < 2; ++ai)
#pragma unroll
                for (int m = 0; m < 4; ++m) { float r = 1.0f;
                    if (g) { float ss = 0.f;
#pragma unroll
                        for (int bj = 0; bj < 2; ++bj)
#pragma unroll
                            for (int n = 0; n < 2; ++n) { const f32x4 v = acc[ai][bj][m][n]; ss += (v[0] * v[0] + v[1] * v[1]) + (v[2] * v[2] + v[3] * v[3]); }
                        ss += shfl_x(ss, 16, ln); ss += shfl_x(ss, 32, ln);
                        r = __builtin_amdgcn_rsqf(ss * (1.0f / 64) + 1e-6f) * post; }
                    bf16_t* rowp = QKV + (size_t)(row0 + ai * HALF + m * 16) * 3072 + hq * 64 + 8 * fq;
#pragma unroll
                    for (int bj = 0; bj < 2; ++bj) { const f32x4 v0 = acc[ai][bj][m][0] * gv[bj][0] * r, v1 = acc[ai][bj][m][1] * gv[bj][1] * r;
                        u32x4 w; w.x = cvt_pk_bf16(v0[0], v0[1]); w.y = cvt_pk_bf16(v0[2], v0[3]); w.z = cvt_pk_bf16(v1[0], v1[1]); w.w = cvt_pk_bf16(v1[2], v1[3]);
                        *(u32x4*)(rowp + 32 * bj) = w; } }
        } else if (u.pn < 15) {
            const int ct = u.pn - 12, col0 = ct * BM + wc * 32 + 8 * fq;
#pragma unroll
            for (int ai = 0; ai < 2; ++ai)
#pragma unroll
                for (int m = 0; m < 4; ++m) { const int row = row0 + ai * HALF + m * 16; float ss = 0.f;
#pragma unroll
                    for (int bj = 0; bj < 2; ++bj) { const f32x4 v0 = acc[ai][bj][m][0], v1 = acc[ai][bj][m][1];
                        ss += (v0[0] * v0[0] + v0[1] * v0[1]) + (v0[2] * v0[2] + v0[3] * v0[3]) + (v1[0] * v1[0] + v1[1] * v1[1]) + (v1[2] * v1[2] + v1[3] * v1[3]);
                        u32x4 w; w.x = cvt_pk_bf16(v0[0], v0[1]); w.y = cvt_pk_bf16(v0[2], v0[3]); w.z = cvt_pk_bf16(v1[0], v1[1]); w.w = cvt_pk_bf16(v1[2], v1[3]);
                        *(u32x4*)(CLAT + (size_t)row * 1024 + col0 + bj * HALF) = w; }
                    ss += shfl_x(ss, 16, ln); ss += shfl_x(ss, 32, ln);
                    if (fq == 0) SSQ[(size_t)row * 12 + ct * 4 + wc] = ss; }
        } else if (wc == 0) {
            const float i0 = inv_freq16(8 * (fq & 1) + 0), i1 = inv_freq16(8 * (fq & 1) + 1), i2 = inv_freq16(8 * (fq & 1) + 2), i3 = inv_freq16(8 * (fq & 1) + 3);
            const float i4 = inv_freq16(8 * (fq & 1) + 4), i5 = inv_freq16(8 * (fq & 1) + 5), i6 = inv_freq16(8 * (fq & 1) + 6), i7 = inv_freq16(8 * (fq & 1) + 7);
            const float ifr[8] = {i0, i1, i2, i3, i4, i5, i6, i7};
            const f32x4 g0 = *(const f32x4*)(g_kr + 8 * fq), g1 = *(const f32x4*)(g_kr + 8 * fq + 4);
            float psv[2][4];
#pragma unroll
            for (int ai = 0; ai < 2; ++ai)
#pragma unroll
                for (int m = 0; m < 4; ++m) psv[ai][m] = (float)pos[row0 + ai * HALF + m * 16];
#pragma unroll
            for (int ai = 0; ai < 2; ++ai)
#pragma unroll
                for (int m = 0; m < 4; ++m) { const int row = row0 + ai * HALF + m * 16; const f32x4 v0 = acc[ai][0][m][0], v1 = acc[ai][0][m][1];
                    float ss = (v0[0] * v0[0] + v0[1] * v0[1]) + (v0[2] * v0[2] + v0[3] * v0[3]) + (v1[0] * v1[0] + v1[1] * v1[1]) + (v1[2] * v1[2] + v1[3] * v1[3]);
                    ss += shfl_x(ss, 16, ln); ss += shfl_x(ss, 32, ln);
                    const float r = __builtin_amdgcn_rsqf(ss * (1.0f / 32) + 1e-6f); const float ps = psv[ai][m];
                    const f32x4 a0 = v0 * g0 * r, a1 = v1 * g1 * r; float o[8];
#pragma unroll
                    for (int e = 0; e < 8; ++e) { const float vn = e < 4 ? a0[e] : a1[e - 4]; const float pr = shfl_x(vn, 32, ln); float sn, cs; fast_sincos(ps * ifr[e], sn, cs);
                        o[e] = (fq & 2) ? (pr * sn + vn * cs) : (vn * cs - pr * sn); }
                    u32x4 w; w.x = cvt_pk_bf16(o[0], o[1]); w.y = cvt_pk_bf16(o[2], o[3]); w.z = cvt_pk_bf16(o[4], o[5]); w.w = cvt_pk_bf16(o[6], o[7]);
                    *(u32x4*)(CLAT + (size_t)row * 1024 + 768 + 8 * fq) = w; }
        }
    }
};
struct EpiQ {
    static constexpr bool PERM = true, AFTER_DRAIN = false, PREFETCH = false;
    bf16_t* QM; const float* SSQ; const int* pos; const float* g_q; float qscale;
    __device__ __forceinline__ void operator()(const f32x4 (&acc)[2][2][4][2], const Unit& u, int wr, int wc, int, int) const {
        const int ln = hw_lane(), fr = ln & 15, fq = ln >> 4;
        const int row0 = u.pm * BM + wr * 64 + fr;
        float rqv[2][4];
#pragma unroll
        for (int ai = 0; ai < 2; ++ai)
#pragma unroll
            for (int m = 0; m < 4; ++m) { const int row = row0 + ai * HALF + m * 16; const f32x4 s0 = *(const f32x4*)(SSQ + (size_t)row * 12), s1 = *(const f32x4*)(SSQ + (size_t)row * 12 + 4);
                rqv[ai][m] = __builtin_amdgcn_rsqf(((s0[0] + s0[1]) + (s0[2] + s0[3]) + (s1[0] + s1[1]) + (s1[2] + s1[3])) * (1.0f / 512) + 1e-6f); }
        if (u.pn < 2) {
            const int h = 4 * u.pn + wc; f32x4 gv[2][2];
#pragma unroll
            for (int bj = 0; bj < 2; ++bj)
#pragma unroll
                for (int n = 0; n < 2; ++n) gv[bj][n] = *(const f32x4*)(g_q + 32 * bj + 8 * fq + 4 * n);
#pragma unroll
            for (int ai = 0; ai < 2; ++ai)
#pragma unroll
                for (int m = 0; m < 4; ++m) { const int row = row0 + ai * HALF + m * 16;
                    const float rq = rqv[ai][m];
                    float ss = 0.f;
#pragma unroll
                    for (int bj = 0; bj < 2; ++bj)
#pragma unroll
                        for (int n = 0; n < 2; ++n) { const f32x4 v = acc[ai][bj][m][n] * rq; ss += (v[0] * v[0] + v[1] * v[1]) + (v[2] * v[2] + v[3] * v[3]); }
                    ss += shfl_x(ss, 16, ln); ss += shfl_x(ss, 32, ln);
                    const float r = __builtin_amdgcn_rsqf(ss * (1.0f / 64) + 1e-6f) * rq * qscale;
                    bf16_t* rowp = QM + (size_t)row * 768 + h * 96 + 8 * fq;
#pragma unroll
                    for (int bj = 0; bj < 2; ++bj) { const f32x4 v0 = acc[ai][bj][m][0] * gv[bj][0] * r, v1 = acc[ai][bj][m][1] * gv[bj][1] * r;
                        u32x4 w; w.x = cvt_pk_bf16(v0[0], v0[1]); w.y = cvt_pk_bf16(v0[2], v0[3]); w.z = cvt_pk_bf16(v1[0], v1[1]); w.w = cvt_pk_bf16(v1[2], v1[3]);
                        *(u32x4*)(rowp + 32 * bj) = w; } }
        } else {
            float ifr[8];
#pragma unroll
            for (int e = 0; e < 8; ++e) ifr[e] = inv_freq16(8 * (fq & 1) + e);
            const f32x4 g0 = *(const f32x4*)(g_q + 64 + 8 * fq), g1 = *(const f32x4*)(g_q + 64 + 8 * fq + 4);
            float psv[2][4];
#pragma unroll
            for (int ai = 0; ai < 2; ++ai)
#pragma unroll
                for (int m = 0; m < 4; ++m) psv[ai][m] = (float)pos[row0 + ai * HALF + m * 16];
#pragma unroll
            for (int ai = 0; ai < 2; ++ai)
#pragma unroll
                for (int m = 0; m < 4; ++m) { const int row = row0 + ai * HALF + m * 16;
                    const float rq = rqv[ai][m];
                    const float ps = psv[ai][m]; float sn[8], cs[8];
#pragma unroll
                    for (int e = 0; e < 8; ++e) fast_sincos(ps * ifr[e], sn[e], cs[e]);
#pragma unroll
                    for (int bj = 0; bj < 2; ++bj) { const int h = 2 * wc + bj; const f32x4 v0 = acc[ai][bj][m][0] * rq, v1 = acc[ai][bj][m][1] * rq;
                        float ss = (v0[0] * v0[0] + v0[1] * v0[1]) + (v0[2] * v0[2] + v0[3] * v0[3]) + (v1[0] * v1[0] + v1[1] * v1[1]) + (v1[2] * v1[2] + v1[3] * v1[3]);
                        ss += shfl_x(ss, 16, ln); ss += shfl_x(ss, 32, ln);
                        const float r = __builtin_amdgcn_rsqf(ss * (1.0f / 32) + 1e-6f); const f32x4 a0 = v0 * g0 * r, a1 = v1 * g1 * r; float o[8];
#pragma unroll
                        for (int e = 0; e < 8; ++e) { const float vn = e < 4 ? a0[e] : a1[e - 4]; const float pr = shfl_x(vn, 32, ln);
                            o[e] = ((fq & 2) ? (pr * sn[e] + vn * cs[e]) : (vn * cs[e] - pr * sn[e])) * qscale; }
                        u32x4 w; w.x = cvt_pk_bf16(o[0], o[1]); w.y = cvt_pk_bf16(o[2], o[3]); w.z = cvt_pk_bf16(o[4], o[5]); w.w = cvt_pk_bf16(o[6], o[7]);
                        *(u32x4*)(QM + (size_t)row * 768 + h * 96 + 64 + 8 * fq) = w; } }
        }
    }
};
struct EpiKV {
    static constexpr bool PERM = true, AFTER_DRAIN = false, PREFETCH = false;
    bf16_t* KVM; const float* SSQ; const float* g_k;
    __device__ __forceinline__ void operator()(const f32x4 (&acc)[2][2][4][2], const Unit& u, int wr, int wc, int, int) const {
        const int ln = hw_lane(), fr = ln & 15, fq = ln >> 4;
        const int row0 = u.pm * BM + wr * 64 + fr; const int h16 = 4 * u.pn + wc; const bool isk = (h16 & 1) == 0;
        f32x4 gv[2][2];
#pragma unroll
        for (int bj = 0; bj < 2; ++bj)
#pragma unroll
            for (int n = 0; n < 2; ++n) gv[bj][n] = isk ? *(const f32x4*)(g_k + 32 * bj + 8 * fq + 4 * n) : (f32x4){1.f, 1.f, 1.f, 1.f};
        float rkv[2][4];
#pragma unroll
        for (int ai = 0; ai < 2; ++ai)
#pragma unroll
            for (int m = 0; m < 4; ++m) { const int row = row0 + ai * HALF + m * 16; const f32x4 s2 = *(const f32x4*)(SSQ + (size_t)row * 12 + 8);
                rkv[ai][m] = __builtin_amdgcn_rsqf(((s2[0] + s2[1]) + (s2[2] + s2[3])) * (1.0f / 256) + 1e-6f); }
#pragma unroll
        for (int ai = 0; ai < 2; ++ai)
#pragma unroll
            for (int m = 0; m < 4; ++m) { const int row = row0 + ai * HALF + m * 16;
                const float rk = rkv[ai][m];
                float r = rk;
                if (isk) { float ss = 0.f;
#pragma unroll
                    for (int bj = 0; bj < 2; ++bj)
#pragma unroll
                        for (int n = 0; n < 2; ++n) { const f32x4 v = acc[ai][bj][m][n] * rk; ss += (v[0] * v[0] + v[1] * v[1]) + (v[2] * v[2] + v[3] * v[3]); }
                    ss += shfl_x(ss, 16, ln); ss += shfl_x(ss, 32, ln);
                    r = __builtin_amdgcn_rsqf(ss * (1.0f / 64) + 1e-6f) * rk; }
                bf16_t* rowp = KVM + (size_t)row * 1024 + h16 * 64 + 8 * fq;
#pragma unroll
                for (int bj = 0; bj < 2; ++bj) { const f32x4 v0 = acc[ai][bj][m][0] * gv[bj][0] * r, v1 = acc[ai][bj][m][1] * gv[bj][1] * r;
                    u32x4 w; w.x = cvt_pk_bf16(v0[0], v0[1]); w.y = cvt_pk_bf16(v0[2], v0[3]); w.z = cvt_pk_bf16(v1[0], v1[1]); w.w = cvt_pk_bf16(v1[2], v1[3]);
                    *(u32x4*)(rowp + 32 * bj) = w; }
                }
    }
};


struct EpiScatterY {
    static constexpr bool PERM = true, AFTER_DRAIN = false, PREFETCH = false;
    bf16_t* Y; const int* slot;
    __device__ __forceinline__ void operator()(const f32x4 (&acc)[2][2][4][2], const Unit& u, int wr, int wc, int, int) const {
        const int ln_ = hw_lane(), fr = ln_ & 15, fq = ln_ >> 4;
        const int row0 = u.pm * BM + wr * 64 + fr, col0 = (u.pn & 3) * BM + wc * 32 + 8 * fq;
        int sl[2][4];
#pragma unroll
        for (int ai = 0; ai < 2; ++ai)
#pragma unroll
            for (int m = 0; m < 4; ++m) sl[ai][m] = slot[row0 + ai * HALF + m * 16];
#pragma unroll
        for (int ai = 0; ai < 2; ++ai)
#pragma unroll
            for (int m = 0; m < 4; ++m) { if (sl[ai][m] >= 0) { bf16_t* rowp = Y + (size_t)sl[ai][m] * 1024 + col0;
#pragma unroll
                    for (int bj = 0; bj < 2; ++bj) { const f32x4 v0 = acc[ai][bj][m][0], v1 = acc[ai][bj][m][1];
                        u32x4 w; w.x = cvt_pk_bf16(v0[0], v0[1]); w.y = cvt_pk_bf16(v0[2], v0[3]); w.z = cvt_pk_bf16(v1[0], v1[1]); w.w = cvt_pk_bf16(v1[2], v1[3]);
                        *(u32x4*)(rowp + bj * HALF) = w; } } }
    }
};
template <class Epi, class Sched, bool ALIGN_EPI = false, bool SP2 = false>
__device__ __forceinline__ void gemm_phase(PG8_LAS unsigned char* lds, const Gemm g, const Sched& S, const Epi& E) {
    const int wid = g.wv, lane = hw_lane(), tid = (wid << 6) | lane,
              wr = wid >> 2, wc = wid & 3, fr = lane & 15, fq = lane >> 4;
    const int K = g.K, nt = K / BK;
    unsigned voffA[2], voffB[2];
#pragma unroll
    for (int i = 0; i < 2; ++i) { int R, C; stage_rc(tid * 16 + i * 8192, R, C); const int Rb = Epi::PERM ? ((R & ~31) + perm32(R & 31)) : R;
        voffA[i] = (unsigned)(R * g.lda + C) * 2u; voffB[i] = (unsigned)(Rb * g.ldb + C) * 2u; }
    const size_t kstep = (size_t)(BK * 2);
    const size_t hstepA = (size_t)HALF * g.lda * 2, hstepB = (size_t)HALF * g.ldb * 2;
    const size_t tstepA = 2 * hstepA, tstepB = 2 * hstepB;
    const unsigned ldsw = (unsigned)wid * 1024u;
    const int aoff = lds_byte(wr * 64 + fr, fq * 8), boff = lds_byte(wc * 32 + fr, fq * 8);
#define PG8_SA(b, h) (((b) * 2 + (h)) * HTB)
#define PG8_SB(b, h) ((4 + (b) * 2 + (h)) * HTB)
#define PG8_STAGE(bufoff, gbase, voff) do { _Pragma("unroll") for (int _i = 0; _i < 2; ++_i) \
        __builtin_amdgcn_global_load_lds((const unsigned*)((const char*)(gbase) + (voff)[_i]), (PG8_LAS unsigned*)(lds + (bufoff) + ldsw + _i * 8192), 16, 0, 0); } while (0)
#define PG8_LDA(dst, b, h) do { _Pragma("unroll") for (int m = 0; m < 4; ++m) _Pragma("unroll") for (int k = 0; k < 2; ++k) dst[m][k] = *(const PG8_LAS bf16x8*)(lds + PG8_SA(b, h) + aoff + m * 2048 + k * 1024); } while (0)
#define PG8_LDB(dst, b, h) do { _Pragma("unroll") for (int n = 0; n < 2; ++n) _Pragma("unroll") for (int k = 0; k < 2; ++k) dst[n][k] = *(const PG8_LAS bf16x8*)(lds + PG8_SB(b, h) + boff + n * 2048 + k * 1024); } while (0)
#define PG8_MMA(ai, bj, At, Bt) do { __builtin_amdgcn_s_setprio(1); _Pragma("unroll") for (int m = 0; m < 4; ++m) _Pragma("unroll") for (int n = 0; n < 2; ++n) _Pragma("unroll") for (int k = 0; k < 2; ++k) \
        acc[ai][bj][m][n] = __builtin_amdgcn_mfma_f32_16x16x32_bf16(Bt[n][k], At[m][k], acc[ai][bj][m][n], 0, 0, 0); __builtin_amdgcn_s_setprio(0); } while (0)
#define PG8_WAIT_V(n) asm volatile("s_waitcnt vmcnt(" #n ")" ::: "memory")
#define PG8_WAIT_L(n) asm volatile("s_waitcnt lgkmcnt(" #n ")" ::: "memory")
#define PG8_BAR __builtin_amdgcn_s_barrier()
#define PG8_SCHED __builtin_amdgcn_sched_barrier(0)
    Unit cur, nxt; int ui = 0;
    if (!S.next(0, cur)) return;
    f32x4 acc[2][2][4][2];
#pragma unroll
    for (int a = 0; a < 2; ++a)
#pragma unroll
        for (int b = 0; b < 2; ++b)
#pragma unroll
            for (int m = 0; m < 4; ++m)
#pragma unroll
                for (int n = 0; n < 2; ++n) acc[a][b][m][n] = (f32x4){0.f, 0.f, 0.f, 0.f};
    bf16x8 At[4][2] = {}, B0[2][2] = {}, B1[2][2] = {};
    const char* cA = (const char*)g.A + (size_t)cur.pm * tstepA; const char* cB = (const char*)g.Bt + (size_t)cur.pn * tstepB;
    S.a_ready(cur);
    if constexpr (SP2) {
        PG8_STAGE(PG8_SB(0, 0), cB, voffB); PG8_STAGE(PG8_SB(0, 1), cB + hstepB, voffB); PG8_STAGE(PG8_SA(0, 0), cA, voffA); PG8_STAGE(PG8_SA(0, 1), cA + hstepA, voffA);
        if (wr == 1) PG8_BAR;
        PG8_WAIT_V(2); PG8_BAR;
        PG8_STAGE(PG8_SB(1, 0), cB + kstep, voffB); PG8_STAGE(PG8_SA(1, 0), cA + kstep, voffA); PG8_STAGE(PG8_SB(1, 1), cB + hstepB + kstep, voffB);
        PG8_WAIT_V(6); PG8_BAR;
    } else {
        PG8_STAGE(PG8_SB(0, 0), cB, voffB); PG8_STAGE(PG8_SA(0, 0), cA, voffA); PG8_STAGE(PG8_SB(0, 1), cB + hstepB, voffB); PG8_STAGE(PG8_SA(0, 1), cA + hstepA, voffA);
        if (wr == 1) PG8_BAR;
        PG8_WAIT_V(4); PG8_BAR;
        PG8_STAGE(PG8_SB(1, 0), cB + kstep, voffB); PG8_STAGE(PG8_SA(1, 0), cA + kstep, voffA); PG8_STAGE(PG8_SB(1, 1), cB + hstepB + kstep, voffB);
        PG8_WAIT_V(6); PG8_BAR;
    }
    for (;;) {
        const bool has_next = S.next(ui + 1, nxt);
        const char* nA = has_next ? (const char*)g.A + (size_t)nxt.pm * tstepA : cA; const char* nB = has_next ? (const char*)g.Bt + (size_t)nxt.pn * tstepB : cB;
        if constexpr (Epi::PREFETCH) E.prefetch(cur, lds + STAGE_BYTES + 16384 + 13312 + wid * 256, wid, lane);
        for (int t = 0; t < nt; t += 2) {
            const bool last = (t == nt - 2);
            const char* a1 = cA + (size_t)(t + 1) * kstep;
            const char* a2 = last ? nA : cA + (size_t)(t + 2) * kstep; const char* b2 = last ? nB : cB + (size_t)(t + 2) * kstep;
            const char* a3 = a2 + kstep; const char* b3 = b2 + kstep;
            if (last && has_next) S.a_ready(nxt);
            if constexpr (SP2) {
            PG8_LDB(B0, 0, 0); PG8_LDB(B1, 0, 1); PG8_SCHED; PG8_LDA(At, 0, 0); PG8_STAGE(PG8_SA(1, 1), a1 + hstepA, voffA);
            PG8_WAIT_V(8); PG8_WAIT_L(0); PG8_BAR; PG8_MMA(0, 0, At, B0); PG8_MMA(0, 1, At, B1); PG8_BAR; PG8_SCHED;
            PG8_LDA(At, 0, 1); PG8_STAGE(PG8_SB(0, 0), b2, voffB); PG8_STAGE(PG8_SB(0, 1), b2 + hstepB, voffB); PG8_STAGE(PG8_SA(0, 0), a2, voffA);
            PG8_WAIT_V(8); PG8_WAIT_L(0); PG8_BAR; PG8_MMA(1, 0, At, B0); PG8_MMA(1, 1, At, B1); PG8_BAR; PG8_SCHED;
            PG8_LDB(B0, 1, 0); PG8_LDB(B1, 1, 1); PG8_SCHED; PG8_LDA(At, 1, 0); PG8_STAGE(PG8_SA(0, 1), a2 + hstepA, voffA);
            PG8_WAIT_V(8); PG8_WAIT_L(0); PG8_BAR; PG8_MMA(0, 0, At, B0); PG8_MMA(0, 1, At, B1); PG8_BAR; PG8_SCHED;
            PG8_LDA(At, 1, 1); PG8_STAGE(PG8_SB(1, 0), b3, voffB); PG8_STAGE(PG8_SB(1, 1), b3 + hstepB, voffB); PG8_STAGE(PG8_SA(1, 0), a3, voffA);
            PG8_WAIT_V(8); PG8_WAIT_L(0); PG8_BAR; PG8_MMA(1, 0, At, B0); PG8_MMA(1, 1, At, B1); PG8_BAR; PG8_SCHED;
            } else {
            PG8_LDB(B0, 0, 0); PG8_SCHED; PG8_LDA(At, 0, 0); PG8_STAGE(PG8_SA(1, 1), a1 + hstepA, voffA);
            PG8_WAIT_L(8); PG8_BAR; PG8_WAIT_L(0); PG8_MMA(0, 0, At, B0); PG8_BAR; PG8_SCHED;
            PG8_LDB(B1, 0, 1); PG8_STAGE(PG8_SB(0, 0), b2, voffB);
            PG8_BAR; PG8_WAIT_L(0); PG8_MMA(0, 1, At, B1); PG8_BAR;
            PG8_LDA(At, 0, 1); PG8_STAGE(PG8_SA(0, 0), a2, voffA);
            PG8_BAR; PG8_WAIT_L(0); PG8_MMA(1, 0, At, B0); PG8_BAR; PG8_SCHED;
            PG8_STAGE(PG8_SB(0, 1), b2 + hstepB, voffB);
            PG8_WAIT_V(6); PG8_BAR; PG8_MMA(1, 1, At, B1); PG8_BAR;
            PG8_LDB(B0, 1, 0); PG8_SCHED; PG8_LDA(At, 1, 0); PG8_STAGE(PG8_SA(0, 1), a2 + hstepA, voffA);
            PG8_WAIT_L(8); PG8_BAR; PG8_WAIT_L(0); PG8_MMA(0, 0, At, B0); PG8_BAR; PG8_SCHED;
            PG8_LDB(B1, 1, 1); PG8_STAGE(PG8_SB(1, 0), b3, voffB);
            PG8_BAR; PG8_WAIT_L(0); PG8_MMA(0, 1, At, B1); PG8_BAR;
            PG8_LDA(At, 1, 1); PG8_STAGE(PG8_SA(1, 0), a3, voffA);
            PG8_BAR; PG8_WAIT_L(0); PG8_MMA(1, 0, At, B0); PG8_BAR; PG8_SCHED;
            PG8_STAGE(PG8_SB(1, 1), b3 + hstepB, voffB);
            PG8_WAIT_V(6); PG8_BAR; PG8_MMA(1, 1, At, B1); PG8_BAR;
            }
        }
        if constexpr (ALIGN_EPI) { if (wr == 0) PG8_BAR; }
        if constexpr (!Epi::AFTER_DRAIN) { E(acc, cur, wr, wc, fr, fq); S.done(cur); }
        if (!has_next) break;
#pragma unroll
        for (int a = 0; a < 2; ++a)
#pragma unroll
            for (int b = 0; b < 2; ++b)
#pragma unroll
                for (int m = 0; m < 4; ++m)
#pragma unroll
                    for (int n = 0; n < 2; ++n) acc[a][b][m][n] = (f32x4){0.f, 0.f, 0.f, 0.f};
        cur = nxt; cA = nA; cB = nB; ++ui;
        if constexpr (ALIGN_EPI) { if (wr == 1) PG8_BAR; }
    }
    PG8_WAIT_V(0);
    if constexpr (!ALIGN_EPI) { if (wr == 0) PG8_BAR; }
    PG8_BAR;
    if constexpr (Epi::AFTER_DRAIN) { E.fused(acc, cur, wr, wc, fr, fq, lds, wid, lane); S.done(cur); }
#undef PG8_SA
#undef PG8_SB
#undef PG8_STAGE
#undef PG8_LDA
#undef PG8_LDB
#undef PG8_MMA
#undef PG8_WAIT_V
#undef PG8_WAIT_L
#undef PG8_BAR
#undef PG8_SCHED
}
template <class Epi, class Sched, bool ALIGN_EPI = false, bool SP2 = false>
__device__ __forceinline__ void gemm_phase_multi(PG8_LAS unsigned char* lds, const GemmM g, const Sched& S, const Epi& E) {
    const int wid = g.wv, lane = hw_lane(), tid = (wid << 6) | lane,
              wr = wid >> 2, wc = wid & 3, fr = lane & 15, fq = lane >> 4;
    int stR[2], stRb[2], stC[2];
#pragma unroll
    for (int i = 0; i < 2; ++i) { int R, C; stage_rc(tid * 16 + i * 8192, R, C); stR[i] = R; stRb[i] = Epi::PERM ? ((R & ~31) + perm32(R & 31)) : R; stC[i] = C; }
    unsigned voffA[2], voffB[2], voffAn[2], voffBn[2]; size_t hstepA, hstepB, hstepAn, hstepBn; int nt, ntn;
#define PG8_KIND(kd, vA, vB, hA, hB, ntk) do { const int la_ = g.lda(kd), lb_ = g.ldb(kd); _Pragma("unroll") for (int i = 0; i < 2; ++i) { vA[i] = (unsigned)(stR[i] * la_ + stC[i]) * 2u; vB[i] = (unsigned)(stRb[i] * lb_ + stC[i]) * 2u; } \
        hA = (size_t)HALF * la_ * 2; hB = (size_t)HALF * lb_ * 2; ntk = g.K(kd) / BK; } while (0)
    const size_t kstep = (size_t)(BK * 2);
    const unsigned ldsw = (unsigned)wid * 1024u;
    const int aoff = lds_byte(wr * 64 + fr, fq * 8), boff = lds_byte(wc * 32 + fr, fq * 8);
#define PG8_SA(b, h) (((b) * 2 + (h)) * HTB)
#define PG8_SB(b, h) ((4 + (b) * 2 + (h)) * HTB)
#define PG8_STAGE(bufoff, gbase, voff) do { _Pragma("unroll") for (int _i = 0; _i < 2; ++_i) \
        __builtin_amdgcn_global_load_lds((const unsigned*)((const char*)(gbase) + (voff)[_i]), (PG8_LAS unsigned*)(lds + (bufoff) + ldsw + _i * 8192), 16, 0, 0); } while (0)
#define PG8_LDA(dst, b, h) do { _Pragma("unroll") for (int m = 0; m < 4; ++m) _Pragma("unroll") for (int k = 0; k < 2; ++k) dst[m][k] = *(const PG8_LAS bf16x8*)(lds + PG8_SA(b, h) + aoff + m * 2048 + k * 1024); } while (0)
#define PG8_LDB(dst, b, h) do { _Pragma("unroll") for (int n = 0; n < 2; ++n) _Pragma("unroll") for (int k = 0; k < 2; ++k) dst[n][k] = *(const PG8_LAS bf16x8*)(lds + PG8_SB(b, h) + boff + n * 2048 + k * 1024); } while (0)
#define PG8_MMA(ai, bj, At, Bt) do { __builtin_amdgcn_s_setprio(1); _Pragma("unroll") for (int m = 0; m < 4; ++m) _Pragma("unroll") for (int n = 0; n < 2; ++n) _Pragma("unroll") for (int k = 0; k < 2; ++k) \
        acc[ai][bj][m][n] = __builtin_amdgcn_mfma_f32_16x16x32_bf16(Bt[n][k], At[m][k], acc[ai][bj][m][n], 0, 0, 0); __builtin_amdgcn_s_setprio(0); } while (0)
#define PG8_WAIT_V(n) asm volatile("s_waitcnt vmcnt(" #n ")" ::: "memory")
#define PG8_WAIT_L(n) asm volatile("s_waitcnt lgkmcnt(" #n ")" ::: "memory")
#define PG8_BAR __builtin_amdgcn_s_barrier()
#define PG8_SCHED __builtin_amdgcn_sched_barrier(0)
    Unit cur, nxt; int ui = 0;
    if (!S.next(0, cur)) return;
    f32x4 acc[2][2][4][2];
#pragma unroll
    for (int a = 0; a < 2; ++a)
#pragma unroll
        for (int b = 0; b < 2; ++b)
#pragma unroll
            for (int m = 0; m < 4; ++m)
#pragma unroll
                for (int n = 0; n < 2; ++n) acc[a][b][m][n] = (f32x4){0.f, 0.f, 0.f, 0.f};
    bf16x8 At[4][2] = {}, B0[2][2] = {}, B1[2][2] = {};
    PG8_KIND(cur.kind, voffA, voffB, hstepA, hstepB, nt);
    const char* cA = (const char*)g.Ap(cur.kind) + (size_t)cur.pm * 2 * hstepA; const char* cB = (const char*)g.Bp(cur.kind) + (size_t)cur.pn * 2 * hstepB;
    S.a_ready(cur);
    if constexpr (SP2) {
        PG8_STAGE(PG8_SB(0, 0), cB, voffB); PG8_STAGE(PG8_SB(0, 1), cB + hstepB, voffB); PG8_STAGE(PG8_SA(0, 0), cA, voffA); PG8_STAGE(PG8_SA(0, 1), cA + hstepA, voffA);
        if (wr == 1) PG8_BAR;
        PG8_WAIT_V(2); PG8_BAR;
        PG8_STAGE(PG8_SB(1, 0), cB + kstep, voffB); PG8_STAGE(PG8_SA(1, 0), cA + kstep, voffA); PG8_STAGE(PG8_SB(1, 1), cB + hstepB + kstep, voffB);
        PG8_WAIT_V(6); PG8_BAR;
    } else {
        PG8_STAGE(PG8_SB(0, 0), cB, voffB); PG8_STAGE(PG8_SA(0, 0), cA, voffA); PG8_STAGE(PG8_SB(0, 1), cB + hstepB, voffB); PG8_STAGE(PG8_SA(0, 1), cA + hstepA, voffA);
        if (wr == 1) PG8_BAR;
        PG8_WAIT_V(4); PG8_BAR;
        PG8_STAGE(PG8_SB(1, 0), cB + kstep, voffB); PG8_STAGE(PG8_SA(1, 0), cA + kstep, voffA); PG8_STAGE(PG8_SB(1, 1), cB + hstepB + kstep, voffB);
        PG8_WAIT_V(6); PG8_BAR;
    }
    for (;;) {
        const bool has_next = S.next(ui + 1, nxt);
        const int nkind = has_next ? nxt.kind : cur.kind;
        PG8_KIND(nkind, voffAn, voffBn, hstepAn, hstepBn, ntn);
        const char* nA = has_next ? (const char*)g.Ap(nkind) + (size_t)nxt.pm * 2 * hstepAn : cA; const char* nB = has_next ? (const char*)g.Bp(nkind) + (size_t)nxt.pn * 2 * hstepBn : cB;
        if constexpr (Epi::PREFETCH) E.prefetch(cur, lds + STAGE_BYTES + 16384 + 13312 + wid * 256, wid, lane);
        for (int t = 0; t < nt; t += 2) {
            const bool last = (t == nt - 2);
            const char* a1 = cA + (size_t)(t + 1) * kstep;
            const char* a2 = last ? nA : cA + (size_t)(t + 2) * kstep; const char* b2 = last ? nB : cB + (size_t)(t + 2) * kstep;
            const char* a3 = a2 + kstep; const char* b3 = b2 + kstep;
            unsigned vA2[2], vB2[2];
#pragma unroll
            for (int i = 0; i < 2; ++i) { vA2[i] = last ? voffAn[i] : voffA[i]; vB2[i] = last ? voffBn[i] : voffB[i]; }
            const size_t hA2 = last ? hstepAn : hstepA, hB2 = last ? hstepBn : hstepB;
            if (last && has_next) S.a_ready(nxt);
            if constexpr (SP2) {
            PG8_LDB(B0, 0, 0); PG8_LDB(B1, 0, 1); PG8_SCHED; PG8_LDA(At, 0, 0); PG8_STAGE(PG8_SA(1, 1), a1 + hstepA, voffA);
            PG8_WAIT_V(8); PG8_WAIT_L(0); PG8_BAR; PG8_MMA(0, 0, At, B0); PG8_MMA(0, 1, At, B1); PG8_BAR; PG8_SCHED;
            PG8_LDA(At, 0, 1); PG8_STAGE(PG8_SB(0, 0), b2, vB2); PG8_STAGE(PG8_SB(0, 1), b2 + hB2, vB2); PG8_STAGE(PG8_SA(0, 0), a2, vA2);
            PG8_WAIT_V(8); PG8_WAIT_L(0); PG8_BAR; PG8_MMA(1, 0, At, B0); PG8_MMA(1, 1, At, B1); PG8_BAR; PG8_SCHED;
            PG8_LDB(B0, 1, 0); PG8_LDB(B1, 1, 1); PG8_SCHED; PG8_LDA(At, 1, 0); PG8_STAGE(PG8_SA(0, 1), a2 + hA2, vA2);
            PG8_WAIT_V(8); PG8_WAIT_L(0); PG8_BAR; PG8_MMA(0, 0, At, B0); PG8_MMA(0, 1, At, B1); PG8_BAR; PG8_SCHED;
            PG8_LDA(At, 1, 1); PG8_STAGE(PG8_SB(1, 0), b3, vB2); PG8_STAGE(PG8_SB(1, 1), b3 + hB2, vB2); PG8_STAGE(PG8_SA(1, 0), a3, vA2);
            PG8_WAIT_V(8); PG8_WAIT_L(0); PG8_BAR; PG8_MMA(1, 0, At, B0); PG8_MMA(1, 1, At, B1); PG8_BAR; PG8_SCHED;
            } else {
            PG8_LDB(B0, 0, 0); PG8_SCHED; PG8_LDA(At, 0, 0); PG8_STAGE(PG8_SA(1, 1), a1 + hstepA, voffA);
            PG8_WAIT_L(8); PG8_BAR; PG8_WAIT_L(0); PG8_MMA(0, 0, At, B0); PG8_BAR; PG8_SCHED;
            PG8_LDB(B1, 0, 1); PG8_STAGE(PG8_SB(0, 0), b2, vB2);
            PG8_BAR; PG8_WAIT_L(0); PG8_MMA(0, 1, At, B1); PG8_BAR;
            PG8_LDA(At, 0, 1); PG8_STAGE(PG8_SA(0, 0), a2, vA2);
            PG8_BAR; PG8_WAIT_L(0); PG8_MMA(1, 0, At, B0); PG8_BAR; PG8_SCHED;
            PG8_STAGE(PG8_SB(0, 1), b2 + hB2, vB2);
            PG8_WAIT_V(6); PG8_BAR; PG8_MMA(1, 1, At, B1); PG8_BAR;
            PG8_LDB(B0, 1, 0); PG8_SCHED; PG8_LDA(At, 1, 0); PG8_STAGE(PG8_SA(0, 1), a2 + hA2, vA2);
            PG8_WAIT_L(8); PG8_BAR; PG8_WAIT_L(0); PG8_MMA(0, 0, At, B0); PG8_BAR; PG8_SCHED;
            PG8_LDB(B1, 1, 1); PG8_STAGE(PG8_SB(1, 0), b3, vB2);
            PG8_BAR; PG8_WAIT_L(0); PG8_MMA(0, 1, At, B1); PG8_BAR;
            PG8_LDA(At, 1, 1); PG8_STAGE(PG8_SA(1, 0), a3, vA2);
            PG8_BAR; PG8_WAIT_L(0); PG8_MMA(1, 0, At, B0); PG8_BAR; PG8_SCHED;
            PG8_STAGE(PG8_SB(1, 1), b3 + hB2, vB2);
            PG8_WAIT_V(6); PG8_BAR; PG8_MMA(1, 1, At, B1); PG8_BAR;
            }
        }
        if constexpr (ALIGN_EPI) { if (wr == 0) PG8_BAR; }
        if constexpr (!Epi::AFTER_DRAIN) { E(acc, cur, wr, wc, fr, fq); S.done(cur); }
        if (!has_next) break;
#pragma unroll
        for (int a = 0; a < 2; ++a)
#pragma unroll
            for (int b = 0; b < 2; ++b)
#pragma unroll
                for (int m = 0; m < 4; ++m)
#pragma unroll
                    for (int n = 0; n < 2; ++n) acc[a][b][m][n] = (f32x4){0.f, 0.f, 0.f, 0.f};
        cur = nxt; cA = nA; cB = nB; ++ui;
#pragma unroll
        for (int i = 0; i < 2; ++i) { voffA[i] = voffAn[i]; voffB[i] = voffBn[i]; }
        hstepA = hstepAn; hstepB = hstepBn; nt = ntn;
        if constexpr (ALIGN_EPI) { if (wr == 1) PG8_BAR; }
    }
    PG8_WAIT_V(0);
    if constexpr (!ALIGN_EPI) { if (wr == 0) PG8_BAR; }
    PG8_BAR;
    if constexpr (Epi::AFTER_DRAIN) { E.fused(acc, cur, wr, wc, fr, fq, lds, wid, lane); S.done(cur); }
#undef PG8_KIND
#undef PG8_SA
#undef PG8_SB
#undef PG8_STAGE
#undef PG8_LDA
#undef PG8_LDB
#undef PG8_MMA
#undef PG8_WAIT_V
#undef PG8_WAIT_L
#undef PG8_BAR
#undef PG8_SCHED
}
template <class Epi, class Sched, bool ALIGN_EPI = false, bool SP2 = false>
__device__ __forceinline__ void gemm_phase_gather(PG8_LAS unsigned char* lds, const Gemm g, const int* rowidx, const Sched& S, const Epi& E) {
    const int wid = g.wv, lane = hw_lane(), tid = (wid << 6) | lane,
              wr = wid >> 2, wc = wid & 3, fr = lane & 15, fq = lane >> 4;
    const int K = g.K, nt = K / BK;
    unsigned voffB[2]; int stR[2], stC[2];
#pragma unroll
    for (int i = 0; i < 2; ++i) { int R, C; stage_rc(tid * 16 + i * 8192, R, C); const int Rb = Epi::PERM ? ((R & ~31) + perm32(R & 31)) : R;
        stR[i] = R; stC[i] = C; voffB[i] = (unsigned)(Rb * g.ldb + C) * 2u; }
    unsigned vA0[2], vA1[2], vA0n[2], vA1n[2];
#define PG8_ROWS(pm_, v0, v1) do { _Pragma("unroll") for (int i = 0; i < 2; ++i) { const int s0_ = rowidx[(pm_) * BM + stR[i]], s1_ = rowidx[(pm_) * BM + HALF + stR[i]]; const int r0_ = (s0_ < 0 ? 0 : s0_) >> 1, r1_ = (s1_ < 0 ? 0 : s1_) >> 1;     \
        v0[i] = (unsigned)(r0_ * g.lda + stC[i]) * 2u; v1[i] = (unsigned)(r1_ * g.lda + stC[i]) * 2u; } } while (0)
    const size_t kstep = (size_t)(BK * 2);
    const size_t hstepB = (size_t)HALF * g.ldb * 2;
    const size_t tstepB = 2 * hstepB;
    const unsigned ldsw = (unsigned)wid * 1024u;
    const int aoff = lds_byte(wr * 64 + fr, fq * 8), boff = lds_byte(wc * 32 + fr, fq * 8);
#define PG8_SA(b, h) (((b) * 2 + (h)) * HTB)
#define PG8_SB(b, h) ((4 + (b) * 2 + (h)) * HTB)
#define PG8_STAGE(bufoff, gbase, voff) do { _Pragma("unroll") for (int _i = 0; _i < 2; ++_i) \
        __builtin_amdgcn_global_load_lds((const unsigned*)((const char*)(gbase) + (voff)[_i]), (PG8_LAS unsigned*)(lds + (bufoff) + ldsw + _i * 8192), 16, 0, 0); } while (0)
#define PG8_LDA(dst, b, h) do { _Pragma("unroll") for (int m = 0; m < 4; ++m) _Pragma("unroll") for (int k = 0; k < 2; ++k) dst[m][k] = *(const PG8_LAS bf16x8*)(lds + PG8_SA(b, h) + aoff + m * 2048 + k * 1024); } while (0)
#define PG8_LDB(dst, b, h) do { _Pragma("unroll") for (int n = 0; n < 2; ++n) _Pragma("unroll") for (int k = 0; k < 2; ++k) dst[n][k] = *(const PG8_LAS bf16x8*)(lds + PG8_SB(b, h) + boff + n * 2048 + k * 1024); } while (0)
#define PG8_MMA(ai, bj, At, Bt) do { __builtin_amdgcn_s_setprio(1); _Pragma("unroll") for (int m = 0; m < 4; ++m) _Pragma("unroll") for (int n = 0; n < 2; ++n) _Pragma("unroll") for (int k = 0; k < 2; ++k) \
        acc[ai][bj][m][n] = __builtin_amdgcn_mfma_f32_16x16x32_bf16(Bt[n][k], At[m][k], acc[ai][bj][m][n], 0, 0, 0); __builtin_amdgcn_s_setprio(0); } while (0)
#define PG8_WAIT_V(n) asm volatile("s_waitcnt vmcnt(" #n ")" ::: "memory")
#define PG8_WAIT_L(n) asm volatile("s_waitcnt lgkmcnt(" #n ")" ::: "memory")
#define PG8_BAR __builtin_amdgcn_s_barrier()
#define PG8_SCHED __builtin_amdgcn_sched_barrier(0)
    Unit cur, nxt; int ui = 0;
    if (!S.next(0, cur)) return;
    f32x4 acc[2][2][4][2];
#pragma unroll
    for (int a = 0; a < 2; ++a)
#pragma unroll
        for (int b = 0; b < 2; ++b)
#pragma unroll
            for (int m = 0; m < 4; ++m)
#pragma unroll
                for (int n = 0; n < 2; ++n) acc[a][b][m][n] = (f32x4){0.f, 0.f, 0.f, 0.f};
    bf16x8 At[4][2] = {}, B0[2][2] = {}, B1[2][2] = {};
    PG8_ROWS(cur.pm, vA0, vA1);
    const char* cA = (const char*)g.A; const char* cB = (const char*)g.Bt + (size_t)cur.pn * tstepB;
    S.a_ready(cur);
    if constexpr (SP2) {
        PG8_STAGE(PG8_SB(0, 0), cB, voffB); PG8_STAGE(PG8_SB(0, 1), cB + hstepB, voffB); PG8_STAGE(PG8_SA(0, 0), cA, vA0); PG8_STAGE(PG8_SA(0, 1), cA, vA1);
        if (wr == 1) PG8_BAR;
        PG8_WAIT_V(2); PG8_BAR;
        PG8_STAGE(PG8_SB(1, 0), cB + kstep, voffB); PG8_STAGE(PG8_SA(1, 0), cA + kstep, vA0); PG8_STAGE(PG8_SB(1, 1), cB + hstepB + kstep, voffB);
        PG8_WAIT_V(6); PG8_BAR;
    } else {
        PG8_STAGE(PG8_SB(0, 0), cB, voffB); PG8_STAGE(PG8_SA(0, 0), cA, vA0); PG8_STAGE(PG8_SB(0, 1), cB + hstepB, voffB); PG8_STAGE(PG8_SA(0, 1), cA, vA1);
        if (wr == 1) PG8_BAR;
        PG8_WAIT_V(4); PG8_BAR;
        PG8_STAGE(PG8_SB(1, 0), cB + kstep, voffB); PG8_STAGE(PG8_SA(1, 0), cA + kstep, vA0); PG8_STAGE(PG8_SB(1, 1), cB + hstepB + kstep, voffB);
        PG8_WAIT_V(6); PG8_BAR;
    }
    for (;;) {
        const bool has_next = S.next(ui + 1, nxt);
        PG8_ROWS((has_next ? nxt.pm : cur.pm), vA0n, vA1n);
        const char* nA = cA; const char* nB = has_next ? (const char*)g.Bt + (size_t)nxt.pn * tstepB : cB;
        if constexpr (Epi::PREFETCH) E.prefetch(cur, lds + STAGE_BYTES + 16384 + 13312 + wid * 256, wid, lane);
        for (int t = 0; t < nt; t += 2) {
            const bool last = (t == nt - 2);
            const char* a1 = cA + (size_t)(t + 1) * kstep;
            const char* a2 = last ? nA : cA + (size_t)(t + 2) * kstep; const char* b2 = last ? nB : cB + (size_t)(t + 2) * kstep;
            const char* a3 = a2 + kstep; const char* b3 = b2 + kstep;
            unsigned wA0[2], wA1[2];
#pragma unroll
            for (int i = 0; i < 2; ++i) { wA0[i] = last ? vA0n[i] : vA0[i]; wA1[i] = last ? vA1n[i] : vA1[i]; }
            if (last && has_next) S.a_ready(nxt);
            if constexpr (SP2) {
            PG8_LDB(B0, 0, 0); PG8_LDB(B1, 0, 1); PG8_SCHED; PG8_LDA(At, 0, 0); PG8_STAGE(PG8_SA(1, 1), a1, vA1);
            PG8_WAIT_V(8); PG8_WAIT_L(0); PG8_BAR; PG8_MMA(0, 0, At, B0); PG8_MMA(0, 1, At, B1); PG8_BAR; PG8_SCHED;
            PG8_LDA(At, 0, 1); PG8_STAGE(PG8_SB(0, 0), b2, voffB); PG8_STAGE(PG8_SB(0, 1), b2 + hstepB, voffB); PG8_STAGE(PG8_SA(0, 0), a2, wA0);
            PG8_WAIT_V(8); PG8_WAIT_L(0); PG8_BAR; PG8_MMA(1, 0, At, B0); PG8_MMA(1, 1, At, B1); PG8_BAR; PG8_SCHED;
            PG8_LDB(B0, 1, 0); PG8_LDB(B1, 1, 1); PG8_SCHED; PG8_LDA(At, 1, 0); PG8_STAGE(PG8_SA(0, 1), a2, wA1);
            PG8_WAIT_V(8); PG8_WAIT_L(0); PG8_BAR; PG8_MMA(0, 0, At, B0); PG8_MMA(0, 1, At, B1); PG8_BAR; PG8_SCHED;
            PG8_LDA(At, 1, 1); PG8_STAGE(PG8_SB(1, 0), b3, voffB); PG8_STAGE(PG8_SB(1, 1), b3 + hstepB, voffB); PG8_STAGE(PG8_SA(1, 0), a3, wA0);
            PG8_WAIT_V(8); PG8_WAIT_L(0); PG8_BAR; PG8_MMA(1, 0, At, B0); PG8_MMA(1, 1, At, B1); PG8_BAR; PG8_SCHED;
            } else {
            PG8_LDB(B0, 0, 0); PG8_SCHED; PG8_LDA(At, 0, 0); PG8_STAGE(PG8_SA(1, 1), a1, vA1);
            PG8_WAIT_L(8); PG8_BAR; PG8_WAIT_L(0); PG8_MMA(0, 0, At, B0); PG8_BAR; PG8_SCHED;
            PG8_LDB(B1, 0, 1); PG8_STAGE(PG8_SB(0, 0), b2, voffB);
            PG8_BAR; PG8_WAIT_L(0); PG8_MMA(0, 1, At, B1); PG8_BAR;
            PG8_LDA(At, 0, 1); PG8_STAGE(PG8_SA(0, 0), a2, wA0);
            PG8_BAR; PG8_WAIT_L(0); PG8_MMA(1, 0, At, B0); PG8_BAR; PG8_SCHED;
            PG8_STAGE(PG8_SB(0, 1), b2 + hstepB, voffB);
            PG8_WAIT_V(6); PG8_BAR; PG8_MMA(1, 1, At, B1); PG8_BAR;
            PG8_LDB(B0, 1, 0); PG8_SCHED; PG8_LDA(At, 1, 0); PG8_STAGE(PG8_SA(0, 1), a2, wA1);
            PG8_WAIT_L(8); PG8_BAR; PG8_WAIT_L(0); PG8_MMA(0, 0, At, B0); PG8_BAR; PG8_SCHED;
            PG8_LDB(B1, 1, 1); PG8_STAGE(PG8_SB(1, 0), b3, voffB);
            PG8_BAR; PG8_WAIT_L(0); PG8_MMA(0, 1, At, B1); PG8_BAR;
            PG8_LDA(At, 1, 1); PG8_STAGE(PG8_SA(1, 0), a3, wA0);
            PG8_BAR; PG8_WAIT_L(0); PG8_MMA(1, 0, At, B0); PG8_BAR; PG8_SCHED;
            PG8_STAGE(PG8_SB(1, 1), b3 + hstepB, voffB);
            PG8_WAIT_V(6); PG8_BAR; PG8_MMA(1, 1, At, B1); PG8_BAR;
            }
        }
        if constexpr (ALIGN_EPI) { if (wr == 0) PG8_BAR; }
        if constexpr (!Epi::AFTER_DRAIN) { E(acc, cur, wr, wc, fr, fq); S.done(cur); }
        if (!has_next) break;
#pragma unroll
        for (int a = 0; a < 2; ++a)
#pragma unroll
            for (int b = 0; b < 2; ++b)
#pragma unroll
                for (int m = 0; m < 4; ++m)
#pragma unroll
                    for (int n = 0; n < 2; ++n) acc[a][b][m][n] = (f32x4){0.f, 0.f, 0.f, 0.f};
        cur = nxt; cA = nA; cB = nB; ++ui;
#pragma unroll
        for (int i = 0; i < 2; ++i) { vA0[i] = vA0n[i]; vA1[i] = vA1n[i]; }
        if constexpr (ALIGN_EPI) { if (wr == 1) PG8_BAR; }
    }
    PG8_WAIT_V(0);
    if constexpr (!ALIGN_EPI) { if (wr == 0) PG8_BAR; }
    PG8_BAR;
    if constexpr (Epi::AFTER_DRAIN) { E.fused(acc, cur, wr, wc, fr, fq, lds, wid, lane); S.done(cur); }
#undef PG8_ROWS
#undef PG8_SA
#undef PG8_SB
#undef PG8_STAGE
#undef PG8_LDA
#undef PG8_LDB
#undef PG8_MMA
#undef PG8_WAIT_V
#undef PG8_WAIT_L
#undef PG8_BAR
#undef PG8_SCHED
}
}

typedef unsigned short bf16;
typedef unsigned u32x4 __attribute__((ext_vector_type(4)));
typedef unsigned u32x2 __attribute__((ext_vector_type(2)));
typedef float f32x4 __attribute__((ext_vector_type(4)));
typedef float f32x2 __attribute__((ext_vector_type(2)));
typedef float f32x16 __attribute__((ext_vector_type(16)));
typedef short bf16x8 __attribute__((ext_vector_type(8)));
typedef short s16x4 __attribute__((ext_vector_type(4)));
#define LAS __attribute__((address_space(3)))

constexpr int NT = 512, NW = 8;
constexpr int T = 32768, D = 1024, SEQ = 2048, NB = 16;
constexpr int IN_COLS = 6944;
constexpr float EPS = 1e-6f;
constexpr float LOG2E = 1.4426950408889634f;
constexpr float SC_HD = 0.125f * LOG2E;
constexpr float SC_MLA = 0.10206207261596575f * LOG2E;
constexpr int XS_ROWS = 73728;

constexpr size_t MiB = 1u << 20;
constexpr size_t OFF_MOD = 64 * 1024, OFF_WRT = 1 * MiB, OFF_RE = 3 * MiB / 2, OFF_RG = 7 * MiB / 4, OFF_RD = 2 * MiB, OFF_BCNT = 9 * MiB / 4, OFF_LSE = 5 * MiB / 2;
constexpr size_t WS_WIN = 4 * MiB, WS_WUQ = 18 * MiB, WS_WUKV = WS_WUQ + 3 * MiB / 4, WS_WBM = WS_WUKV + MiB / 2, WS_WBD = WS_WBM + MiB, WS_WBW = WS_WBD + MiB / 2, WS_WOUT = WS_WBW + MiB;
constexpr size_t WS_W13 = 24 * MiB, WS_W2 = 72 * MiB;
constexpr size_t WS_XN = 96 * MiB, WS_CLAT = 160 * MiB, WS_QKV = 224 * MiB, WS_QM = 416 * MiB, WS_KVM = 464 * MiB, WS_END = 528 * MiB;
static_assert(WS_WOUT + 2 * MiB <= WS_W13, "weight map");
constexpr int LDS_BYTES = 163840, MISC_OFF = 147456;

struct Params {
    const float *x, *c; const int* pos;
    const float *w_ada, *b_ada, *g_norm1, *w_in, *g_cq, *w_uq, *g_ckv, *w_ukv, *g_q_mla, *g_k_mla, *g_q_dil, *g_k_dil, *g_q_win, *g_k_win, *sink_win;
    const float *w_br_mla, *w_br_dil, *w_br_win, *w_out, *g_norm2, *w_gr, *b_gr, *w_er, *b_er, *w1, *w3, *w2;
    float* out; unsigned char* ws;
};

typedef const __attribute__((address_space(4))) Params* KP;
__device__ __forceinline__ KP kparams() { KP k = (KP)__builtin_amdgcn_kernarg_segment_ptr(); asm volatile("" : "+s"(k)); return k; }
__device__ __forceinline__ int otid(int wv) { return (wv << 6) | pg8::hw_lane(); }
#define WAVE_IDS() const int tid = otid(wv), lane = tid & 63, wave = wv, gw = (int)blockIdx.x * NW + wave, NGW = (int)gridDim.x * NW; (void)gw; (void)NGW; (void)lane; (void)wave
__device__ __forceinline__ unsigned f2bf(float f) { unsigned u = __builtin_bit_cast(unsigned, f); return (u + 0x7fffu + ((u >> 16) & 1u)) >> 16; }
__device__ __forceinline__ unsigned pk2(float lo, float hi) { return pg8::cvt_pk_bf16(lo, hi); }
__device__ __forceinline__ float bflo(unsigned w) { return __uint_as_float(w << 16); }
__device__ __forceinline__ float bfhi(unsigned w) { return __uint_as_float(w & 0xffff0000u); }
__device__ __forceinline__ float shflx(float v, int m, int lane) { return __builtin_bit_cast(float, __builtin_amdgcn_ds_bpermute((lane ^ m) << 2, __builtin_bit_cast(int, v))); }
__device__ __forceinline__ float wave_sum(float v, int lane) {
#pragma unroll
    for (int o = 1; o < 64; o <<= 1) v += shflx(v, o, lane);
    return v;
}
__device__ __forceinline__ float sum8(float v, int lane) { v += shflx(v, 1, lane); v += shflx(v, 2, lane); v += shflx(v, 4, lane); return v; }
__device__ __forceinline__ void unpack8(const u32x4 w, float (&f)[8]) { f[0] = bflo(w.x); f[1] = bfhi(w.x); f[2] = bflo(w.y); f[3] = bfhi(w.y); f[4] = bflo(w.z); f[5] = bfhi(w.z); f[6] = bflo(w.w); f[7] = bfhi(w.w); }
__device__ __forceinline__ u32x4 pack8(const float (&f)[8]) { u32x4 w; w.x = pk2(f[0], f[1]); w.y = pk2(f[2], f[3]); w.z = pk2(f[4], f[5]); w.w = pk2(f[6], f[7]); return w; }
__device__ __forceinline__ float rope_inv_freq(int i, int half) { return __builtin_amdgcn_exp2f(-(float)i / (float)half * 13.287712379549449f); }

#define XB_TMO      128
#define XB_XCNT(j)  (256  + 64 * (j))
#define XB_XSUB(j)  (1280 + 64 * (j))
#define XB_XGEN(j)  (2304 + 64 * (j))
#define XB_TOP      3328
#define XB_TOPGEN   3392
#define XCD_BAR_WORDS 3456
#define XB_SPIN_CAP (1u << 18)

__device__ __forceinline__ unsigned xb_ld(unsigned* p)              { return __hip_atomic_load(p, __ATOMIC_RELAXED, __HIP_MEMORY_SCOPE_AGENT); }
__device__ __forceinline__ unsigned xb_add(unsigned* p, unsigned v) { return __hip_atomic_fetch_add(p, v, __ATOMIC_RELAXED, __HIP_MEMORY_SCOPE_AGENT); }
__device__ __forceinline__ unsigned xb_xcc_id() { return (unsigned)__builtin_amdgcn_s_getreg((3 << 11) | 20) & 0xFu; }
#define XB_SPIN(cond, bar) do { unsigned _sp = 0; while (cond) { __builtin_amdgcn_s_sleep(1); \
    if ((++_sp & 255u) == 0u) { if (xb_ld(&(bar)[XB_TMO])) break; if (_sp > XB_SPIN_CAP) { atomicAdd(&(bar)[XB_TMO], 1u); break; } } } } while (0)

struct XcdBarrier {
    int wv;
    unsigned* bar; unsigned x;
    volatile LAS unsigned* st;
};

__device__ __forceinline__ XcdBarrier xcd_barrier_post(unsigned* bar, volatile LAS unsigned* st, int wv) {
    XcdBarrier b; b.wv = wv; b.bar = bar; b.x = xb_xcc_id(); b.st = st;
    if (wv == 0 && pg8::hw_lane() == 0) (void)xb_add(&bar[XB_XCNT(b.x)], 1u);
    return b;
}
__device__ __forceinline__ void xcd_barrier_complete(unsigned* bar, unsigned x, unsigned& nloc, unsigned& nx) {
    const unsigned G = gridDim.x * gridDim.y * gridDim.z;
    unsigned sum, cnt, mine, sp = 0u;
    for (;;) {
        sum = 0u; cnt = 0u; mine = 0u;
#pragma unroll
        for (unsigned j = 0; j < 16; ++j) { const unsigned c = xb_ld(&bar[XB_XCNT(j)]); sum += c; cnt += (c > 0u) ? 1u : 0u; mine = (j == x) ? c : mine; }
        if (sum == G) break;
        __builtin_amdgcn_s_sleep(1);
        if ((++sp & 255u) == 0u) { if (xb_ld(&bar[XB_TMO])) break; if (sp > XB_SPIN_CAP) { atomicAdd(&bar[XB_TMO], 1u); break; } }
    }
    nloc = mine > 0u ? mine : 1u; nx = cnt > 0u ? cnt : 1u;
}

__device__ __forceinline__ void xcd_barrier(const XcdBarrier& b) {
    asm volatile("s_waitcnt vmcnt(0)" ::: "memory");
    __syncthreads();
    if (b.wv == 0 && pg8::hw_lane() == 0) {
        unsigned* bar = b.bar;
        __builtin_amdgcn_s_waitcnt(0);
        unsigned nloc = b.st[0], nx = b.st[1];
        if (nloc == 0u) { xcd_barrier_complete(bar, b.x, nloc, nx); b.st[0] = nloc; b.st[1] = nx; }
        const unsigned old = xb_add(&bar[XB_XSUB(b.x)], 1u);
        const unsigned gen = old / nloc;
        if (old + 1u == (gen + 1u) * nloc) {
            __builtin_amdgcn_fence(__ATOMIC_RELEASE, "agent");
            asm volatile("s_waitcnt vmcnt(0)" ::: "memory");
            const unsigned og = xb_add(&bar[XB_TOP], 1u);
            const unsigned tg = og / nx;
            if (og + 1u == (tg + 1u) * nx) xb_add(&bar[XB_TOPGEN], 1u);
            else XB_SPIN(xb_ld(&bar[XB_TOPGEN]) == tg, bar);
            __builtin_amdgcn_fence(__ATOMIC_ACQUIRE, "agent");
            xb_add(&bar[XB_XGEN(b.x)], 1u);
            asm volatile("s_waitcnt vmcnt(0)" ::: "memory");
        } else {
            XB_SPIN(xb_ld(&bar[XB_XGEN(b.x)]) == gen, bar);
            __builtin_amdgcn_fence(__ATOMIC_ACQUIRE, "agent");
            asm volatile("s_waitcnt vmcnt(0)" ::: "memory");
        }
    }
    __syncthreads();
}


__device__ __forceinline__ void phase_mod(KP p, LAS unsigned char* lds, int wv) {
    LAS float* cond = (LAS float*)lds;
    LAS float* red = (LAS float*)(lds + 65536);
    const int tid = otid(wv);
    float* mod = (float*)(p->ws + OFF_MOD);
    if ((int)blockIdx.x < 192) {
        for (int i = tid; i < NB * D; i += NT) { const float v = p->c[i]; cond[i] = v / (1.0f + __expf(-v)); }
        __syncthreads();
        for (int u = blockIdx.x; u < 192; u += gridDim.x) {
            const int l = u / 96, n0 = (u % 96) * 64, col = tid & 63, ks = wv;
            float acc[NB];
#pragma unroll
            for (int b = 0; b < NB; ++b) acc[b] = 0.f;
            const float* w = p->w_ada + (size_t)l * D * 6144 + n0;
#pragma unroll 1
            for (int k = ks * 128; k < ks * 128 + 128; k += 16) { float wr[16]; int kl = k; asm volatile("" : "+v"(kl));
#pragma unroll
                for (int i = 0; i < 16; ++i) { const float* wk = w + (size_t)(k + i) * 6144; wr[i] = wk[col]; }
#pragma unroll
                for (int i = 0; i < 16; i += 4) {
#pragma unroll
                    for (int b = 0; b < NB; ++b) { const f32x4 c4 = *(const LAS f32x4*)(cond + b * D + kl + i); acc[b] += (c4.x * wr[i] + c4.y * wr[i + 1]) + (c4.z * wr[i + 2] + c4.w * wr[i + 3]); } } }
#pragma unroll
            for (int b = 0; b < NB; ++b) red[(ks * NB + b) * 64 + col] = acc[b];
            __syncthreads();
            for (int i = tid; i < NB * 64; i += NT) { const int b = i >> 6, cc = i & 63; float s = 0.f;
#pragma unroll
                for (int k8 = 0; k8 < 8; ++k8) s += red[(k8 * NB + b) * 64 + cc];
                mod[(size_t)(l * NB + b) * 6144 + n0 + cc] = s + p->b_ada[l * 6144 + n0 + cc]; }
            __syncthreads();
        }
    }
}
struct CItem { const float* W; int ldw, k0, n0; bf16* WT; int ldt, drow; const float* gk; };
__device__ __forceinline__ CItem conv_decode(KP p, int l, unsigned char* ws, int it) {
    constexpr int I_IN = 16 * 217, I_UQ = 8 * 24, I_UKV = 4 * 32, I_BM = 8 * 32, I_BD = 4 * 32, I_BW = 8 * 32, I_OUT = 16 * 32, I_E1 = 32 * 16 * 12;
    CItem c; c.gk = nullptr; int r = it;
    if (r < I_IN) { const int kb = r / 217, nb = r % 217, n0 = nb * 32; int drow; if (n0 < 800) drow = 3072 + n0; else if (n0 < 3872) { const int c0 = n0 - 800, hq = c0 >> 6, dh = (c0 >> 5) & 1; drow = 256 * (hq >> 2) + 128 * dh + 32 * (hq & 3); } else drow = 4096 + n0 - 3872;
        c.W = p->w_in + (size_t)l * D * IN_COLS; c.ldw = IN_COLS; c.k0 = kb * 64; c.n0 = n0; c.WT = (bf16*)(ws + WS_WIN); c.ldt = 1024; c.drow = drow; return c; } r -= I_IN;
    if (r < I_UQ) { const int nb = r % 24, h = nb / 3, part = nb % 3;
        c.W = p->w_uq + (size_t)l * 512 * 768; c.ldw = 768; c.k0 = (r / 24) * 64; c.n0 = nb * 32; c.WT = (bf16*)(ws + WS_WUQ); c.ldt = 512; c.gk = p->g_cq + l * 512;
        c.drow = part < 2 ? 256 * (h >> 2) + 128 * part + 32 * (h & 3) : 512 + 128 * (h & 1) + 32 * (h >> 1); return c; } r -= I_UQ;
    if (r < I_UKV) { const int nb = r % 32, h16 = nb >> 1, dh = nb & 1;
        c.W = p->w_ukv + (size_t)l * 256 * 1024; c.ldw = 1024; c.k0 = (r / 32) * 64; c.n0 = nb * 32; c.WT = (bf16*)(ws + WS_WUKV); c.ldt = 256; c.gk = p->g_ckv + l * 256; c.drow = 256 * (h16 >> 2) + 128 * dh + 32 * (h16 & 3); return c; } r -= I_UKV;
    if (r < I_BM) { c.W = p->w_br_mla + (size_t)l * 512 * 1024; c.ldw = 1024; c.k0 = (r / 32) * 64; c.n0 = (r % 32) * 32; c.WT = (bf16*)(ws + WS_WBM); c.ldt = 512; c.drow = c.n0; return c; } r -= I_BM;
    if (r < I_BD) { c.W = p->w_br_dil + (size_t)l * 256 * 1024; c.ldw = 1024; c.k0 = (r / 32) * 64; c.n0 = (r % 32) * 32; c.WT = (bf16*)(ws + WS_WBD); c.ldt = 256; c.drow = c.n0; return c; } r -= I_BD;
    if (r < I_BW) { c.W = p->w_br_win + (size_t)l * 512 * 1024; c.ldw = 1024; c.k0 = (r / 32) * 64; c.n0 = (r % 32) * 32; c.WT = (bf16*)(ws + WS_WBW); c.ldt = 512; c.drow = c.n0; return c; } r -= I_BW;
    if (r < I_OUT) { c.W = p->w_out + (size_t)l * 1024 * 1024; c.ldw = 1024; c.k0 = (r / 32) * 64; c.n0 = (r % 32) * 32; c.WT = (bf16*)(ws + WS_WOUT); c.ldt = 1024; c.drow = c.n0; return c; } r -= I_OUT;
    if (r < 2 * I_E1) { const int which = r / I_E1; r -= which * I_E1; const int e = r / 192, q = r % 192, kb = q / 12, nb = q % 12, n0 = nb * 32;
        c.W = (which ? p->w3 : p->w1) + ((size_t)l * 32 + e) * 1024 * 384; c.ldw = 384; c.k0 = kb * 64; c.n0 = n0; c.WT = (bf16*)(ws + WS_W13); c.ldt = 1024; c.drow = e * 768 + 256 * (n0 >> 7) + which * 128 + (n0 & 127); return c; } r -= 2 * I_E1;
    { const int e = r / 192, q = r % 192, kb = q / 32, nb = q % 32;
      c.W = p->w2 + ((size_t)l * 32 + e) * 384 * 1024; c.ldw = 1024; c.k0 = kb * 64; c.n0 = nb * 32; c.WT = (bf16*)(ws + WS_W2); c.ldt = 384; c.drow = e * 1024 + nb * 32; return c; }
}
__device__ __forceinline__ void conv_load(const CItem& c, int lane, float (&wv)[32]) {
#pragma unroll
    for (int i = 0; i < 32; ++i) wv[i] = c.W[(size_t)(c.k0 + 2 * i + (lane >> 5)) * c.ldw + c.n0 + (lane & 31)];
}
__device__ __forceinline__ void conv_finish(const CItem& c, float (&wv)[32], LAS float* scr, int lane) {
    if (c.gk) {
#pragma unroll
        for (int i = 0; i < 32; ++i) wv[i] *= c.gk[c.k0 + 2 * i + (lane >> 5)]; }
#pragma unroll
    for (int i = 0; i < 32; ++i) scr[(2 * i + (lane >> 5)) * 33 + (lane & 31)] = wv[i];
    asm volatile("s_waitcnt lgkmcnt(0)" ::: "memory");
    const int cidx = lane & 7;
#pragma unroll
    for (int j = 0; j < 4; ++j) { const int n = (lane >> 3) + 8 * j; const LAS float* s = scr + (8 * cidx) * 33 + n;
        u32x4 o; o.x = pk2(s[0 * 33], s[1 * 33]); o.y = pk2(s[2 * 33], s[3 * 33]); o.z = pk2(s[4 * 33], s[5 * 33]); o.w = pk2(s[6 * 33], s[7 * 33]);
        *(u32x4*)(c.WT + (size_t)(c.drow + n) * c.ldt + c.k0 + 8 * cidx) = o; }
    asm volatile("s_waitcnt lgkmcnt(0)" ::: "memory");
}
constexpr int CONV_NONMOE = 16 * 217 + 8 * 24 + 4 * 32;
__device__ __forceinline__ void phase_convert(KP p, int l, LAS unsigned char* lds, int wv, const bool moe, const int cgw = -1, const int cngw = 0) {
    WAVE_IDS();
    const int GW = cgw < 0 ? gw : cgw, NG = cgw < 0 ? NGW : cngw;
    LAS float* scr = (LAS float*)(lds + wave * 16384);
    unsigned char* ws = p->ws;
    constexpr int NITEMS = 16 * 217 + 8 * 24 + 4 * 32 + 8 * 32 + 4 * 32 + 8 * 32 + 16 * 32 + 2 * 32 * 16 * 12 + 32 * 6 * 32;
    const int IT1 = moe ? NITEMS : CONV_NONMOE;
    int it = (moe ? CONV_NONMOE : 0) + GW; float va[32], vb[32]; CItem ca, cb;
    if (it < IT1) { ca = conv_decode(p, l, ws, it); conv_load(ca, lane, va); }
    while (it < IT1) {
        const int itb = it + NG; if (itb < IT1) { cb = conv_decode(p, l, ws, itb); conv_load(cb, lane, vb); }
        conv_finish(ca, va, scr, lane);
        if (itb >= IT1) break;
        const int ita = itb + NG; if (ita < IT1) { ca = conv_decode(p, l, ws, ita); conv_load(ca, lane, va); }
        conv_finish(cb, vb, scr, lane);
        it = ita;
    }
    if (moe) return;
    { u32x4* z = (u32x4*)((bf16*)(ws + WS_WIN) + (size_t)3872 * 1024); const u32x4 zero = {0u, 0u, 0u, 0u};
      for (int i = GW * 64 + lane; i < 224 * 128; i += NG * 64) z[i] = zero; }
    { float* wrt = (float*)(ws + OFF_WRT) + (size_t)l * 36 * 1024;
      for (int i = GW * 64 + lane; i < 36 * 1024; i += NG * 64) { const int j = i >> 10, k = i & 1023;
          wrt[i] = j < 4 ? p->w_gr[((size_t)l * 1024 + k) * 4 + j] : p->w_er[((size_t)l * 1024 + k) * 32 + (j - 4)]; } }
}

__device__ __forceinline__ void norm_row(const float* xrow, bf16* orow, const float* g, const float* sh, const float* sc, int lane) {
    f32x4 v[4]; float ss = 0.f;
#pragma unroll
    for (int j = 0; j < 4; ++j) { v[j] = *(const f32x4*)(xrow + 4 * lane + 256 * j); ss += (v[j].x * v[j].x + v[j].y * v[j].y) + (v[j].z * v[j].z + v[j].w * v[j].w); }
    const float rstd = __builtin_amdgcn_rsqf(wave_sum(ss, lane) * (1.0f / D) + EPS);
#pragma unroll
    for (int j = 0; j < 4; ++j) { const int cidx = 4 * lane + 256 * j; const f32x4 gg = *(const f32x4*)(g + cidx), s1 = *(const f32x4*)(sc + cidx), s0 = *(const f32x4*)(sh + cidx);
        const f32x4 y = v[j] * rstd * gg * (s1 + 1.0f) + s0;
        u32x2 o; o.x = pk2(y.x, y.y); o.y = pk2(y.z, y.w); *(u32x2*)(orow + cidx) = o; }
}
__device__ __forceinline__ void norm_row2(const float* xa, bf16* oa, const float* xb, bf16* ob, const float* g, const float* moda, const float* modb, int lane) {
    f32x4 va[4], vb[4]; float sa = 0.f, sb = 0.f;
#pragma unroll
    for (int j = 0; j < 4; ++j) { va[j] = *(const f32x4*)(xa + 4 * lane + 256 * j); vb[j] = *(const f32x4*)(xb + 4 * lane + 256 * j); }
#pragma unroll
    for (int j = 0; j < 4; ++j) { sa += (va[j].x * va[j].x + va[j].y * va[j].y) + (va[j].z * va[j].z + va[j].w * va[j].w); sb += (vb[j].x * vb[j].x + vb[j].y * vb[j].y) + (vb[j].z * vb[j].z + vb[j].w * vb[j].w); }
    const float ra = __builtin_amdgcn_rsqf(wave_sum(sa, lane) * (1.0f / D) + EPS), rb = __builtin_amdgcn_rsqf(wave_sum(sb, lane) * (1.0f / D) + EPS);
    f32x4 gg[4], s1a[4], s0a[4], s1b[4], s0b[4];
#pragma unroll
    for (int j = 0; j < 4; ++j) { const int cidx = 4 * lane + 256 * j; gg[j] = *(const f32x4*)(g + cidx); s1a[j] = *(const f32x4*)(moda + 1024 + cidx); s0a[j] = *(const f32x4*)(moda + cidx); s1b[j] = *(const f32x4*)(modb + 1024 + cidx); s0b[j] = *(const f32x4*)(modb + cidx); }
#pragma unroll
    for (int j = 0; j < 4; ++j) { const int cidx = 4 * lane + 256 * j;
        { const f32x4 y = va[j] * ra * gg[j] * (s1a[j] + 1.0f) + s0a[j]; u32x2 o; o.x = pk2(y.x, y.y); o.y = pk2(y.z, y.w); *(u32x2*)(oa + cidx) = o; }
        { const f32x4 y = vb[j] * rb * gg[j] * (s1b[j] + 1.0f) + s0b[j]; u32x2 o; o.x = pk2(y.x, y.y); o.y = pk2(y.z, y.w); *(u32x2*)(ob + cidx) = o; } }
}
__device__ __forceinline__ void phase_norm1(KP p, int l, const float* xin, int wv) {
    WAVE_IDS();
    const float* mod = (const float*)(p->ws + OFF_MOD) + (size_t)l * NB * 6144;
    bf16* XN = (bf16*)(p->ws + WS_XN);
    for (int m = gw; m < T; m += 2 * NGW) {
        const int m1 = m + NGW;
        norm_row2(xin + (size_t)m * D, XN + (size_t)m * D, xin + (size_t)m1 * D, XN + (size_t)m1 * D, p->g_norm1 + l * D, mod + (m >> 11) * 6144, mod + (m1 >> 11) * 6144, lane); }
}
__device__ __forceinline__ void phase_norms_a(KP p, int l, int wv) {
    WAVE_IDS();
    bf16* CLAT = (bf16*)(p->ws + WS_CLAT); bf16* QKV = (bf16*)(p->ws + WS_QKV);
    for (int m = gw; m < T; m += NGW) {
        bf16* cl = CLAT + (size_t)m * 1024; bf16* qk = QKV + (size_t)m * 3072;
        const int pos = p->pos[m];
        const u32x4 wq = *(const u32x4*)(cl + 8 * lane);
        const u32x2 wkv = *(const u32x2*)(cl + 512 + 4 * lane);
        const bf16 wr = lane < 32 ? cl[768 + lane] : (bf16)0;
        u32x4 wd[3];
#pragma unroll
        for (int it = 0; it < 3; ++it) wd[it] = *(const u32x4*)(qk + it * 512 + 8 * lane);
        const u32x4 ww0 = *(const u32x4*)(qk + 2304 + 8 * lane);
        u32x4 ww1 = {0u, 0u, 0u, 0u}; if (lane < 16) ww1 = *(const u32x4*)(qk + 2816 + 8 * lane);
        { float f[8]; unpack8(wq, f); float ss = 0.f;
#pragma unroll
          for (int i = 0; i < 8; ++i) ss += f[i] * f[i];
          const float rstd = __builtin_amdgcn_rsqf(wave_sum(ss, lane) * (1.0f / 512) + EPS); const float* g = p->g_cq + l * 512 + 8 * lane;
#pragma unroll
          for (int i = 0; i < 8; ++i) f[i] *= rstd * g[i];
          *(u32x4*)(cl + 8 * lane) = pack8(f); }
        { float f0 = bflo(wkv.x), f1 = bfhi(wkv.x), f2 = bflo(wkv.y), f3 = bfhi(wkv.y);
          const float rstd = __builtin_amdgcn_rsqf(wave_sum(f0 * f0 + f1 * f1 + f2 * f2 + f3 * f3, lane) * (1.0f / 256) + EPS); const float* g = p->g_ckv + l * 256 + 4 * lane;
          u32x2 o; o.x = pk2(f0 * rstd * g[0], f1 * rstd * g[1]); o.y = pk2(f2 * rstd * g[2], f3 * rstd * g[3]); *(u32x2*)(cl + 512 + 4 * lane) = o; }
        { const float v = __uint_as_float((unsigned)wr << 16);
          const float rstd = __builtin_amdgcn_rsqf(wave_sum(v * v, lane) * (1.0f / 32) + EPS);
          const float vn = v * rstd * p->g_k_mla[l * 96 + 64 + (lane & 31)];
          const float pr = shflx(vn, 16, lane);
          const float ang = (float)pos * rope_inv_freq(lane & 15, 16); float sn, cs; sincosf(ang, &sn, &cs);
          const float o = (lane & 16) ? (pr * sn + vn * cs) : (vn * cs - pr * sn);
          if (lane < 32) cl[768 + lane] = (bf16)f2bf(o); }
#pragma unroll
        for (int it = 0; it < 3; ++it) { const int col0 = it * 512 + 8 * lane; const bool isq = col0 < 768; const int d0 = col0 & 63;
            float f[8]; unpack8(wd[it], f); float ss = 0.f;
#pragma unroll
            for (int i = 0; i < 8; ++i) ss += f[i] * f[i];
            const float rstd = __builtin_amdgcn_rsqf(sum8(ss, lane) * (1.0f / 64) + EPS) * (isq ? SC_HD : 1.0f);
            const float* g = (isq ? p->g_q_dil : p->g_k_dil) + l * 64 + d0;
#pragma unroll
            for (int i = 0; i < 8; ++i) f[i] *= rstd * g[i];
            *(u32x4*)(qk + col0) = pack8(f); }
        { float f[8]; unpack8(ww0, f); float ss = 0.f;
#pragma unroll
          for (int i = 0; i < 8; ++i) ss += f[i] * f[i];
          const float rstd = __builtin_amdgcn_rsqf(sum8(ss, lane) * (1.0f / 64) + EPS) * SC_HD; const float* g = p->g_q_win + l * 64 + ((8 * lane) & 63);
#pragma unroll
          for (int i = 0; i < 8; ++i) f[i] *= rstd * g[i];
          *(u32x4*)(qk + 2304 + 8 * lane) = pack8(f); }
        { float f[8]; unpack8(ww1, f); float ss = 0.f;
#pragma unroll
          for (int i = 0; i < 8; ++i) ss += f[i] * f[i];
          const float rstd = __builtin_amdgcn_rsqf(sum8(ss, lane) * (1.0f / 64) + EPS); const float* g = p->g_k_win + l * 64 + ((8 * lane) & 63);
#pragma unroll
          for (int i = 0; i < 8; ++i) f[i] *= rstd * g[i];
          if (lane < 16) *(u32x4*)(qk + 2816 + 8 * lane) = pack8(f); }
    }
}
__device__ __forceinline__ void phase_norms_b(KP p, int l, int wv) {
    WAVE_IDS();
    bf16* QM = (bf16*)(p->ws + WS_QM); bf16* KVM = (bf16*)(p->ws + WS_KVM);
    const int h = lane >> 3, j = lane & 7;
    for (int m = gw; m < T; m += NGW) {
        bf16* qn = QM + (size_t)m * 768 + h * 96 + 8 * j; bf16* qr = QM + (size_t)m * 768 + h * 96 + 64 + 4 * j; bf16* kn = KVM + (size_t)m * 1024 + h * 128 + 8 * j;
        const int pos = p->pos[m];
        const u32x4 wn = *(const u32x4*)qn; const u32x2 wr = *(const u32x2*)qr; const u32x4 wk = *(const u32x4*)kn;
        { float f[8]; unpack8(wn, f); float ss = 0.f;
#pragma unroll
          for (int i = 0; i < 8; ++i) ss += f[i] * f[i];
          const float rstd = __builtin_amdgcn_rsqf(sum8(ss, lane) * (1.0f / 64) + EPS) * SC_MLA; const float* g = p->g_q_mla + l * 96 + 8 * j;
#pragma unroll
          for (int i = 0; i < 8; ++i) f[i] *= rstd * g[i];
          *(u32x4*)qn = pack8(f); }
        { float f[4] = {bflo(wr.x), bfhi(wr.x), bflo(wr.y), bfhi(wr.y)};
          const float rstd = __builtin_amdgcn_rsqf(sum8(f[0] * f[0] + f[1] * f[1] + f[2] * f[2] + f[3] * f[3], lane) * (1.0f / 32) + EPS); const float* g = p->g_q_mla + l * 96 + 64 + 4 * j;
          float o[4];
#pragma unroll
          for (int e = 0; e < 4; ++e) { const float vn = f[e] * rstd * g[e]; const float pr = shflx(vn, 4, lane);
              const float ang = (float)pos * rope_inv_freq(4 * (j & 3) + e, 16); float sn, cs; sincosf(ang, &sn, &cs);
              o[e] = ((j & 4) ? (pr * sn + vn * cs) : (vn * cs - pr * sn)) * SC_MLA; }
          u32x2 w; w.x = pk2(o[0], o[1]); w.y = pk2(o[2], o[3]); *(u32x2*)qr = w; }
        { float f[8]; unpack8(wk, f); float ss = 0.f;
#pragma unroll
          for (int i = 0; i < 8; ++i) ss += f[i] * f[i];
          const float rstd = __builtin_amdgcn_rsqf(sum8(ss, lane) * (1.0f / 64) + EPS); const float* g = p->g_k_mla + l * 96 + 8 * j;
#pragma unroll
          for (int i = 0; i < 8; ++i) f[i] *= rstd * g[i];
          *(u32x4*)kn = pack8(f); }
    }
}
__device__ __forceinline__ int crow(int r, int hi) { return (r & 3) + 8 * (r >> 2) + 4 * hi; }
__device__ __forceinline__ s16x4 vtr(const LAS unsigned char* ptr) { return __builtin_bit_cast(s16x4, __builtin_amdgcn_ds_read_tr16_b64_v4i16((LAS s16x4*)ptr)); }
__device__ __forceinline__ unsigned cvtpk(float lo, float hi) { return pg8::cvt_pk_bf16(lo, hi); }

__device__ __forceinline__ float fmax2(float a, float b) { return __builtin_amdgcn_fmed3f(a, b, INFINITY); }
__device__ __forceinline__ float max3f(float a, float b, float c) { float r; asm("v_max3_f32 %0, %1, %2, %3" : "=v"(r) : "v"(a), "v"(b), "v"(c)); return r; }
constexpr float SM_THR = 8.0f;
template <bool MFMA_DIRECT>
__device__ __forceinline__ void softmax_tile(f32x16& s0, f32x16& s1, float& m_run, float& l_run, bool& seen, f32x16& negm, f32x16 (&o)[2], bf16x8 (&pb)[4], int lane) {
    if (MFMA_DIRECT) asm volatile("s_nop 15\n\ts_nop 7" : "+v"(s0), "+v"(s1));
    float ma = max3f(s0[0], s0[1], s1[0]), mb = max3f(s0[2], s0[3], s1[1]); ma = max3f(ma, s1[2], s1[3]);
#pragma unroll
    for (int r = 4; r < 16; r += 4) { ma = max3f(ma, s0[r], s0[r + 1]); mb = max3f(mb, s0[r + 2], s0[r + 3]); ma = max3f(ma, s1[r], s1[r + 1]); mb = max3f(mb, s1[r + 2], s1[r + 3]); }
    const float mh_ = max3f(ma, mb, mb);
    const auto rr_ = __builtin_amdgcn_permlane32_swap(__float_as_uint(mh_), __float_as_uint(mh_), false, false);
    float mx = max3f(__uint_as_float(rr_[0]), __uint_as_float(rr_[1]), mh_);
    const bool has = mx > -INFINITY;
    const bool need = seen ? (mx > SM_THR) : has;
    if (__any(need)) {
        const float delta = seen ? fmax2(mx, 0.f) : (has ? mx : 0.f);
        const float alpha = seen ? __builtin_amdgcn_exp2f(-delta) : 1.0f;
        m_run += delta; l_run *= alpha;
#pragma unroll
        for (int r = 0; r < 16; ++r) { s0[r] -= delta; s1[r] -= delta; o[0][r] *= alpha; o[1][r] *= alpha; negm[r] = -m_run; }
    }
    seen = seen || has;
    float rs0 = 0.f, rs1 = 0.f, rs2 = 0.f, rs3 = 0.f;
#pragma unroll
    for (int r = 0; r < 16; ++r) { s0[r] = __builtin_amdgcn_exp2f(s0[r]); s1[r] = __builtin_amdgcn_exp2f(s1[r]); }
#pragma unroll
    for (int r = 0; r < 16; r += 2) { rs0 += s0[r]; rs1 += s0[r + 1]; rs2 += s1[r]; rs3 += s1[r + 1]; }
    l_run += (rs0 + rs1) + (rs2 + rs3);
#pragma unroll
    for (int ks = 0; ks < 4; ++ks) { u32x4 w;
        if (ks < 2) { const int b = 8 * ks; w.x = cvtpk(s0[b], s0[b + 1]); w.y = cvtpk(s0[b + 2], s0[b + 3]); w.z = cvtpk(s0[b + 4], s0[b + 5]); w.w = cvtpk(s0[b + 6], s0[b + 7]); }
        else { const int b = 8 * (ks - 2); w.x = cvtpk(s1[b], s1[b + 1]); w.y = cvtpk(s1[b + 2], s1[b + 3]); w.z = cvtpk(s1[b + 4], s1[b + 5]); w.w = cvtpk(s1[b + 6], s1[b + 7]); }
        pb[ks] = __builtin_bit_cast(bf16x8, w); }
}
template <bool MFMA_DIRECT>
__device__ __forceinline__ void softmax_tile4(f32x16& s0, f32x16& s1, f32x16& s2, f32x16& s3, float& m_run, float& l_run, bool& seen, f32x16& negm, f32x16 (&o)[2], bf16x8 (&pa)[4], bf16x8 (&pb)[4], int lane) {
    if (MFMA_DIRECT) asm volatile("s_nop 15\n\ts_nop 7" : "+v"(s0), "+v"(s1), "+v"(s2), "+v"(s3));
    float ma = max3f(s0[0], s0[1], s1[0]), mb = max3f(s0[2], s0[3], s1[1]); ma = max3f(ma, s1[2], s1[3]);
#pragma unroll
    for (int r = 4; r < 16; r += 4) { ma = max3f(ma, s0[r], s0[r + 1]); mb = max3f(mb, s0[r + 2], s0[r + 3]); ma = max3f(ma, s1[r], s1[r + 1]); mb = max3f(mb, s1[r + 2], s1[r + 3]); }
#pragma unroll
    for (int r = 0; r < 16; r += 4) { ma = max3f(ma, s2[r], s2[r + 1]); mb = max3f(mb, s2[r + 2], s2[r + 3]); ma = max3f(ma, s3[r], s3[r + 1]); mb = max3f(mb, s3[r + 2], s3[r + 3]); }
    const float mh_ = max3f(ma, mb, mb);
    const auto rr_ = __builtin_amdgcn_permlane32_swap(__float_as_uint(mh_), __float_as_uint(mh_), false, false);
    float mx = max3f(__uint_as_float(rr_[0]), __uint_as_float(rr_[1]), mh_);
    const bool has = mx > -INFINITY;
    const bool need = seen ? (mx > SM_THR) : has;
    if (__any(need)) {
        const float delta = seen ? fmax2(mx, 0.f) : (has ? mx : 0.f);
        const float alpha = seen ? __builtin_amdgcn_exp2f(-delta) : 1.0f;
        m_run += delta; l_run *= alpha;
#pragma unroll
        for (int r = 0; r < 16; ++r) { s0[r] -= delta; s1[r] -= delta; s2[r] -= delta; s3[r] -= delta; o[0][r] *= alpha; o[1][r] *= alpha; negm[r] = -m_run; }
    }
    seen = seen || has;
    float rs0 = 0.f, rs1 = 0.f, rs2 = 0.f, rs3 = 0.f;
#pragma unroll
    for (int r = 0; r < 16; ++r) { s0[r] = __builtin_amdgcn_exp2f(s0[r]); s1[r] = __builtin_amdgcn_exp2f(s1[r]); s2[r] = __builtin_amdgcn_exp2f(s2[r]); s3[r] = __builtin_amdgcn_exp2f(s3[r]); }
#pragma unroll
    for (int r = 0; r < 16; ++r) { rs0 += s0[r]; rs1 += s1[r]; rs2 += s2[r]; rs3 += s3[r]; }
    l_run += (rs0 + rs1) + (rs2 + rs3);
#pragma unroll
    for (int ks = 0; ks < 4; ++ks) { u32x4 w, v;
        if (ks < 2) { const int b = 8 * ks; w.x = cvtpk(s0[b], s0[b + 1]); w.y = cvtpk(s0[b + 2], s0[b + 3]); w.z = cvtpk(s0[b + 4], s0[b + 5]); w.w = cvtpk(s0[b + 6], s0[b + 7]);
                                            v.x = cvtpk(s2[b], s2[b + 1]); v.y = cvtpk(s2[b + 2], s2[b + 3]); v.z = cvtpk(s2[b + 4], s2[b + 5]); v.w = cvtpk(s2[b + 6], s2[b + 7]); }
        else { const int b = 8 * (ks - 2); w.x = cvtpk(s1[b], s1[b + 1]); w.y = cvtpk(s1[b + 2], s1[b + 3]); w.z = cvtpk(s1[b + 4], s1[b + 5]); w.w = cvtpk(s1[b + 6], s1[b + 7]);
                                            v.x = cvtpk(s3[b], s3[b + 1]); v.y = cvtpk(s3[b + 2], s3[b + 3]); v.z = cvtpk(s3[b + 4], s3[b + 5]); v.w = cvtpk(s3[b + 6], s3[b + 7]); }
        pa[ks] = __builtin_bit_cast(bf16x8, w); pb[ks] = __builtin_bit_cast(bf16x8, v); }
}
__device__ __forceinline__ void pv_tile(f32x16 (&o)[2], const LAS unsigned char* vt, int vlane, const bf16x8 (&pb)[4]) {
#pragma unroll
    for (int d0 = 0; d0 < 2; ++d0) { const LAS unsigned char* vb = vt + (d0 ? (vlane ^ 64) : vlane);
#pragma unroll
        for (int ks = 0; ks < 4; ++ks) { const s16x4 lo = vtr(vb + ks * 2048), hi4 = vtr(vb + ks * 2048 + 1024);
            const bf16x8 vf = {lo[0], lo[1], lo[2], lo[3], hi4[0], hi4[1], hi4[2], hi4[3]};
            o[d0] = __builtin_amdgcn_mfma_f32_32x32x16_bf16(vf, pb[ks], o[d0], 0, 0, 0); } }
}
__device__ __forceinline__ void store_o(bf16* orow, const f32x16 (&o)[2], float inv, int hi) {
#pragma unroll
    for (int d0 = 0; d0 < 2; ++d0)
#pragma unroll
        for (int gq = 0; gq < 4; ++gq) { u32x2 w; w.x = pk2(o[d0][4 * gq] * inv, o[d0][4 * gq + 1] * inv); w.y = pk2(o[d0][4 * gq + 2] * inv, o[d0][4 * gq + 3] * inv);
            *(u32x2*)(orow + 32 * d0 + 8 * gq + 4 * hi) = w; }
}

constexpr int MLA_KP = 208;
constexpr int MLA_SK = 128 * MLA_KP, MLA_STAGE = MLA_SK + 128 * 128;
__device__ __forceinline__ void mla_unit(KP p, int b, int h, int qb, LAS unsigned char* lds, int wv) {
    const int tid = otid(wv), lane = tid & 63, wid = tid >> 6, r32 = lane & 31, hi = lane >> 5;
    const bf16* QM = (const bf16*)(p->ws + WS_QM); const bf16* KVM = (const bf16*)(p->ws + WS_KVM); bf16* CLAT = (bf16*)(p->ws + WS_CLAT);
    const size_t row0 = (size_t)b * SEQ;
    const size_t qtok = row0 + qb * 256 + wid * 32 + r32;
    bf16x8 qf[6];
#pragma unroll
    for (int s = 0; s < 6; ++s) qf[s] = *(const bf16x8*)(QM + qtok * 768 + h * 96 + 16 * s + 8 * hi);
    const int skey = tid >> 3, sch = tid & 7, rkey = tid >> 2, rch = tid & 3;
    const bf16* gkn = KVM + (row0 + skey) * 1024 + h * 128 + 8 * sch;
    const bf16* gkr = CLAT + (row0 + rkey) * 1024 + 768 + 8 * rch;
    const int lkn = skey * MLA_KP + 16 * sch, lkr = rkey * MLA_KP + 128 + 16 * rch, lv = MLA_SK + skey * 128 + ((sch ^ (((skey >> 1) & 1) << 2)) * 16);
    const int q4 = (lane & 15) >> 2, p4 = lane & 3, G1 = (lane >> 4) & 1;
    const int vlane = (4 * hi + q4) * 128 + (4 * ((q4 >> 1) & 1) + 2 * G1 + (p4 >> 1)) * 16 + 8 * (p4 & 1);
    const int klane = r32 * MLA_KP + 16 * hi;
    f32x16 o[2]; o[0] = f32x16{}; o[1] = f32x16{};
    float m_run = 0.f, l_run = 0.f; bool seen = false; f32x16 negm = f32x16{};
    u32x4 rk0, rk1, rv0, rv1, rkr;
#define MLA_LOAD(t) do { const size_t adv = (size_t)(t) * 128 * 1024; rk0 = *(const u32x4*)(gkn + adv); rk1 = *(const u32x4*)(gkn + adv + 64 * 1024); rv0 = *(const u32x4*)(gkn + adv + 64); rv1 = *(const u32x4*)(gkn + adv + 64 * 1024 + 64); rkr = *(const u32x4*)(gkr + adv); } while (0)
#define MLA_WRITE(buf) do { LAS unsigned char* B_ = lds + (buf) * MLA_STAGE; *(LAS u32x4*)(B_ + lkn) = rk0; *(LAS u32x4*)(B_ + lkn + 64 * MLA_KP) = rk1; *(LAS u32x4*)(B_ + lv) = rv0; *(LAS u32x4*)(B_ + lv + 64 * 128) = rv1; *(LAS u32x4*)(B_ + lkr) = rkr; } while (0)
    const bool grpB = wv >= 4;
#define PP_BAR() do { __builtin_amdgcn_sched_barrier(0); __syncthreads(); __builtin_amdgcn_sched_barrier(0); } while (0)
    MLA_LOAD(0); MLA_WRITE(0); MLA_LOAD(1);
    constexpr int NS = SEQ / 128;
    PP_BAR();
    if (grpB) PP_BAR();
    bf16x8 pa[4] = {}, pb[4] = {};
    int bc = 0, bn = 1, bp = 2;
    for (int t = 0; t < NS; ++t) {
        __builtin_amdgcn_s_setprio(1);
        if (t + 1 < NS) MLA_WRITE(bn);
        if (t + 2 < NS) MLA_LOAD(t + 2);
        const LAS unsigned char* Kb = lds + bc * MLA_STAGE; const LAS unsigned char* Vp = lds + bp * MLA_STAGE + MLA_SK;
        if (t > 0) { pv_tile(o, Vp, vlane, pa); pv_tile(o, Vp + 64 * 128, vlane, pb); }
        f32x16 s0 = negm, s1 = negm, s2 = negm, s3 = negm;
#pragma unroll
        for (int s = 0; s < 6; ++s) { const bf16x8 a0 = *(const LAS bf16x8*)(Kb + klane + 32 * s), a1 = *(const LAS bf16x8*)(Kb + klane + 32 * MLA_KP + 32 * s);
            const bf16x8 a2 = *(const LAS bf16x8*)(Kb + klane + 64 * MLA_KP + 32 * s), a3 = *(const LAS bf16x8*)(Kb + klane + 96 * MLA_KP + 32 * s);
            s0 = __builtin_amdgcn_mfma_f32_32x32x16_bf16(a0, qf[s], s0, 0, 0, 0); s1 = __builtin_amdgcn_mfma_f32_32x32x16_bf16(a1, qf[s], s1, 0, 0, 0);
            s2 = __builtin_amdgcn_mfma_f32_32x32x16_bf16(a2, qf[s], s2, 0, 0, 0); s3 = __builtin_amdgcn_mfma_f32_32x32x16_bf16(a3, qf[s], s3, 0, 0, 0); }
        __builtin_amdgcn_s_setprio(0);
        PP_BAR();
        softmax_tile4<true>(s0, s1, s2, s3, m_run, l_run, seen, negm, o, pa, pb, lane);
        PP_BAR();
        const int tmp = bp; bp = bc; bc = bn; bn = tmp;
    }
    { const LAS unsigned char* Vp = lds + bp * MLA_STAGE + MLA_SK; pv_tile(o, Vp, vlane, pa); pv_tile(o, Vp + 64 * 128, vlane, pb); }
    if (!grpB) PP_BAR();
#undef PP_BAR
#undef MLA_LOAD
#undef MLA_WRITE
    l_run += shflx(l_run, 32, lane);
    store_o(CLAT + qtok * 1024 + h * 64, o, 1.0f / l_run, hi);
    __syncthreads();
}
__device__ __forceinline__ int conv_group() { return (int)((blockIdx.x >> 3) % 6u); }
__device__ __forceinline__ void phase_attn_mla(KP p, int l, LAS unsigned char* lds, int wv) {
    const int G = gridDim.x, bx = blockIdx.x; const int vcu = (G % 8 == 0) ? (bx % 8) * (G / 8) + bx / 8 : bx;
    const int grp = conv_group(); int k = 0;
    for (int u = vcu; u < NB * 8 * 8; u += G, ++k) { if (k == grp) { phase_convert(p, l, lds, wv, true); __syncthreads(); } mla_unit(p, u >> 6, (u >> 3) & 7, u & 7, lds, wv); }
    if (k <= grp && grp < 4) { phase_convert(p, l, lds, wv, true); __syncthreads(); }
}

constexpr int W_KP = 144;
constexpr int W_TILE = 64 * W_KP + 64 * 128 + 256;
struct WinDesc {
    int ntile, dil, Lsub, tokbase, kcol, vcol;
    int kind, sbase, rbase;
    int qsub, posq, tlo, tn, ksub_lo, radius;
    float slope2, sink2; bool sink; bf16* qrow; float* lse_out;
    __device__ __forceinline__ int sub0(int t) const { return kind == 0 ? sbase + 64 * t : 64 * (t & 1); }
    __device__ __forceinline__ int res(int t) const { return kind == 0 ? rbase : rbase + (t >> 1); }
    __device__ __forceinline__ bool on(int t) const { const int s0 = sub0(t); return t < ntile && s0 >= 0 && s0 < Lsub; }
};
__device__ __forceinline__ void win_make_desc(KP p, int l, int u, int wid, int r32, WinDesc& D) {
    bf16* QKV = (bf16*)(p->ws + WS_QKV); float* LSE = (float*)(p->ws + OFF_LSE);
    if (u < 1536) {
        const int g = u >> 9, v = u & 511, b = v >> 5, h = (v >> 3) & 3, w8 = v & 7;
        const int dil = g == 0 ? 1 : (g == 1 ? 4 : 16);
        D.dil = dil; D.Lsub = SEQ / dil; D.tokbase = b * SEQ; D.kcol = 768 + g * 256 + h * 64; D.vcol = 1536 + g * 256 + h * 64;
        int rq, qs0;
        if (g == 0) { D.ntile = 6; D.kind = 0; D.sbase = 256 * w8 - 64; D.rbase = 0; rq = 0; qs0 = 256 * w8 + 32 * wid; D.tlo = wid >> 1; D.tn = 3; D.ksub_lo = 256 * w8 - 64 + 64 * D.tlo; }
        else if (g == 1) { const int rr = w8 >> 1, uu = w8 & 1; D.ntile = 6; D.kind = 0; D.sbase = 256 * uu - 64; D.rbase = rr; rq = rr; qs0 = 256 * uu + 32 * wid; D.tlo = wid >> 1; D.tn = 3; D.ksub_lo = 256 * uu - 64 + 64 * D.tlo; }
        else { D.ntile = 4; D.kind = 1; D.sbase = 0; D.rbase = 2 * w8; rq = 2 * w8 + (wid >> 2); qs0 = 32 * (wid & 3); D.tlo = 2 * (wid >> 2); D.tn = 2; D.ksub_lo = 0; }
        D.qsub = qs0 + r32; const size_t tok = (size_t)b * SEQ + (size_t)D.qsub * dil + rq;
        D.qrow = QKV + tok * 3072 + g * 256 + h * 64; D.posq = p->pos[tok]; D.radius = 64;
        D.slope2 = __builtin_amdgcn_exp2f(-8.0f * (float)(4 * g + h + 1) / 12.0f) * LOG2E; D.sink2 = 0.f; D.sink = false;
        D.lse_out = LSE + tok * 12 + g * 4 + h;
    } else {
        const int v = u - 1536, b = v >> 6, kvh = (v >> 5) & 1, blk = v & 31;
        D.dil = 1; D.Lsub = SEQ; D.tokbase = b * SEQ; D.kcol = 2816 + kvh * 64; D.vcol = 2944 + kvh * 64; D.ntile = 5; D.kind = 0; D.sbase = 64 * blk - 128; D.rbase = 0;
        const int rep = wid >> 1, head = kvh * 4 + rep;
        D.qsub = 64 * blk + 32 * (wid & 1) + r32; const size_t tok = (size_t)b * SEQ + D.qsub;
        D.qrow = QKV + tok * 3072 + 2304 + head * 64; D.posq = p->pos[tok]; D.radius = 128; D.tlo = 0; D.tn = 5; D.ksub_lo = 64 * blk - 128;
        D.slope2 = __builtin_amdgcn_exp2f(-(float)(head + 1)) * LOG2E; D.sink2 = p->sink_win[l * 8 + head] * LOG2E; D.sink = true; D.lse_out = nullptr;
    }
}
struct WinRegs { u32x4 rk[6], rv[6]; int rp[6]; bf16x8 qf[4]; };
__device__ __forceinline__ void win_issue(KP p, const WinDesc& D, int tid, int hi, WinRegs& R) {
    const bf16* QKV = (const bf16*)(p->ws + WS_QKV); const int key = tid >> 3, ch = tid & 7;
#pragma unroll
    for (int t = 0; t < 6; ++t) { if (D.on(t)) { const size_t tok = (size_t)D.tokbase + (size_t)(D.sub0(t) + key) * D.dil + D.res(t);
            R.rk[t] = *(const u32x4*)(QKV + tok * 3072 + D.kcol + 8 * ch); R.rv[t] = *(const u32x4*)(QKV + tok * 3072 + D.vcol + 8 * ch);
            R.rp[t] = (tid < 64) ? p->pos[(size_t)D.tokbase + (size_t)(D.sub0(t) + tid) * D.dil + D.res(t)] : 0; } }
#pragma unroll
    for (int s = 0; s < 4; ++s) R.qf[s] = *(const bf16x8*)(D.qrow + 16 * s + 8 * hi);
}
__device__ __forceinline__ void win_write(LAS unsigned char* lds, const WinDesc& D, int tid, const WinRegs& R) {
    const int key = tid >> 3, ch = tid & 7;
#pragma unroll
    for (int t = 0; t < 6; ++t) { if (D.on(t)) { LAS unsigned char* Kt = lds + t * W_TILE;
            *(LAS u32x4*)(Kt + key * W_KP + 16 * ch) = R.rk[t];
            *(LAS u32x4*)(Kt + 64 * W_KP + key * 128 + ((ch ^ (((key >> 1) & 1) << 2)) * 16)) = R.rv[t];
            if (tid < 64) *(LAS float*)(Kt + 64 * W_KP + 64 * 128 + 4 * tid) = (float)R.rp[t]; } }
}
template <bool SINK>
__device__ __forceinline__ void win_wave(LAS unsigned char* lds, const WinDesc& D, const bf16x8 (&qf)[4], int lane) {
    const int r32 = lane & 31, hi = lane >> 5;
    const int q4 = (lane & 15) >> 2, p4 = lane & 3, G1 = (lane >> 4) & 1;
    const int vlane = (4 * hi + q4) * 128 + (4 * ((q4 >> 1) & 1) + 2 * G1 + (p4 >> 1)) * 16 + 8 * (p4 & 1);
    const int klane = r32 * W_KP + 16 * hi;
    f32x16 o[2]; o[0] = f32x16{}; o[1] = f32x16{};
    float m_run = SINK ? D.sink2 : 0.f, l_run = SINK ? (hi == 0 ? 1.0f : 0.0f) : 0.f; bool seen = SINK; f32x16 negm;
#pragma unroll
    for (int r = 0; r < 16; ++r) negm[r] = -m_run;
    const int qsub = D.qsub, radius = D.radius; const float slope2 = D.slope2, posqf = (float)D.posq;
    for (int tt = 0; tt < D.tn; ++tt) {
        const int ks0 = D.ksub_lo + 64 * tt;
        if (ks0 < 0 || ks0 >= D.Lsub) continue;
        const LAS unsigned char* Kt = lds + (D.tlo + tt) * W_TILE; const LAS unsigned char* Vt = Kt + 64 * W_KP; const LAS float* pkf = (const LAS float*)(Vt + 64 * 128);
        f32x16 s0 = negm, s1 = negm;
#pragma unroll
        for (int s = 0; s < 4; ++s) { const bf16x8 a0 = *(const LAS bf16x8*)(Kt + klane + 32 * s), a1 = *(const LAS bf16x8*)(Kt + klane + 32 * W_KP + 32 * s);
            s0 = __builtin_amdgcn_mfma_f32_32x32x16_bf16(a0, qf[s], s0, 0, 0, 0); s1 = __builtin_amdgcn_mfma_f32_32x32x16_bf16(a1, qf[s], s1, 0, 0, 0); }
        const int c0 = ks0 - qsub + 4 * hi + radius; const unsigned lim = 2u * (unsigned)radius;
#pragma unroll
        for (int gq = 0; gq < 4; ++gq) { const f32x4 pa = *(const LAS f32x4*)(pkf + 8 * gq + 4 * hi), pb4 = *(const LAS f32x4*)(pkf + 32 + 8 * gq + 4 * hi);
#pragma unroll
            for (int e = 0; e < 4; ++e) { const int r = 4 * gq + e;
                s0[r] = (unsigned)(c0 + 8 * gq + e) <= lim ? s0[r] - slope2 * fabsf(posqf - pa[e]) : -INFINITY;
                s1[r] = (unsigned)(c0 + 8 * gq + e + 32) <= lim ? s1[r] - slope2 * fabsf(posqf - pb4[e]) : -INFINITY; } }
        bf16x8 pb[4];
        softmax_tile<false>(s0, s1, m_run, l_run, seen, negm, o, pb, lane);
        pv_tile(o, Vt, vlane, pb);
    }
    l_run += shflx(l_run, 32, lane);
    store_o(D.qrow, o, 1.0f / l_run, hi);
    if (!SINK && hi == 0) *D.lse_out = m_run + __log2f(l_run);
}
__device__ __forceinline__ void phase_attn_win(KP p, int l, LAS unsigned char* lds, int wv) {
    const int tid = otid(wv), lane = tid & 63, wid = wv, r32 = lane & 31, hi = lane >> 5;
    const int G = gridDim.x, bx = blockIdx.x;
    int u = (G % 8 == 0) ? (bx % 8) * (G / 8) + bx / 8 : bx;
    WinDesc Dn; WinRegs Rn;
    if (u < 2560) { win_make_desc(p, l, u, wid, r32, Dn); win_issue(p, Dn, tid, hi, Rn); }
    for (; u < 2560; u += G) {
        const WinDesc D = Dn;
        __syncthreads();
        win_write(lds, D, tid, Rn);
        bf16x8 qf[4];
#pragma unroll
        for (int s = 0; s < 4; ++s) qf[s] = Rn.qf[s];
        __syncthreads();
        if (u + G < 2560) { win_make_desc(p, l, u + G, wid, r32, Dn); win_issue(p, Dn, tid, hi, Rn); }
        if (D.sink) win_wave<true>(lds, D, qf, lane); else win_wave<false>(lds, D, qf, lane);
    }
    __syncthreads();
}
__device__ __forceinline__ void phase_dil_combine(KP p, int wv) {
    WAVE_IDS();
    const bf16* QKV = (const bf16*)(p->ws + WS_QKV); const float* LSE = (const float*)(p->ws + OFF_LSE); bf16* CLAT = (bf16*)(p->ws + WS_CLAT);
    const int h = lane >> 4, d0 = (lane & 15) * 4;
    for (int m0 = gw; m0 < T; m0 += 4 * NGW) {
        float ls[4][3]; u32x2 w[4][3];
#pragma unroll
        for (int q = 0; q < 4; ++q) { const int m = m0 + q * NGW;
#pragma unroll
            for (int g = 0; g < 3; ++g) { ls[q][g] = LSE[(size_t)m * 12 + g * 4 + h]; w[q][g] = *(const u32x2*)(QKV + (size_t)m * 3072 + g * 256 + h * 64 + d0); } }
#pragma unroll
        for (int q = 0; q < 4; ++q) { const int m = m0 + q * NGW;
            const float mx = fmaxf(ls[q][0], fmaxf(ls[q][1], ls[q][2]));
            float e[3], es = 0.f;
#pragma unroll
            for (int g = 0; g < 3; ++g) { e[g] = __builtin_amdgcn_exp2f(ls[q][g] - mx); es += e[g]; }
            const float inv = 1.0f / es; float o[4] = {0.f, 0.f, 0.f, 0.f};
#pragma unroll
            for (int g = 0; g < 3; ++g) { const float wg = e[g] * inv; o[0] += wg * bflo(w[q][g].x); o[1] += wg * bfhi(w[q][g].x); o[2] += wg * bflo(w[q][g].y); o[3] += wg * bfhi(w[q][g].y); }
            u32x2 ow; ow.x = pk2(o[0], o[1]); ow.y = pk2(o[2], o[3]);
            *(u32x2*)(CLAT + (size_t)m * 1024 + 512 + h * 64 + d0) = ow; }
    }
}
__device__ __forceinline__ void split3(const f32x4 w, u32x2& hi, u32x2& mid, u32x2& lo) {
    hi.x = pg8::cvt_pk_bf16(w.x, w.y); hi.y = pg8::cvt_pk_bf16(w.z, w.w);
    const f32x4 r1 = {w.x - bflo(hi.x), w.y - bfhi(hi.x), w.z - bflo(hi.y), w.w - bfhi(hi.y)};
    mid.x = pg8::cvt_pk_bf16(r1.x, r1.y); mid.y = pg8::cvt_pk_bf16(r1.z, r1.w);
    const f32x4 r2 = {r1.x - bflo(mid.x), r1.y - bfhi(mid.x), r1.z - bflo(mid.y), r1.w - bfhi(mid.y)};
    lo.x = pg8::cvt_pk_bf16(r2.x, r2.y); lo.y = pg8::cvt_pk_bf16(r2.z, r2.w);
}
__device__ __forceinline__ void phase_norm2_route(KP p, int l, LAS unsigned char* lds, int wv) {
    WAVE_IDS();
    constexpr int WPITCH = 1040;
    constexpr int GS_OFF = 112640, SH_OFF = GS_OFF + 4096, CB_OFF = SH_OFF + 4096, LG_OFF = CB_OFF + 1024;
    static_assert(3 * 36 * WPITCH <= GS_OFF && LG_OFF + 8 * 2304 <= MISC_OFF, "router LDS map");
    const float* mod = (const float*)(p->ws + OFF_MOD) + (size_t)l * NB * 6144;
    const float* wrt = (const float*)(p->ws + OFF_WRT) + (size_t)l * 36 * 1024;
    bf16* XN = (bf16*)(p->ws + WS_XN);
    int* RE = (int*)(p->ws + OFF_RE); float* RG = (float*)(p->ws + OFF_RG); int* BCNT = (int*)(p->ws + OFF_BCNT);
    LAS int* hist = (LAS int*)(lds + MISC_OFF + 4096);
    LAS float* ssl = (LAS float*)(lds + MISC_OFF + 4608) + wave * 16;
    LAS float* lgw = (LAS float*)(lds + LG_OFF) + wave * 16 * 36;
    LAS float* cbp = (LAS float*)(lds + CB_OFF);
    { int* tokidx = (int*)(p->ws + OFF_LSE); for (int i = (int)blockIdx.x * NT + tid; i < XS_ROWS; i += (int)gridDim.x * NT) tokidx[i] = -1; }
    for (int chunk = blockIdx.x; chunk < T / 128; chunk += gridDim.x) {
        int tl = tid; asm volatile("" : "+v"(tl));
        const int r = tl & 15, q = (tl >> 4) & 3;
        const int k4 = tl & 127, j0 = tl >> 7;
        const int b = chunk >> 4;
        const int row = chunk * 128 + wave * 16 + r;
        f32x4 wst[9];
#pragma unroll
        for (int it = 0; it < 9; ++it) wst[it] = *(const f32x4*)(wrt + (j0 + 4 * it) * 1024 + 4 * k4);
        const f32x2 gn = *(const f32x2*)(p->g_norm2 + l * D + 2 * tid), sc = *(const f32x2*)(mod + b * 6144 + 4096 + 2 * tid), sh = *(const f32x2*)(mod + b * 6144 + 3072 + 2 * tid);
        u32x4 xa[32];
        { const bf16* xrow = (const bf16*)(p->ws + WS_CLAT) + (size_t)row * D + 8 * q;
#pragma unroll
          for (int s = 0; s < 32; ++s) xa[s] = *(const u32x4*)(xrow + 32 * s); }
        if (tid < 32) hist[tid] = 0;
        *(LAS f32x2*)(lds + GS_OFF + 8 * tid) = gn * (sc + 1.0f); *(LAS f32x2*)(lds + SH_OFF + 8 * tid) = sh;
        __syncthreads();
        f32x4 acc[3] = {{0.f, 0.f, 0.f, 0.f}, {0.f, 0.f, 0.f, 0.f}, {0.f, 0.f, 0.f, 0.f}}, ssa = {0.f, 0.f, 0.f, 0.f};
#pragma unroll
        for (int h = 0; h < 2; ++h) {
            { const int col = 512 * h + 4 * k4;
              const f32x4 g4 = *(const LAS f32x4*)(lds + GS_OFF + 4 * col), s4 = *(const LAS f32x4*)(lds + SH_OFF + 4 * col);
#pragma unroll
              for (int it = 0; it < 9; ++it) { const int j = j0 + 4 * it; const f32x4 w = wst[it];
                  float cp = (s4.x * w.x + s4.y * w.y) + (s4.z * w.z + s4.w * w.w);
                  cp = wave_sum(cp, lane);
                  if (lane == 0) cbp[(2 * h + (wave & 1)) * 36 + j] = cp + ((h == 0 && (wave & 1) == 0) ? (j < 4 ? p->b_gr[l * 4 + j] : p->b_er[l * 32 + j - 4]) : 0.f);
                  u32x2 hi, mid, lo; split3(w * g4, hi, mid, lo);
                  *(LAS u32x2*)(lds + (0 * 36 + j) * WPITCH + 8 * k4) = hi; *(LAS u32x2*)(lds + (1 * 36 + j) * WPITCH + 8 * k4) = mid; *(LAS u32x2*)(lds + (2 * 36 + j) * WPITCH + 8 * k4) = lo; } }
            __syncthreads();
#pragma unroll
            for (int s2 = 0; s2 < 16; ++s2) { const bf16x8 a = __builtin_bit_cast(bf16x8, xa[16 * h + s2]);
                ssa = __builtin_amdgcn_mfma_f32_16x16x32_bf16(a, a, ssa, 0, 0, 0);
#pragma unroll
                for (int nt = 0; nt < 3; ++nt) { const int jr = (16 * nt + r) < 35 ? (16 * nt + r) : 35;
#pragma unroll
                    for (int t = 0; t < 3; ++t) { const bf16x8 bw = *(const LAS bf16x8*)(lds + (t * 36 + jr) * WPITCH + 64 * s2 + 16 * q);
                        acc[nt] = __builtin_amdgcn_mfma_f32_16x16x32_bf16(a, bw, acc[nt], 0, 0, 0); } }
                __builtin_amdgcn_sched_barrier(0); }
            if (h == 0) {
#pragma unroll
                for (int it = 0; it < 9; ++it) wst[it] = *(const f32x4*)(wrt + (j0 + 4 * it) * 1024 + 512 + 4 * k4); }
            __syncthreads();
        }
#pragma unroll
        for (int nt = 0; nt < 3; ++nt) if (16 * nt + r < 36) {
#pragma unroll
            for (int i = 0; i < 4; ++i) lgw[(4 * q + i) * 36 + 16 * nt + r] = acc[nt][i]; }
        if ((r >> 2) == q) { const int i = r & 3; ssl[r] = i == 0 ? ssa.x : (i == 1 ? ssa.y : (i == 2 ? ssa.z : ssa.w)); }
        asm volatile("s_waitcnt lgkmcnt(0)" ::: "memory");
        const float rstd = __builtin_amdgcn_rsqf(ssl[r] * (1.0f / D) + EPS);
        if (lane < 16) { const int m = row; const LAS float* Lr = lgw + lane * 36;
#define LGT(j) (Lr[j] * rstd + ((cbp[j] + cbp[36 + (j)]) + (cbp[72 + (j)] + cbp[108 + (j)])))
            float Lg[4];
#pragma unroll
            for (int g = 0; g < 4; ++g) Lg[g] = LGT(g);
            float gm = Lg[0]; int gi = 0;
#pragma unroll
            for (int g = 1; g < 4; ++g) if (Lg[g] > gm) { gm = Lg[g]; gi = g; }
            float gs = 0.f;
#pragma unroll
            for (int g = 0; g < 4; ++g) gs += __expf(Lg[g] - gm);
            const float gw_ = 1.0f / gs;
            float el[8]; float em = -INFINITY;
#pragma unroll
            for (int e = 0; e < 8; ++e) { el[e] = LGT(4 + gi * 8 + e); em = fmaxf(em, el[e]); }
#undef LGT
            float es = 0.f;
#pragma unroll
            for (int e = 0; e < 8; ++e) { el[e] = __expf(el[e] - em); es += el[e]; }
            int i1 = 0; float p1 = el[0];
#pragma unroll
            for (int e = 1; e < 8; ++e) if (el[e] > p1) { p1 = el[e]; i1 = e; }
            int i2 = -1; float p2 = -1.f;
#pragma unroll
            for (int e = 0; e < 8; ++e) if (e != i1 && el[e] > p2) { p2 = el[e]; i2 = e; }
            const float inv = gw_ / (p1 + p2);
            const int e1 = gi * 8 + i1, e2 = gi * 8 + i2;
            RE[2 * m] = e1; RE[2 * m + 1] = e2; RG[2 * m] = p1 * inv; RG[2 * m + 1] = p2 * inv;
            __hip_atomic_fetch_add(&hist[e1], 1, __ATOMIC_RELAXED, __HIP_MEMORY_SCOPE_WORKGROUP); __hip_atomic_fetch_add(&hist[e2], 1, __ATOMIC_RELAXED, __HIP_MEMORY_SCOPE_WORKGROUP);
        }
        { bf16* xo = XN + (size_t)row * D + 8 * q;
#pragma unroll
          for (int s = 0; s < 32; ++s) { const int col = 32 * s + 8 * q; const u32x4 w = xa[s];
              const f32x4 g0 = *(const LAS f32x4*)(lds + GS_OFF + 4 * col), g1 = *(const LAS f32x4*)(lds + GS_OFF + 4 * col + 16), h0 = *(const LAS f32x4*)(lds + SH_OFF + 4 * col), h1 = *(const LAS f32x4*)(lds + SH_OFF + 4 * col + 16);
              const f32x4 y0 = (f32x4){bflo(w.x), bfhi(w.x), bflo(w.y), bfhi(w.y)} * rstd * g0 + h0, y1 = (f32x4){bflo(w.z), bfhi(w.z), bflo(w.w), bfhi(w.w)} * rstd * g1 + h1;
              u32x4 o; o.x = pg8::cvt_pk_bf16(y0.x, y0.y); o.y = pg8::cvt_pk_bf16(y0.z, y0.w); o.z = pg8::cvt_pk_bf16(y1.x, y1.y); o.w = pg8::cvt_pk_bf16(y1.z, y1.w);
              *(u32x4*)(xo + 32 * s) = o; __builtin_amdgcn_sched_barrier(0); } }
        __syncthreads();
        if (tid < 32) BCNT[chunk * 32 + tid] = hist[tid];
        __syncthreads();
    }
}
__device__ __forceinline__ void phase_dispatch(KP p, LAS unsigned char* lds, int wv) {
    WAVE_IDS();
    const int* BCNT = (const int*)(p->ws + OFF_BCNT); const int* RE = (const int*)(p->ws + OFF_RE); int* RD = (int*)(p->ws + OFF_RD);
    int* tokidx = (int*)(p->ws + OFF_LSE);
    LAS int* part = (LAS int*)lds;
    LAS int* tot = (LAS int*)(lds + 4096);
    LAS int* earr = (LAS int*)(lds + 8192);
    LAS int* darr = (LAS int*)(lds + 8192 + 1024);
    LAS int* misc = (LAS int*)(lds + MISC_OFF);
    for (int chunk = blockIdx.x; chunk < T / 128; chunk += gridDim.x) {
        { const int e = tid & 31, pt = tid >> 5; int s = 0, sb = 0;
          for (int c = pt * 16; c < pt * 16 + 16; ++c) { const int v = BCNT[c * 32 + e]; s += v; if (c < chunk) sb += v; }
          part[pt * 32 + e] = s; part[512 + pt * 32 + e] = sb; }
        if (tid < 256) earr[tid] = RE[chunk * 256 + tid];
        __syncthreads();
        if (tid < 32) { int s = 0, sb = 0;
            for (int pt = 0; pt < 16; ++pt) { s += part[pt * 32 + tid]; sb += part[512 + pt * 32 + tid]; }
            tot[tid] = s; tot[32 + tid] = sb; }
        __syncthreads();
        if (tid < 32) { int base = 0; for (int e = 0; e < tid; ++e) base += (tot[e] + 255) & ~255; tot[64 + tid] = base; }
        __syncthreads();
        if (tid == 0) { int nt = 0; for (int e = 0; e < 32; ++e) { const int k = (tot[e] + 255) >> 8; for (int i = 0; i < k; ++i) misc[16 + nt + i] = e; nt += k; } misc[0] = nt; }
        if (tid < 256) { const int e = earr[tid]; int rank = 0; for (int a = 0; a < tid; ++a) rank += (earr[a] == e) ? 1 : 0;
            const int dest = tot[64 + e] + tot[32 + e] + rank; darr[tid] = dest; RD[chunk * 256 + tid] = dest; }
        __syncthreads();
        if (tid < 256) tokidx[darr[tid]] = chunk * 256 + tid;
        __syncthreads();
    }
}
template <int NJ> struct MoeOrder {
    const LAS int* misc; int G, c;
    __device__ __forceinline__ bool next(int i, pg8::Unit& u) const {
        const int L = i * G + c; const int nt = misc[0];
        if (L >= nt * NJ) return false;
        const int tile = L / NJ, j = L - tile * NJ; u.pm = tile; u.pn = misc[16 + tile] * NJ + j; return true;
    }
    __device__ __forceinline__ void a_ready(const pg8::Unit&) const {}
    __device__ __forceinline__ void done(const pg8::Unit&) const {}
};
__device__ __forceinline__ void phase_combine(KP p, int l, bool next_norm, int wv) {
    WAVE_IDS();
    const float* mod = (const float*)(p->ws + OFF_MOD) + (size_t)l * NB * 6144;
    const float* modn = (const float*)(p->ws + OFF_MOD) + (size_t)(l + 1) * NB * 6144;
    const int* RD = (const int*)(p->ws + OFF_RD); const float* RG = (const float*)(p->ws + OFF_RG);
    const bf16* Y = (const bf16*)(p->ws + WS_QKV); bf16* XN = (bf16*)(p->ws + WS_XN);
    for (int m0 = gw; m0 < T; m0 += 2 * NGW) {
        int dd[2][2]; float gg[2][2];
#pragma unroll
        for (int q = 0; q < 2; ++q) { const int m = m0 + q * NGW; dd[q][0] = 2 * m; dd[q][1] = 2 * m + 1;
            gg[q][0] = RG[2 * m]; gg[q][1] = RG[2 * m + 1];
        }
        f32x4 xv[2][4]; u32x2 y0[2][4], y1[2][4];
#pragma unroll
        for (int q = 0; q < 2; ++q) { const int m = m0 + q * NGW; const bf16* xrow = (const bf16*)(p->ws + WS_CLAT) + (size_t)m * D;
#pragma unroll
            for (int j = 0; j < 4; ++j) { const int cidx = 4 * lane + 256 * j; { const u32x2 w = *(const u32x2*)(xrow + cidx); xv[q][j] = (f32x4){bflo(w.x), bfhi(w.x), bflo(w.y), bfhi(w.y)}; }
                y0[q][j] = *(const u32x2*)(Y + (size_t)dd[q][0] * D + cidx); y1[q][j] = *(const u32x2*)(Y + (size_t)dd[q][1] * D + cidx); } }
        f32x4 gtv[2][4], gnv[4], s1v[2][4], s0v[2][4];
#pragma unroll
        for (int q = 0; q < 2; ++q) { const int b = (m0 + q * NGW) >> 11;
#pragma unroll
            for (int j = 0; j < 4; ++j) { const int cidx = 4 * lane + 256 * j; gtv[q][j] = *(const f32x4*)(mod + b * 6144 + 5120 + cidx);
                if (next_norm) { s1v[q][j] = *(const f32x4*)(modn + b * 6144 + 1024 + cidx); s0v[q][j] = *(const f32x4*)(modn + b * 6144 + cidx); if (q == 0) gnv[j] = *(const f32x4*)(p->g_norm1 + (l + 1) * D + cidx); } } }
#pragma unroll
        for (int q = 0; q < 2; ++q) { const int m = m0 + q * NGW; float* xrow = p->out + (size_t)m * D; bf16* xrow16 = (bf16*)p->out + (size_t)m * D; const float g0 = gg[q][0], g1 = gg[q][1]; f32x4 v[4]; float ss = 0.f;
#pragma unroll
            for (int j = 0; j < 4; ++j) { const int cidx = 4 * lane + 256 * j; const f32x4 gt = gtv[q][j];
                f32x4 yy; yy.x = g0 * bflo(y0[q][j].x) + g1 * bflo(y1[q][j].x); yy.y = g0 * bfhi(y0[q][j].x) + g1 * bfhi(y1[q][j].x); yy.z = g0 * bflo(y0[q][j].y) + g1 * bflo(y1[q][j].y); yy.w = g0 * bfhi(y0[q][j].y) + g1 * bfhi(y1[q][j].y);
                v[j] = xv[q][j] + gt * yy;
                if (next_norm) { u32x2 o; o.x = pk2(v[j].x, v[j].y); o.y = pk2(v[j].z, v[j].w); *(u32x2*)(xrow16 + cidx) = o; }
                else *(f32x4*)(xrow + cidx) = v[j];
                ss += (v[j].x * v[j].x + v[j].y * v[j].y) + (v[j].z * v[j].z + v[j].w * v[j].w); }
            if (next_norm) { const float rstd = __builtin_amdgcn_rsqf(wave_sum(ss, lane) * (1.0f / D) + EPS);
#pragma unroll
                for (int j = 0; j < 4; ++j) { const int cidx = 4 * lane + 256 * j;
                    const f32x4 y = v[j] * rstd * gnv[j] * (s1v[q][j] + 1.0f) + s0v[q][j]; u32x2 o; o.x = pk2(y.x, y.y); o.y = pk2(y.z, y.w); *(u32x2*)(XN + (size_t)m * D + cidx) = o; } } }
    }
}

#ifndef ALIGN_SMALLK
#define ALIGN_SMALLK true
#endif
template <int l> __device__ __forceinline__ void layer_body(LAS unsigned char* lds, const XcdBarrier& xbar, int wv) {
    const int G = gridDim.x, bx = blockIdx.x;
    unsigned char* ws = kparams()->ws;
    bf16* XN = (bf16*)(ws + WS_XN); bf16* CLAT = (bf16*)(ws + WS_CLAT); bf16* QKV = (bf16*)(ws + WS_QKV); bf16* QM = (bf16*)(ws + WS_QM); bf16* KVM = (bf16*)(ws + WS_KVM);
    const float* modall = (const float*)(ws + OFF_MOD);
    const bf16* Win_t = (const bf16*)(ws + WS_WIN);
    {
        const float* xin = l == 0 ? kparams()->x : kparams()->out;
        { pg8::Gemm g{XN, Win_t, 1024, 1024, 1024, wv}; pg8::StaticOrder S; S.init(T, 4096, G, bx);
          KP p = kparams();
          pg8::EpiProj E{QKV, CLAT, (float*)(ws + OFF_LSE), p->pos, p->g_q_dil + l * 64, p->g_k_dil + l * 64, p->g_q_win + l * 64, p->g_k_win + l * 64, p->g_k_mla + l * 96 + 64, SC_HD};
          pg8::gemm_phase<pg8::EpiProj, pg8::StaticOrder, true, true>(lds, g, S, E); }
        xcd_barrier(xbar);
        { pg8::Gemm g{CLAT, (const bf16*)(ws + WS_WUQ), 1024, 512, 512, wv}; pg8::StaticOrder S; S.init(T, 768, G, bx);
          KP p = kparams();
          pg8::EpiQ E{QM, (const float*)(ws + OFF_LSE), p->pos, p->g_q_mla + l * 96, SC_MLA};
          pg8::gemm_phase<pg8::EpiQ, pg8::StaticOrder, ALIGN_SMALLK, true>(lds, g, S, E); }
        { pg8::Gemm g{CLAT + 512, (const bf16*)(ws + WS_WUKV), 1024, 256, 256, wv}; pg8::StaticOrder S; S.init(T, 1024, G, bx);
          KP p = kparams();
          pg8::EpiKV E{KVM, (const float*)(ws + OFF_LSE), p->g_k_mla + l * 96};
          pg8::gemm_phase<pg8::EpiKV, pg8::StaticOrder, ALIGN_SMALLK, true>(lds, g, S, E); }
        xcd_barrier(xbar);
        phase_attn_mla(kparams(), l, lds, wv);
        if (conv_group() == 4) { phase_convert(kparams(), l, lds, wv, true); __syncthreads(); }
        phase_attn_win(kparams(), l, lds, wv);
        if (conv_group() == 5) { phase_convert(kparams(), l, lds, wv, true); }
        xcd_barrier(xbar);
        phase_dil_combine(kparams(), wv);
        xcd_barrier(xbar);
        { unsigned char* G8 = ws + WS_KVM; bf16* MERGED = QKV + 1024;
          pg8::GemmM g{XN, Win_t + (size_t)4096 * 1024, CLAT, CLAT + 512, QKV + 2304, (const bf16*)(ws + WS_WBM), (const bf16*)(ws + WS_WBD), (const bf16*)(ws + WS_WBW), 1024, 1024, 3072, 512, 256, 512, wv};
          pg8::MultiOrder<6> S; S.S.init(T, 1024, G, bx); pg8::EpiGateBranch E{G8, MERGED, 3072};
          pg8::gemm_phase_multi<pg8::EpiGateBranch, pg8::MultiOrder<6>, true, true>(lds, g, S, E); }
        xcd_barrier(xbar);
        { pg8::Gemm g{QKV + 1024, (const bf16*)(ws + WS_WOUT), 3072, 1024, 1024, wv}; pg8::StaticOrder S; S.init(T, 1024, G, bx);
          pg8::EpiResidual<l == 0> E{kparams()->x, (const bf16*)kparams()->out, CLAT, modall + (size_t)l * NB * 6144 + 2048};
          pg8::gemm_phase<pg8::EpiResidual<l == 0>, pg8::StaticOrder, true, true>(lds, g, S, E); }
        xcd_barrier(xbar);
        phase_norm2_route(kparams(), l, lds, wv);
        xcd_barrier(xbar);
        phase_dispatch(kparams(), lds, wv);
        xcd_barrier(xbar);
        { pg8::Gemm g{XN, (const bf16*)(ws + WS_W13), 1024, 1024, 1024, wv}; MoeOrder<3> S{(const LAS int*)(lds + MISC_OFF), G, (G % 8 == 0) ? (bx % 8) * (G / 8) + bx / 8 : bx};
          pg8::EpiSwiGLU E{KVM};
          pg8::gemm_phase_gather<pg8::EpiSwiGLU, MoeOrder<3>, true, true>(lds, g, (const int*)(ws + OFF_LSE), S, E); }
        xcd_barrier(xbar);
        { pg8::Gemm g{KVM, (const bf16*)(ws + WS_W2), 384, 384, 384, wv}; MoeOrder<4> S{(const LAS int*)(lds + MISC_OFF), G, (G % 8 == 0) ? (bx % 8) * (G / 8) + bx / 8 : bx};
          pg8::EpiScatterY E{QKV, (const int*)(ws + OFF_LSE)};
          pg8::gemm_phase<pg8::EpiScatterY, MoeOrder<4>, true, true>(lds, g, S, E); }
        xcd_barrier(xbar);
        phase_combine(kparams(), l, l == 0, wv);
        if (l == 0) phase_convert(kparams(), 1, lds, wv, false);
        xcd_barrier(xbar);
    }
}

__global__ void __launch_bounds__(NT, 2) mega_fwd(Params p_unused) {
    extern __shared__ __attribute__((aligned(16))) unsigned char lds_raw[];
    LAS unsigned char* lds = (LAS unsigned char*)lds_raw;
    cg::grid_group grid = cg::this_grid();
    const int wv = __builtin_amdgcn_readfirstlane(threadIdx.x >> 6);
    { volatile LAS unsigned* st = (volatile LAS unsigned*)(lds + MISC_OFF + 12288); const int t0_ = otid(wv); if (t0_ < 4) st[t0_] = 0u; }
    __syncthreads();
    const XcdBarrier xbar = xcd_barrier_post((unsigned*)kparams()->ws, (volatile LAS unsigned*)(lds + MISC_OFF + 12288), wv);

    phase_mod(kparams(), lds, wv);
    if ((int)gridDim.x >= 224) { if ((int)blockIdx.x >= 192) phase_convert(kparams(), 0, lds, wv, false, ((int)blockIdx.x - 192) * NW + wv, ((int)gridDim.x - 192) * NW); }
    else phase_convert(kparams(), 0, lds, wv, false);
    if (gridDim.x == 0x7fffff) grid.sync();
    xcd_barrier(xbar);
    phase_norm1(kparams(), 0, kparams()->x, wv);
    xcd_barrier(xbar);
    layer_body<0>(lds, xbar, wv);
    layer_body<1>(lds, xbar, wv);
}

extern "C" void kernel_launch(void* const* d_in, const int* in_sizes, int n_in, void* d_out, int out_size, void* d_ws, size_t ws_size, hipStream_t stream) {
    static int grid = 0;
    if (grid == 0) {
        int dev = 0, cus = 0, per_cu = 0;
        (void)hipGetDevice(&dev);
        (void)hipDeviceGetAttribute(&cus, hipDeviceAttributeMultiprocessorCount, dev);
        (void)hipFuncSetAttribute((const void*)mega_fwd, hipFuncAttributeMaxDynamicSharedMemorySize, LDS_BYTES);
        (void)hipOccupancyMaxActiveBlocksPerMultiprocessor(&per_cu, (const void*)mega_fwd, NT, LDS_BYTES);
        grid = cus;
        if (per_cu < 1 || n_in != 30 || out_size != T * D || ws_size < WS_END) { fprintf(stderr, "kernel_launch: per_cu %d n_in %d out %d ws %zu (need %zu)\n", per_cu, n_in, out_size, ws_size, (size_t)WS_END); }
        if (ws_size < WS_END) grid = -1;
    }
    if (grid < 0) return;
    Params hp{};
    const float** fp = (const float**)&hp;
    for (int i = 0; i < 30; ++i) fp[i] = (const float*)d_in[i];
    hp.out = (float*)d_out; hp.ws = (unsigned char*)d_ws;
    (void)hipMemsetAsync(d_ws, 0, 16384, stream);
    void* args[] = {&hp};
    hipError_t e = hipLaunchCooperativeKernel((const void*)mega_fwd, dim3(grid), dim3(NT), args, LDS_BYTES, stream);
    if (e != hipSuccess) fprintf(stderr, "cooperative launch failed: %s (grid %d)\n", hipGetErrorString(e), grid);
}
```

```cpp
#include <hip/hip_runtime.h>
#include <hip/hip_cooperative_groups.h>
#include <cstdio>
#include <cstdint>
namespace cg = cooperative_groups;

namespace pg8 {
#define PG8_LAS __attribute__((address_space(3)))
typedef unsigned short bf16_t;
typedef short bf16x8 __attribute__((ext_vector_type(8)));
typedef float f32x4 __attribute__((ext_vector_type(4)));
typedef unsigned u32x4 __attribute__((ext_vector_type(4)));
typedef unsigned u32x2 __attribute__((ext_vector_type(2)));
constexpr int BM = 256, BK = 64, HALF = 128, HTB = HALF * BK * 2  , STAGE_BYTES = 8 * HTB, NXCD = 8, WGM = 8;

__host__ __device__ __forceinline__ int lds_byte(int r, int c) { const int st = (r >> 4) * 2 + (c >> 5), rr = r & 15, cc = c & 31, ob = rr * 64 + cc * 2; return st * 1024 + (ob ^ (((ob >> 9) & 1) << 5)); }
__host__ __device__ __forceinline__ void stage_rc(int b, int& R, int& C) { const int st = b / 1024, sb = b % 1024, swz = sb ^ (((sb >> 9) & 1) << 5); R = (st >> 1) * 16 + swz / 64; C = (st & 1) * 32 + (swz % 64) / 2; }
__host__ __device__ __forceinline__ int perm32(int rho) { const int n = rho >> 4, i = rho & 15; return 8 * (i >> 2) + 4 * n + (i & 3); }

struct Unit { int pm, pn, kind; };
struct Gemm { const bf16_t* A; const bf16_t* Bt; int lda, ldb, K; int wv; };

template <class T_> __device__ __forceinline__ T_ sel3(int k, T_ a, T_ b, T_ c) { return k == 0 ? a : (k == 1 ? b : c); }
struct GemmM { const bf16_t* gA; const bf16_t* gB; const bf16_t *A0, *A1, *A2; const bf16_t *B0, *B1, *B2; int lda0, lda1, lda2, K0, K1, K2; int wv;
    __device__ __forceinline__ int lda(int k) const { return (k & 1) ? sel3(k >> 1, lda0, lda1, lda2) : 1024; }
    __device__ __forceinline__ int ldb(int k) const { return (k & 1) ? sel3(k >> 1, K0, K1, K2) : 1024; }
    __device__ __forceinline__ int K(int k) const { return (k & 1) ? sel3(k >> 1, K0, K1, K2) : 1024; }
    __device__ __forceinline__ const bf16_t* Ap(int k) const { return (k & 1) ? sel3(k >> 1, A0, A1, A2) : gA; }
    __device__ __forceinline__ const bf16_t* Bp(int k) const { return (k & 1) ? sel3(k >> 1, B0, B1, B2) : gB + (size_t)(k >> 1) * 1024 * 1024; }
};
struct StaticOrder {
    int nM, nN, nwg, G, c;
    __device__ void init(int M, int N, int G_, int c_) { nM = M / BM; nN = N / BM; nwg = nM * nN; G = G_; c = c_; }
    __device__ bool next(int i, Unit& u) const {
        const long L = (long)i * G + c; if (L >= nwg) return false;
        int wgid = (int)L; { const int q = nwg / NXCD, r = nwg % NXCD, xcd = wgid % NXCD, off = wgid / NXCD; wgid = (xcd < r ? xcd * (q + 1) : r * (q + 1) + (xcd - r) * q) + off; }
        const int nig = WGM * nN, gid = wgid / nig, fm = gid * WGM, gsz = (nM - fm) < WGM ? (nM - fm) : WGM;
        u.pm = fm + ((wgid % nig) % gsz); u.pn = (wgid % nig) / gsz; return true;
    }
    __device__ __forceinline__ void a_ready(const Unit&) const {}
    __device__ __forceinline__ void done(const Unit&) const {}
};

typedef float f32x2_t __attribute__((ext_vector_type(2))); typedef __bf16 bf16x2_t __attribute__((ext_vector_type(2)));
__device__ __forceinline__ unsigned cvt_pk_bf16(float lo, float hi) { f32x2_t v = {lo, hi}; bf16x2_t b = __builtin_convertvector(v, bf16x2_t); return __builtin_bit_cast(unsigned, b); }

__device__ __forceinline__ int hw_lane() { int l; asm volatile("v_mbcnt_lo_u32_b32 %0, -1, 0\n\tv_mbcnt_hi_u32_b32 %0, -1, %0" : "=v"(l)); return l; }
__device__ __forceinline__ float fast_sigmoid(float x) { return __builtin_amdgcn_rcpf(1.0f + __builtin_amdgcn_exp2f(-1.4426950408889634f * x)); }
__device__ __forceinline__ float bf_lo(unsigned w) { return __uint_as_float(w << 16); }
__device__ __forceinline__ float bf_hi(unsigned w) { return __uint_as_float(w & 0xffff0000u); }

template <int ACT> struct EpiStore {
    static constexpr bool PERM = true, AFTER_DRAIN = false, PREFETCH = false;
    bf16_t* O; int ldc; bf16_t* O2; int ldc2; int split_pn; int pn_mod;
    __device__ __forceinline__ void operator()(const f32x4 (&acc)[2][2][4][2], const Unit& u, int wr, int wc, int, int) const {
        const int ln_ = hw_lane(), fr = ln_ & 15, fq = ln_ >> 4;
        const int row0 = u.pm * BM + wr * 64 + fr;
        bf16_t* base = O; int ld = ldc; int pn = pn_mod ? (u.pn % pn_mod) : u.pn;
        if (pn >= split_pn) { base = O2; ld = ldc2; pn -= split_pn; }
        const int col0 = pn * BM + wc * 32 + 8 * fq;
#pragma unroll
        for (int ai = 0; ai < 2; ++ai)
#pragma unroll
            for (int m = 0; m < 4; ++m) { bf16_t* rowp = base + (size_t)(row0 + ai * HALF + m * 16) * ld + col0;
#pragma unroll
                for (int bj = 0; bj < 2; ++bj) { f32x4 v0 = acc[ai][bj][m][0], v1 = acc[ai][bj][m][1];
                    if (ACT == 1) {
#pragma unroll
                        for (int e = 0; e < 4; ++e) { v0[e] = fast_sigmoid(v0[e]); v1[e] = fast_sigmoid(v1[e]); } }
                    u32x4 w; w.x = cvt_pk_bf16(v0[0], v0[1]); w.y = cvt_pk_bf16(v0[2], v0[3]); w.z = cvt_pk_bf16(v1[0], v1[1]); w.w = cvt_pk_bf16(v1[2], v1[3]);
                    *(u32x4*)(rowp + bj * HALF) = w; } }
    }
};
template <bool XF32> struct EpiResidual {
    static constexpr bool PERM = true, AFTER_DRAIN = false, PREFETCH = false;
    const float* xf; const bf16_t* xb; bf16_t* out; const float* gate;
    __device__ __forceinline__ void operator()(const f32x4 (&acc)[2][2][4][2], const Unit& u, int wr, int wc, int, int) const {
        const int ln_ = hw_lane(), fr = ln_ & 15, fq = ln_ >> 4;
        const int row0 = u.pm * BM + wr * 64 + fr, col0 = u.pn * BM + wc * 32 + 8 * fq;
        const float* gp = gate + (size_t)((u.pm * BM) >> 11) * 6144 + col0;
        f32x4 gv[2][2];
#pragma unroll
        for (int bj = 0; bj < 2; ++bj)
#pragma unroll
            for (int n = 0; n < 2; ++n) gv[bj][n] = *(const f32x4*)(gp + bj * HALF + n * 4);
#pragma unroll
        for (int ai = 0; ai < 2; ++ai) {
            f32x4 xv[4][2][2];
#pragma unroll
            for (int m = 0; m < 4; ++m) { const size_t off = (size_t)(row0 + ai * HALF + m * 16) * 1024 + col0;
#pragma unroll
                for (int bj = 0; bj < 2; ++bj) {
                    if (XF32) { xv[m][bj][0] = *(const f32x4*)(xf + off + bj * HALF); xv[m][bj][1] = *(const f32x4*)(xf + off + bj * HALF + 4); }
                    else { const u32x4 w = *(const u32x4*)(xb + off + bj * HALF); xv[m][bj][0] = (f32x4){bf_lo(w.x), bf_hi(w.x), bf_lo(w.y), bf_hi(w.y)}; xv[m][bj][1] = (f32x4){bf_lo(w.z), bf_hi(w.z), bf_lo(w.w), bf_hi(w.w)}; } } }
#pragma unroll
            for (int m = 0; m < 4; ++m) { const size_t off = (size_t)(row0 + ai * HALF + m * 16) * 1024 + col0;
#pragma unroll
                for (int bj = 0; bj < 2; ++bj) { const f32x4 v0 = xv[m][bj][0] + gv[bj][0] * acc[ai][bj][m][0], v1 = xv[m][bj][1] + gv[bj][1] * acc[ai][bj][m][1];
                    u32x4 w; w.x = cvt_pk_bf16(v0[0], v0[1]); w.y = cvt_pk_bf16(v0[2], v0[3]); w.z = cvt_pk_bf16(v1[0], v1[1]); w.w = cvt_pk_bf16(v1[2], v1[3]);
                    *(u32x4*)(out + off + bj * HALF) = w; } } }
    }
};
struct EpiSwiGLU {
    static constexpr bool PERM = true, AFTER_DRAIN = false, PREFETCH = false;
    bf16_t* O;
    __device__ __forceinline__ void operator()(const f32x4 (&acc)[2][2][4][2], const Unit& u, int wr, int wc, int, int) const {
        const int ln_ = hw_lane(), fr = ln_ & 15, fq = ln_ >> 4;
        const int row0 = u.pm * BM + wr * 64 + fr, col0 = (u.pn % 3) * HALF + wc * 32 + 8 * fq;
#pragma unroll
        for (int ai = 0; ai < 2; ++ai)
#pragma unroll
            for (int m = 0; m < 4; ++m) { float o[8];
#pragma unroll
                for (int n = 0; n < 2; ++n)
#pragma unroll
                    for (int e = 0; e < 4; ++e) { const float a = acc[ai][0][m][n][e], b = acc[ai][1][m][n][e]; o[n * 4 + e] = a * fast_sigmoid(a) * b; }
                u32x4 w; w.x = cvt_pk_bf16(o[0], o[1]); w.y = cvt_pk_bf16(o[2], o[3]); w.z = cvt_pk_bf16(o[4], o[5]); w.w = cvt_pk_bf16(o[6], o[7]);
                *(u32x4*)(O + (size_t)(row0 + ai * HALF + m * 16) * 384 + col0) = w; }
    }
};

struct EpiGateBranch {
    static constexpr bool PERM = true, AFTER_DRAIN = false, PREFETCH = false;
    unsigned char* G; bf16_t* Mo; int ldm;
    __device__ __forceinline__ void operator()(const f32x4 (&acc)[2][2][4][2], const Unit& u, int wr, int wc, int, int) const {
        const int ln_ = hw_lane(), fr = ln_ & 15, fq = ln_ >> 4;
        const int row0 = u.pm * BM + wr * 64 + fr, col0 = u.pn * BM + wc * 32 + 8 * fq;
        if ((u.kind & 1) == 0) {
#pragma unroll
            for (int ai = 0; ai < 2; ++ai)
#pragma unroll
                for (int m = 0; m < 4; ++m) { unsigned char* rowp = G + (size_t)(row0 + ai * HALF + m * 16) * 1024 + col0;
#pragma unroll
                    for (int bj = 0; bj < 2; ++bj) { unsigned q[8];
#pragma unroll
                        for (int e = 0; e < 4; ++e) { q[e] = (unsigned)(fast_sigmoid(acc[ai][bj][m][0][e]) * 255.0f + 0.5f); q[4 + e] = (unsigned)(fast_sigmoid(acc[ai][bj][m][1][e]) * 255.0f + 0.5f); }
                        u32x2 w; w.x = q[0] | (q[1] << 8) | (q[2] << 16) | (q[3] << 24); w.y = q[4] | (q[5] << 8) | (q[6] << 16) | (q[7] << 24);
                        *(u32x2*)(rowp + bj * HALF) = w; } }
        } else {
            const bool accum = u.kind != 1;
#pragma unroll
            for (int ai = 0; ai < 2; ++ai) {
                u32x2 gq[4][2]; u32x4 pm[4][2];
#pragma unroll
                for (int m = 0; m < 4; ++m) { const size_t r = (size_t)(row0 + ai * HALF + m * 16);
#pragma unroll
                    for (int bj = 0; bj < 2; ++bj) { gq[m][bj] = *(const u32x2*)(G + r * 1024 + col0 + bj * HALF);
                        if (accum) pm[m][bj] = *(const u32x4*)(Mo + r * ldm + col0 + bj * HALF); else pm[m][bj] = (u32x4){0u, 0u, 0u, 0u}; } }
#pragma unroll
                for (int m = 0; m < 4; ++m) { const size_t r = (size_t)(row0 + ai * HALF + m * 16);
#pragma unroll
                    for (int bj = 0; bj < 2; ++bj) { const f32x4 v0 = acc[ai][bj][m][0], v1 = acc[ai][bj][m][1]; const u32x2 g = gq[m][bj]; const u32x4 p = pm[m][bj];
                        constexpr float q_ = 1.0f / 255.0f; float o[8];
                        o[0] = v0[0] * (float)(g.x & 255u) * q_ + bf_lo(p.x); o[1] = v0[1] * (float)((g.x >> 8) & 255u) * q_ + bf_hi(p.x); o[2] = v0[2] * (float)((g.x >> 16) & 255u) * q_ + bf_lo(p.y); o[3] = v0[3] * (float)(g.x >> 24) * q_ + bf_hi(p.y);
                        o[4] = v1[0] * (float)(g.y & 255u) * q_ + bf_lo(p.z); o[5] = v1[1] * (float)((g.y >> 8) & 255u) * q_ + bf_hi(p.z); o[6] = v1[2] * (float)((g.y >> 16) & 255u) * q_ + bf_lo(p.w); o[7] = v1[3] * (float)(g.y >> 24) * q_ + bf_hi(p.w);
                        u32x4 w; w.x = cvt_pk_bf16(o[0], o[1]); w.y = cvt_pk_bf16(o[2], o[3]); w.z = cvt_pk_bf16(o[4], o[5]); w.w = cvt_pk_bf16(o[6], o[7]);
                        *(u32x4*)(Mo + r * ldm + col0 + bj * HALF) = w; } } }
        }
    }
};
template <int NK> struct MultiOrder {
    StaticOrder S;
    __device__ __forceinline__ bool next(int i, Unit& u) const { const int ti = i / NK; if (!S.next(ti, u)) return false; u.kind = i - ti * NK; return true; }
    __device__ __forceinline__ void a_ready(const Unit&) const {}
    __device__ __forceinline__ void done(const Unit&) const {}
};
__device__ __forceinline__ float shfl_x(float v, int m, int ln) { return __builtin_bit_cast(float, __builtin_amdgcn_ds_bpermute((ln ^ m) << 2, __builtin_bit_cast(int, v))); }
__device__ __forceinline__ void fast_sincos(float ang, float& sn, float& cs) { float rv = ang * 0.15915494309189535f; rv = rv - floorf(rv); sn = __builtin_amdgcn_sinf(rv); cs = __builtin_amdgcn_cosf(rv); }
__device__ __forceinline__ float inv_freq16(int i) { return __builtin_amdgcn_exp2f(-(float)i * (13.287712379549449f / 16.0f)); }
struct HeadRow { float t[2][2][4]; };
struct EpiProj {
    static constexpr bool PERM = true, AFTER_DRAIN = false, PREFETCH = false;
    bf16_t* QKV; bf16_t* CLAT; float* SSQ; const int* pos; const float *g_q_dil, *g_k_dil, *g_q_win, *g_k_win, *g_kr; float qscale;
    __device__ __forceinline__ void operator()(const f32x4 (&acc)[2][2][4][2], const Unit& u, int wr, int wc, int, int) const {
        const int ln = hw_lane(), fr = ln & 15, fq = ln >> 4;
        const int row0 = u.pm * BM + wr * 64 + fr;
        if (u.pn < 12) {
            const int hq = 4 * u.pn + wc;
            const float* g = nullptr; float post = 1.0f;
            if (hq < 12) { g = g_q_dil; post = qscale; } else if (hq < 24) g = g_k_dil; else if (hq >= 36 && hq < 44) { g = g_q_win; post = qscale; } else if (hq >= 44 && hq < 46) g = g_k_win;
            f32x4 gv[2][2];
#pragma unroll
            for (int bj = 0; bj < 2; ++bj)
#pragma unroll
                for (int n = 0; n < 2; ++n) gv[bj][n] = g ? *(const f32x4*)(g + 32 * bj + 8 * fq + 4 * n) : (f32x4){1.f, 1.f, 1.f, 1.f};
#pragma unroll
            for (int ai = 0; ai < 2; ++ai)
#pragma unroll
                for (int m = 0; m < 4; ++m) { float r = 1.0f;
                    if (g) { float ss = 0.f;
#pragma unroll
                        for (int bj = 0; bj < 2; ++bj)
#pragma unroll
                            for (int n = 0; n < 2; ++n) { const f32x4 v = acc[ai][bj][m][n]; ss += (v[0] * v[0] + v[1] * v[1]) + (v[2] * v[2] + v[3] * v[3]); }
                        ss += shfl_x(ss, 16, ln); ss += shfl_x(ss, 32, ln);
                        r = __builtin_amdgcn_rsqf(ss * (1.0f / 64) + 1e-6f) * post; }
                    bf16_t* rowp = QKV + (size_t)(row0 + ai * HALF + m * 16) * 3072 + hq * 64 + 8 * fq;
#pragma unroll
                    for (int bj = 0; bj < 2; ++bj) { const f32x4 v0 = acc[ai][bj][m][0] * gv[bj][0] * r, v1 = acc[ai][bj][m][1] * gv[bj][1] * r;
                        u32x4 w; w.x = cvt_pk_bf16(v0[0], v0[1]); w.y = cvt_pk_bf16(v0[2], v0[3]); w.z = cvt_pk_bf16(v1[0], v1[1]); w.w = cvt_pk_bf16(v1[2], v1[3]);
                        *(u32x4*)(rowp + 32 * bj) = w; } }
        } else if (u.pn < 15) {
            const int ct = u.pn - 12, col0 = ct * BM + wc * 32 + 8 * fq;
#pragma unroll
            for (int ai = 0; ai < 2; ++ai)
#pragma unroll
                for (int m = 0; m < 4; ++m) { const int row = row0 + ai * HALF + m * 16; float ss = 0.f;
#pragma unroll
                    for (int bj = 0; bj < 2; ++bj) { const f32x4 v0 = acc[ai][bj][m][0], v1 = acc[ai][bj][m][1];
                        ss += (v0[0] * v0[0] + v0[1] * v0[1]) + (v0[2] * v0[2] + v0[3] * v0[3]) + (v1[0] * v1[0] + v1[1] * v1[1]) + (v1[2] * v1[2] + v1[3] * v1[3]);
                        u32x4 w; w.x = cvt_pk_bf16(v0[0], v0[1]); w.y = cvt_pk_bf16(v0[2], v0[3]); w.z = cvt_pk_bf16(v1[0], v1[1]); w.w = cvt_pk_bf16(v1[2], v1[3]);
                        *(u32x4*)(CLAT + (size_t)row * 1024 + col0 + bj * HALF) = w; }
                    ss += shfl_x(ss, 16, ln); ss += shfl_x(ss, 32, ln);
                    if (fq == 0) SSQ[(size_t)row * 12 + ct * 4 + wc] = ss; }
        } else if (wc == 0) {
            const float i0 = inv_freq16(8 * (fq & 1) + 0), i1 = inv_freq16(8 * (fq & 1) + 1), i2 = inv_freq16(8 * (fq & 1) + 2), i3 = inv_freq16(8 * (fq & 1) + 3);
            const float i4 = inv_freq16(8 * (fq & 1) + 4), i5 = inv_freq16(8 * (fq & 1) + 5), i6 = inv_freq16(8 * (fq & 1) + 6), i7 = inv_freq16(8 * (fq & 1) + 7);
            const float ifr[8] = {i0, i1, i2, i3, i4, i5, i6, i7};
            const f32x4 g0 = *(const f32x4*)(g_kr + 8 * fq), g1 = *(const f32x4*)(g_kr + 8 * fq + 4);
            float psv[2][4];
#pragma unroll
            for (int ai = 0; ai < 2; ++ai)
#pragma unroll
                for (int m = 0; m < 4; ++m) psv[ai][m] = (float)pos[row0 + ai * HALF + m * 16];
#pragma unroll
            for (int ai = 0; ai < 2; ++ai)
#pragma unroll
                for (int m = 0; m < 4; ++m) { const int row = row0 + ai * HALF + m * 16; const f32x4 v0 = acc[ai][0][m][0], v1 = acc[ai][0][m][1];
                    float ss = (v0[0] * v0[0] + v0[1] * v0[1]) + (v0[2] * v0[2] + v0[3] * v0[3]) + (v1[0] * v1[0] + v1[1] * v1[1]) + (v1[2] * v1[2] + v1[3] * v1[3]);
                    ss += shfl_x(ss, 16, ln); ss += shfl_x(ss, 32, ln);
                    const float r = __builtin_amdgcn_rsqf(ss * (1.0f / 32) + 1e-6f); const float ps = psv[ai][m];
                    const f32x4 a0 = v0 * g0 * r, a1 = v1 * g1 * r; float o[8];
#pragma unroll
                    for (int e = 0; e < 8; ++e) { const float vn = e < 4 ? a0[e] : a1[e - 4]; const float pr = shfl_x(vn, 32, ln); float sn, cs; fast_sincos(ps * ifr[e], sn, cs);
                        o[e] = (fq & 2) ? (pr * sn + vn * cs) : (vn * cs - pr * sn); }
                    u32x4 w; w.x = cvt_pk_bf16(o[0], o[1]); w.y = cvt_pk_bf16(o[2], o[3]); w.z = cvt_pk_bf16(o[4], o[5]); w.w = cvt_pk_bf16(o[6], o[7]);
                    *(u32x4*)(CLAT + (size_t)row * 1024 + 768 + 8 * fq) = w; }
        }
    }
};
struct EpiQ {
    static constexpr bool PERM = true, AFTER_DRAIN = false, PREFETCH = false;
    bf16_t* QM; const float* SSQ; const int* pos; const float* g_q; float qscale;
    __device__ __forceinline__ void operator()(const f32x4 (&acc)[2][2][4][2], const Unit& u, int wr, int wc, int, int) const {
        const int ln = hw_lane(), fr = ln & 15, fq = ln >> 4;
        const int row0 = u.pm * BM + wr * 64 + fr;
        float rqv[2][4];
#pragma unroll
        for (int ai = 0; ai < 2; ++ai)
#pragma unroll
            for (int m = 0; m < 4; ++m) { const int row = row0 + ai * HALF + m * 16; const f32x4 s0 = *(const f32x4*)(SSQ + (size_t)row * 12), s1 = *(const f32x4*)(SSQ + (size_t)row * 12 + 4);
                rqv[ai][m] = __builtin_amdgcn_rsqf(((s0[0] + s0[1]) + (s0[2] + s0[3]) + (s1[0] + s1[1]) + (s1[2] + s1[3])) * (1.0f / 512) + 1e-6f); }
        if (u.pn < 2) {
            const int h = 4 * u.pn + wc; f32x4 gv[2][2];
#pragma unroll
            for (int bj = 0; bj < 2; ++bj)
#pragma unroll
                for (int n = 0; n < 2; ++n) gv[bj][n] = *(const f32x4*)(g_q + 32 * bj + 8 * fq + 4 * n);
#pragma unroll
            for (int ai = 0; ai < 2; ++ai)
#pragma unroll
                for (int m = 0; m < 4; ++m) { const int row = row0 + ai * HALF + m * 16;
                    const float rq = rqv[ai][m];
                    float ss = 0.f;
#pragma unroll
                    for (int bj = 0; bj < 2; ++bj)
#pragma unroll
                        for (int n = 0; n < 2; ++n) { const f32x4 v = acc[ai][bj][m][n] * rq; ss += (v[0] * v[0] + v[1] * v[1]) + (v[2] * v[2] + v[3] * v[3]); }
                    ss += shfl_x(ss, 16, ln); ss += shfl_x(ss, 32, ln);
                    const float r = __builtin_amdgcn_rsqf(ss * (1.0f / 64) + 1e-6f) * rq * qscale;
                    bf16_t* rowp = QM + (size_t)row * 768 + h * 96 + 8 * fq;
#pragma unroll
                    for (int bj = 0; bj < 2; ++bj) { const f32x4 v0 = acc[ai][bj][m][0] * gv[bj][0] * r, v1 = acc[ai][bj][m][1] * gv[bj][1] * r;
                        u32x4 w; w.x = cvt_pk_bf16(v0[0], v0[1]); w.y = cvt_pk_bf16(v0[2], v0[3]); w.z = cvt_pk_bf16(v1[0], v1[1]); w.w = cvt_pk_bf16(v1[2], v1[3]);
                        *(u32x4*)(rowp + 32 * bj) = w; } }
        } else {
            float ifr[8];
#pragma unroll
            for (int e = 0; e < 8; ++e) ifr[e] = inv_freq16(8 * (fq & 1) + e);
            const f32x4 g0 = *(const f32x4*)(g_q + 64 + 8 * fq), g1 = *(const f32x4*)(g_q + 64 + 8 * fq + 4);
            float psv[2][4];
#pragma unroll
            for (int ai = 0; ai < 2; ++ai)
#pragma unroll
                for (int m = 0; m < 4; ++m) psv[ai][m] = (float)pos[row0 + ai * HALF + m * 16];
#pragma unroll
            for (int ai = 0; ai < 2; ++ai)
#pragma unroll
                for (int m = 0; m < 4; ++m) { const int row = row0 + ai * HALF + m * 16;
                    const float rq = rqv[ai][m];
                    const float ps = psv[ai][m]; float sn[8], cs[8];
#pragma unroll
                    for (int e = 0; e < 8; ++e) fast_sincos(ps * ifr[e], sn[e], cs[e]);
#pragma unroll
                    for (int bj = 0; bj < 2; ++bj) { const int h = 2 * wc + bj; const f32x4 v0 = acc[ai][bj][m][0] * rq, v1 = acc[ai][bj][m][1] * rq;
                        float ss = (v0[0] * v0[0] + v0[1] * v0[1]) + (v0[2] * v0[2] + v0[3] * v0[3]) + (v1[0] * v1[0] + v1[1] * v1[1]) + (v1[2] * v1[2] + v1[3] * v1[3]);
                        ss += shfl_x(ss, 16, ln); ss += shfl_x(ss, 32, ln);
                        const float r = __builtin_amdgcn_rsqf(ss * (1.0f / 32) + 1e-6f); const f32x4 a0 = v0 * g0 * r, a1 = v1 * g1 * r; float o[8];
#pragma unroll
                        for (int e = 0; e < 8; ++e) { const float vn = e < 4 ? a0[e] : a1[e - 4]; const float pr = shfl_x(vn, 32, ln);
                            o[e] = ((fq & 2) ? (pr * sn[e] + vn * cs[e]) : (vn * cs[e] - pr * sn[e])) * qscale; }
                        u32x4 w; w.x = cvt_pk_bf16(o[0], o[1]); w.y = cvt_pk_bf16(o[2], o[3]); w.z = cvt_pk_bf16(o[4], o[5]); w.w = cvt_pk_bf16(o[6], o[7]);
                        *(u32x4*)(QM + (size_t)row * 768 + h * 96 + 64 + 8 * fq) = w; } }
        }
    }
};
struct EpiKV {
    static constexpr bool PERM = true, AFTER_DRAIN = false, PREFETCH = false;
    bf16_t* KVM; const float* SSQ; const float* g_k;
    __device__ __forceinline__ void operator()(const f32x4 (&acc)[2][2][4][2], const Unit& u, int wr, int wc, int, int) const {
        const int ln = hw_lane(), fr = ln & 15, fq = ln >> 4;
        const int row0 = u.pm * BM + wr * 64 + fr; const int h16 = 4 * u.pn + wc; const bool isk = (h16 & 1) == 0;
        f32x4 gv[2][2];
#pragma unroll
        for (int bj = 0; bj < 2; ++bj)
#pragma unroll
            for (int n = 0; n < 2; ++n) gv[bj][n] = isk ? *(const f32x4*)(g_k + 32 * bj + 8 * fq + 4 * n) : (f32x4){1.f, 1.f, 1.f, 1.f};
        float rkv[2][4];
#pragma unroll
        for (int ai = 0; ai < 2; ++ai)
#pragma unroll
            for (int m = 0; m < 4; ++m) { const int row = row0 + ai * HALF + m * 16; const f32x4 s2 = *(const f32x4*)(SSQ + (size_t)row * 12 + 8);
                rkv[ai][m] = __builtin_amdgcn_rsqf(((s2[0] + s2[1]) + (s2[2] + s2[3])) * (1.0f / 256) + 1e-6f); }
#pragma unroll
        for (int ai = 0; ai < 2; ++ai)
#pragma unroll
            for (int m = 0; m < 4; ++m) { const int row = row0 + ai * HALF + m * 16;
                const float rk = rkv[ai][m];
                float r = rk;
                if (isk) { float ss = 0.f;
#pragma unroll
                    for (int bj = 0; bj < 2; ++bj)
#pragma unroll
                        for (int n = 0; n < 2; ++n) { const f32x4 v = acc[ai][bj][m][n] * rk; ss += (v[0] * v[0] + v[1] * v[1]) + (v[2] * v[2] + v[3] * v[3]); }
                    ss += shfl_x(ss, 16, ln); ss += shfl_x(ss, 32, ln);
                    r = __builtin_amdgcn_rsqf(ss * (1.0f / 64) + 1e-6f) * rk; }
                bf16_t* rowp = KVM + (size_t)row * 1024 + h16 * 64 + 8 * fq;
#pragma unroll
                for (int bj = 0; bj < 2; ++bj) { const f32x4 v0 = acc[ai][bj][m][0] * gv[bj][0] * r, v1 = acc[ai][bj][m][1] * gv[bj][1] * r;
                    u32x4 w; w.x = cvt_pk_bf16(v0[0], v0[1]); w.y = cvt_pk_bf16(v0[2], v0[3]); w.z = cvt_pk_bf16(v1[0], v1[1]); w.w = cvt_pk_bf16(v1[2], v1[3]);
                    *(u32x4*)(rowp + 32 * bj) = w; }
                }
    }
};


struct EpiScatterY {
    static constexpr bool PERM = true, AFTER_DRAIN = false, PREFETCH = false;
    bf16_t* Y; const int* slot;
    __device__ __forceinline__ void operator()(const f32x4 (&acc)[2][2][4][2], const Unit& u, int wr, int wc, int, int) const {
        const int ln_ = hw_lane(), fr = ln_ & 15, fq = ln_ >> 4;
        const int row0 = u.pm * BM + wr * 64 + fr, col0 = (u.pn & 3) * BM + wc * 32 + 8 * fq;
        int sl[2][4];
#pragma unroll
        for (int ai = 0; ai < 2; ++ai)
#pragma unroll
            for (int m = 0; m < 4; ++m) sl[ai][m] = slot[row0 + ai * HALF + m * 16];
#pragma unroll
        for (int ai = 0; ai < 2; ++ai)
#pragma unroll
            for (int m = 0; m < 4; ++m) { if (sl[ai][m] >= 0) { bf16_t* rowp = Y + (size_t)sl[ai][m] * 1024 + col0;
#pragma unroll
                    for (int bj = 0; bj < 2; ++bj) { const f32x4 v0 = acc[ai][bj][m][0], v1 = acc[ai][bj][m][1];
                        u32x4 w; w.x = cvt_pk_bf16(v0[0], v0[1]); w.y = cvt_pk_bf16(v0[2], v0[3]); w.z = cvt_pk_bf16(v1[0], v1[1]); w.w = cvt_pk_bf16(v1[2], v1[3]);
                        *(u32x4*)(rowp + bj * HALF) = w; } } }
    }
};
template <class Epi, class Sched, bool ALIGN_EPI = false, bool SP2 = false>
__device__ __forceinline__ void gemm_phase(PG8_LAS unsigned char* lds, const Gemm g, const Sched& S, const Epi& E) {
    const int wid = g.wv, lane = hw_lane(), tid = (wid << 6) | lane,
              wr = wid >> 2, wc = wid & 3, fr = lane & 15, fq = lane >> 4;
    const int K = g.K, nt = K / BK;
    unsigned voffA[2], voffB[2];
#pragma unroll
    for (int i = 0; i < 2; ++i) { int R, C; stage_rc(tid * 16 + i * 8192, R, C); const int Rb = Epi::PERM ? ((R & ~31) + perm32(R & 31)) : R;
        voffA[i] = (unsigned)(R * g.lda + C) * 2u; voffB[i] = (unsigned)(Rb * g.ldb + C) * 2u; }
    const size_t kstep = (size_t)(BK * 2);
    const size_t hstepA = (size_t)HALF * g.lda * 2, hstepB = (size_t)HALF * g.ldb * 2;
    const size_t tstepA = 2 * hstepA, tstepB = 2 * hstepB;
    const unsigned ldsw = (unsigned)wid * 1024u;
    const int aoff = lds_byte(wr * 64 + fr, fq * 8), boff = lds_byte(wc * 32 + fr, fq * 8);
#define PG8_SA(b, h) (((b) * 2 + (h)) * HTB)
#define PG8_SB(b, h) ((4 + (b) * 2 + (h)) * HTB)
#define PG8_STAGE(bufoff, gbase, voff) do { _Pragma("unroll") for (int _i = 0; _i < 2; ++_i) \
        __builtin_amdgcn_global_load_lds((const unsigned*)((const char*)(gbase) + (voff)[_i]), (PG8_LAS unsigned*)(lds + (bufoff) + ldsw + _i * 8192), 16, 0, 0); } while (0)
#define PG8_LDA(dst, b, h) do { _Pragma("unroll") for (int m = 0; m < 4; ++m) _Pragma("unroll") for (int k = 0; k < 2; ++k) dst[m][k] = *(const PG8_LAS bf16x8*)(lds + PG8_SA(b, h) + aoff + m * 2048 + k * 1024); } while (0)
#define PG8_LDB(dst, b, h) do { _Pragma("unroll") for (int n = 0; n < 2; ++n) _Pragma("unroll") for (int k = 0; k < 2; ++k) dst[n][k] = *(const PG8_LAS bf16x8*)(lds + PG8_SB(b, h) + boff + n * 2048 + k * 1024); } while (0)
#define PG8_MMA(ai, bj, At, Bt) do { __builtin_amdgcn_s_setprio(1); _Pragma("unroll") for (int m = 0; m < 4; ++m) _Pragma("unroll") for (int n = 0; n < 2; ++n) _Pragma("unroll") for (int k = 0; k < 2; ++k) \
        acc[ai][bj][m][n] = __builtin_amdgcn_mfma_f32_16x16x32_bf16(Bt[n][k], At[m][k], acc[ai][bj][m][n], 0, 0, 0); __builtin_amdgcn_s_setprio(0); } while (0)
#define PG8_WAIT_V(n) asm volatile("s_waitcnt vmcnt(" #n ")" ::: "memory")
#define PG8_WAIT_L(n) asm volatile("s_waitcnt lgkmcnt(" #n ")" ::: "memory")
#define PG8_BAR __builtin_amdgcn_s_barrier()
#define PG8_SCHED __builtin_amdgcn_sched_barrier(0)
    Unit cur, nxt; int ui = 0;
    if (!S.next(0, cur)) return;
    f32x4 acc[2][2][4][2];
#pragma unroll
    for (int a = 0; a < 2; ++a)
#pragma unroll
        for (int b = 0; b < 2; ++b)
#pragma unroll
            for (int m = 0; m < 4; ++m)
#pragma unroll
                for (int n = 0; n < 2; ++n) acc[a][b][m][n] = (f32x4){0.f, 0.f, 0.f, 0.f};
    bf16x8 At[4][2] = {}, B0[2][2] = {}, B1[2][2] = {};
    const char* cA = (const char*)g.A + (size_t)cur.pm * tstepA; const char* cB = (const char*)g.Bt + (size_t)cur.pn * tstepB;
    S.a_ready(cur);
    if constexpr (SP2) {
        PG8_STAGE(PG8_SB(0, 0), cB, voffB); PG8_STAGE(PG8_SB(0, 1), cB + hstepB, voffB); PG8_STAGE(PG8_SA(0, 0), cA, voffA); PG8_STAGE(PG8_SA(0, 1), cA + hstepA, voffA);
        if (wr == 1) PG8_BAR;
        PG8_WAIT_V(2); PG8_BAR;
        PG8_STAGE(PG8_SB(1, 0), cB + kstep, voffB); PG8_STAGE(PG8_SA(1, 0), cA + kstep, voffA); PG8_STAGE(PG8_SB(1, 1), cB + hstepB + kstep, voffB);
        PG8_WAIT_V(6); PG8_BAR;
    } else {
        PG8_STAGE(PG8_SB(0, 0), cB, voffB); PG8_STAGE(PG8_SA(0, 0), cA, voffA); PG8_STAGE(PG8_SB(0, 1), cB + hstepB, voffB); PG8_STAGE(PG8_SA(0, 1), cA + hstepA, voffA);
        if (wr == 1) PG8_BAR;
        PG8_WAIT_V(4); PG8_BAR;
        PG8_STAGE(PG8_SB(1, 0), cB + kstep, voffB); PG8_STAGE(PG8_SA(1, 0), cA + kstep, voffA); PG8_STAGE(PG8_SB(1, 1), cB + hstepB + kstep, voffB);
        PG8_WAIT_V(6); PG8_BAR;
    }
    for (;;) {
        const bool has_next = S.next(ui + 1, nxt);
        const char* nA = has_next ? (const char*)g.A + (size_t)nxt.pm * tstepA : cA; const char* nB = has_next ? (const char*)g.Bt + (size_t)nxt.pn * tstepB : cB;
        if constexpr (Epi::PREFETCH) E.prefetch(cur, lds + STAGE_BYTES + 16384 + 13312 + wid * 256, wid, lane);
        for (int t = 0; t < nt; t += 2) {
            const bool last = (t == nt - 2);
            const char* a1 = cA + (size_t)(t + 1) * kstep;
            const char* a2 = last ? nA : cA + (size_t)(t + 2) * kstep; const char* b2 = last ? nB : cB + (size_t)(t + 2) * kstep;
            const char* a3 = a2 + kstep; const char* b3 = b2 + kstep;
            if (last && has_next) S.a_ready(nxt);
            if constexpr (SP2) {
            PG8_LDB(B0, 0, 0); PG8_LDB(B1, 0, 1); PG8_SCHED; PG8_LDA(At, 0, 0); PG8_STAGE(PG8_SA(1, 1), a1 + hstepA, voffA);
            PG8_WAIT_V(8); PG8_WAIT_L(0); PG8_BAR; PG8_MMA(0, 0, At, B0); PG8_MMA(0, 1, At, B1); PG8_BAR; PG8_SCHED;
            PG8_LDA(At, 0, 1); PG8_STAGE(PG8_SB(0, 0), b2, voffB); PG8_STAGE(PG8_SB(0, 1), b2 + hstepB, voffB); PG8_STAGE(PG8_SA(0, 0), a2, voffA);
            PG8_WAIT_V(8); PG8_WAIT_L(0); PG8_BAR; PG8_MMA(1, 0, At, B0); PG8_MMA(1, 1, At, B1); PG8_BAR; PG8_SCHED;
            PG8_LDB(B0, 1, 0); PG8_LDB(B1, 1, 1); PG8_SCHED; PG8_LDA(At, 1, 0); PG8_STAGE(PG8_SA(0, 1), a2 + hstepA, voffA);
            PG8_WAIT_V(8); PG8_WAIT_L(0); PG8_BAR; PG8_MMA(0, 0, At, B0); PG8_MMA(0, 1, At, B1); PG8_BAR; PG8_SCHED;
            PG8_LDA(At, 1, 1); PG8_STAGE(PG8_SB(1, 0), b3, voffB); PG8_STAGE(PG8_SB(1, 1), b3 + hstepB, voffB); PG8_STAGE(PG8_SA(1, 0), a3, voffA);
            PG8_WAIT_V(8); PG8_WAIT_L(0); PG8_BAR; PG8_MMA(1, 0, At, B0); PG8_MMA(1, 1, At, B1); PG8_BAR; PG8_SCHED;
            } else {
            PG8_LDB(B0, 0, 0); PG8_SCHED; PG8_LDA(At, 0, 0); PG8_STAGE(PG8_SA(1, 1), a1 + hstepA, voffA);
            PG8_WAIT_L(8); PG8_BAR; PG8_WAIT_L(0); PG8_MMA(0, 0, At, B0); PG8_BAR; PG8_SCHED;
            PG8_LDB(B1, 0, 1); PG8_STAGE(PG8_SB(0, 0), b2, voffB);
            PG8_BAR; PG8_WAIT_L(0); PG8_MMA(0, 1, At, B1); PG8_BAR;
            PG8_LDA(At, 0, 1); PG8_STAGE(PG8_SA(0, 0), a2, voffA);
            PG8_BAR; PG8_WAIT_L(0); PG8_MMA(1, 0, At, B0); PG8_BAR; PG8_SCHED;
            PG8_STAGE(PG8_SB(0, 1), b2 + hstepB, voffB);
            PG8_WAIT_V(6); PG8_BAR; PG8_MMA(1, 1, At, B1); PG8_BAR;
            PG8_LDB(B0, 1, 0); PG8_SCHED; PG8_LDA(At, 1, 0); PG8_STAGE(PG8_SA(0, 1), a2 + hstepA, voffA);
            PG8_WAIT_L(8); PG8_BAR; PG8_WAIT_L(0); PG8_MMA(0, 0, At, B0); PG8_BAR; PG8_SCHED;
            PG8_LDB(B1, 1, 1); PG8_STAGE(PG8_SB(1, 0), b3, voffB);
            PG8_BAR; PG8_WAIT_L(0); PG8_MMA(0, 1, At, B1); PG8_BAR;
            PG8_LDA(At, 1, 1); PG8_STAGE(PG8_SA(1, 0), a3, voffA);
            PG8_BAR; PG8_WAIT_L(0); PG8_MMA(1, 0, At, B0); PG8_BAR; PG8_SCHED;
            PG8_STAGE(PG8_SB(1, 1), b3 + hstepB, voffB);
            PG8_WAIT_V(6); PG8_BAR; PG8_MMA(1, 1, At, B1); PG8_BAR;
            }
        }
        if constexpr (ALIGN_EPI) { if (wr == 0) PG8_BAR; }
        if constexpr (!Epi::AFTER_DRAIN) { E(acc, cur, wr, wc, fr, fq); S.done(cur); }
        if (!has_next) break;
#pragma unroll
        for (int a = 0; a < 2; ++a)
#pragma unroll
            for (int b = 0; b < 2; ++b)
#pragma unroll
                for (int m = 0; m < 4; ++m)
#pragma unroll
                    for (int n = 0; n < 2; ++n) acc[a][b][m][n] = (f32x4){0.f, 0.f, 0.f, 0.f};
        cur = nxt; cA = nA; cB = nB; ++ui;
        if constexpr (ALIGN_EPI) { if (wr == 1) PG8_BAR; }
    }
    PG8_WAIT_V(0);
    if constexpr (!ALIGN_EPI) { if (wr == 0) PG8_BAR; }
    PG8_BAR;
    if constexpr (Epi::AFTER_DRAIN) { E.fused(acc, cur, wr, wc, fr, fq, lds, wid, lane); S.done(cur); }
#undef PG8_SA
#undef PG8_SB
#undef PG8_STAGE
#undef PG8_LDA
#undef PG8_LDB
#undef PG8_MMA
#undef PG8_WAIT_V
#undef PG8_WAIT_L
#undef PG8_BAR
#undef PG8_SCHED
}
template <class Epi, class Sched, bool ALIGN_EPI = false, bool SP2 = false>
__device__ __forceinline__ void gemm_phase_multi(PG8_LAS unsigned char* lds, const GemmM g, const Sched& S, const Epi& E) {
    const int wid = g.wv, lane = hw_lane(), tid = (wid << 6) | lane,
              wr = wid >> 2, wc = wid & 3, fr = lane & 15, fq = lane >> 4;
    int stR[2], stRb[2], stC[2];
#pragma unroll
    for (int i = 0; i < 2; ++i) { int R, C; stage_rc(tid * 16 + i * 8192, R, C); stR[i] = R; stRb[i] = Epi::PERM ? ((R & ~31) + perm32(R & 31)) : R; stC[i] = C; }
    unsigned voffA[2], voffB[2], voffAn[2], voffBn[2]; size_t hstepA, hstepB, hstepAn, hstepBn; int nt, ntn;
#define PG8_KIND(kd, vA, vB, hA, hB, ntk) do { const int la_ = g.lda(kd), lb_ = g.ldb(kd); _Pragma("unroll") for (int i = 0; i < 2; ++i) { vA[i] = (unsigned)(stR[i] * la_ + stC[i]) * 2u; vB[i] = (unsigned)(stRb[i] * lb_ + stC[i]) * 2u; } \
        hA = (size_t)HALF * la_ * 2; hB = (size_t)HALF * lb_ * 2; ntk = g.K(kd) / BK; } while (0)
    const size_t kstep = (size_t)(BK * 2);
    const unsigned ldsw = (unsigned)wid * 1024u;
    const int aoff = lds_byte(wr * 64 + fr, fq * 8), boff = lds_byte(wc * 32 + fr, fq * 8);
#define PG8_SA(b, h) (((b) * 2 + (h)) * HTB)
#define PG8_SB(b, h) ((4 + (b) * 2 + (h)) * HTB)
#define PG8_STAGE(bufoff, gbase, voff) do { _Pragma("unroll") for (int _i = 0; _i < 2; ++_i) \
        __builtin_amdgcn_global_load_lds((const unsigned*)((const char*)(gbase) + (voff)[_i]), (PG8_LAS unsigned*)(lds + (bufoff) + ldsw + _i * 8192), 16, 0, 0); } while (0)
#define PG8_LDA(dst, b, h) do { _Pragma("unroll") for (int m = 0; m < 4; ++m) _Pragma("unroll") for (int k = 0; k < 2; ++k) dst[m][k] = *(const PG8_LAS bf16x8*)(lds + PG8_SA(b, h) + aoff + m * 2048 + k * 1024); } while (0)
#define PG8_LDB(dst, b, h) do { _Pragma("unroll") for (int n = 0; n < 2; ++n) _Pragma("unroll") for (int k = 0; k < 2; ++k) dst[n][k] = *(const PG8_LAS bf16x8*)(lds + PG8_SB(b, h) + boff + n * 2048 + k * 1024); } while (0)
#define PG8_MMA(ai, bj, At, Bt) do { __builtin_amdgcn_s_setprio(1); _Pragma("unroll") for (int m = 0; m < 4; ++m) _Pragma("unroll") for (int n = 0; n < 2; ++n) _Pragma("unroll") for (int k = 0; k < 2; ++k) \
        acc[ai][bj][m][n] = __builtin_amdgcn_mfma_f32_16x16x32_bf16(Bt[n][k], At[m][k], acc[ai][bj][m][n], 0, 0, 0); __builtin_amdgcn_s_setprio(0); } while (0)
#define PG8_WAIT_V(n) asm volatile("s_waitcnt vmcnt(" #n ")" ::: "memory")
#define PG8_WAIT_L(n) asm volatile("s_waitcnt lgkmcnt(" #n ")" ::: "memory")
#define PG8_BAR __builtin_amdgcn_s_barrier()
#define PG8_SCHED __builtin_amdgcn_sched_barrier(0)
    Unit cur, nxt; int ui = 0;
    if (!S.next(0, cur)) return;
    f32x4 acc[2][2][4][2];
#pragma unroll
    for (int a = 0; a < 2; ++a)
#pragma unroll
        for (int b = 0; b < 2; ++b)
#pragma unroll
            for (int m = 0; m < 4; ++m)
#pragma unroll
                for (int n = 0; n < 2; ++n) acc[a][b][m][n] = (f32x4){0.f, 0.f, 0.f, 0.f};
    bf16x8 At[4][2] = {}, B0[2][2] = {}, B1[2][2] = {};
    PG8_KIND(cur.kind, voffA, voffB, hstepA, hstepB, nt);
    const char* cA = (const char*)g.Ap(cur.kind) + (size_t)cur.pm * 2 * hstepA; const char* cB = (const char*)g.Bp(cur.kind) + (size_t)cur.pn * 2 * hstepB;
    S.a_ready(cur);
    if constexpr (SP2) {
        PG8_STAGE(PG8_SB(0, 0), cB, voffB); PG8_STAGE(PG8_SB(0, 1), cB + hstepB, voffB); PG8_STAGE(PG8_SA(0, 0), cA, voffA); PG8_STAGE(PG8_SA(0, 1), cA + hstepA, voffA);
        if (wr == 1) PG8_BAR;
        PG8_WAIT_V(2); PG8_BAR;
        PG8_STAGE(PG8_SB(1, 0), cB + kstep, voffB); PG8_STAGE(PG8_SA(1, 0), cA + kstep, voffA); PG8_STAGE(PG8_SB(1, 1), cB + hstepB + kstep, voffB);
        PG8_WAIT_V(6); PG8_BAR;
    } else {
        PG8_STAGE(PG8_SB(0, 0), cB, voffB); PG8_STAGE(PG8_SA(0, 0), cA, voffA); PG8_STAGE(PG8_SB(0, 1), cB + hstepB, voffB); PG8_STAGE(PG8_SA(0, 1), cA + hstepA, voffA);
        if (wr == 1) PG8_BAR;
        PG8_WAIT_V(4); PG8_BAR;
        PG8_STAGE(PG8_SB(1, 0), cB + kstep, voffB); PG8_STAGE(PG8_SA(1, 0), cA + kstep, voffA); PG8_STAGE(PG8_SB(1, 1), cB + hstepB + kstep, voffB);
        PG8_WAIT_V(6); PG8_BAR;
    }
    for (;;) {
        const bool has_next = S.next(ui + 1, nxt);
        const int nkind = has_next ? nxt.kind : cur.kind;
        PG8_KIND(nkind, voffAn, voffBn, hstepAn, hstepBn, ntn);
        const char* nA = has_next ? (const char*)g.Ap(nkind) + (size_t)nxt.pm * 2 * hstepAn : cA; const char* nB = has_next ? (const char*)g.Bp(nkind) + (size_t)nxt.pn * 2 * hstepBn : cB;
        if constexpr (Epi::PREFETCH) E.prefetch(cur, lds + STAGE_BYTES + 16384 + 13312 + wid * 256, wid, lane);
        for (int t = 0; t < nt; t += 2) {
            const bool last = (t == nt - 2);
            const char* a1 = cA + (size_t)(t + 1) * kstep;
            const char* a2 = last ? nA : cA + (size_t)(t + 2) * kstep; const char* b2 = last ? nB : cB + (size_t)(t + 2) * kstep;
            const char* a3 = a2 + kstep; const char* b3 = b2 + kstep;
            unsigned vA2[2], vB2[2];
#pragma unroll
            for (int i = 0; i < 2; ++i) { vA2[i] = last ? voffAn[i] : voffA[i]; vB2[i] = last ? voffBn[i] : voffB[i]; }
            const size_t hA2 = last ? hstepAn : hstepA, hB2 = last ? hstepBn : hstepB;
            if (last && has_next) S.a_ready(nxt);
            if constexpr (SP2) {
            PG8_LDB(B0, 0, 0); PG8_LDB(B1, 0, 1); PG8_SCHED; PG8_LDA(At, 0, 0); PG8_STAGE(PG8_SA(1, 1), a1 + hstepA, voffA);
            PG8_WAIT_V(8); PG8_WAIT_L(0); PG8_BAR; PG8_MMA(0, 0, At, B0); PG8_MMA(0, 1, At, B1); PG8_BAR; PG8_SCHED;
            PG8_LDA(At, 0, 1); PG8_STAGE(PG8_SB(0, 0), b2, vB2); PG8_STAGE(PG8_SB(0, 1), b2 + hB2, vB2); PG8_STAGE(PG8_SA(0, 0), a2, vA2);
            PG8_WAIT_V(8); PG8_WAIT_L(0); PG8_BAR; PG8_MMA(1, 0, At, B0); PG8_MMA(1, 1, At, B1); PG8_BAR; PG8_SCHED;
            PG8_LDB(B0, 1, 0); PG8_LDB(B1, 1, 1); PG8_SCHED; PG8_LDA(At, 1, 0); PG8_STAGE(PG8_SA(0, 1), a2 + hA2, vA2);
            PG8_WAIT_V(8); PG8_WAIT_L(0); PG8_BAR; PG8_MMA(0, 0, At, B0); PG8_MMA(0, 1, At, B1); PG8_BAR; PG8_SCHED;
            PG8_LDA(At, 1, 1); PG8_STAGE(PG8_SB(1, 0), b3, vB2); PG8_STAGE(PG8_SB(1, 1), b3 + hB2, vB2); PG8_STAGE(PG8_SA(1, 0), a3, vA2);
            PG8_WAIT_V(8); PG8_WAIT_L(0); PG8_BAR; PG8_MMA(1, 0, At, B0); PG8_MMA(1, 1, At, B1); PG8_BAR; PG8_SCHED;
            } else {
            PG8_LDB(B0, 0, 0); PG8_SCHED; PG8_LDA(At, 0, 0); PG8_STAGE(PG8_SA(1, 1), a1 + hstepA, voffA);
            PG8_WAIT_L(8); PG8_BAR; PG8_WAIT_L(0); PG8_MMA(0, 0, At, B0); PG8_BAR; PG8_SCHED;
            PG8_LDB(B1, 0, 1); PG8_STAGE(PG8_SB(0, 0), b2, vB2);
            PG8_BAR; PG8_WAIT_L(0); PG8_MMA(0, 1, At, B1); PG8_BAR;
            PG8_LDA(At, 0, 1); PG8_STAGE(PG8_SA(0, 0), a2, vA2);
            PG8_BAR; PG8_WAIT_L(0); PG8_MMA(1, 0, At, B0); PG8_BAR; PG8_SCHED;
            PG8_STAGE(PG8_SB(0, 1), b2 + hB2, vB2);
            PG8_WAIT_V(6); PG8_BAR; PG8_MMA(1, 1, At, B1); PG8_BAR;
            PG8_LDB(B0, 1, 0); PG8_SCHED; PG8_LDA(At, 1, 0); PG8_STAGE(PG8_SA(0, 1), a2 + hA2, vA2);
            PG8_WAIT_L(8); PG8_BAR; PG8_WAIT_L(0); PG8_MMA(0, 0, At, B0); PG8_BAR; PG8_SCHED;
            PG8_LDB(B1, 1, 1); PG8_STAGE(PG8_SB(1, 0), b3, vB2);
            PG8_BAR; PG8_WAIT_L(0); PG8_MMA(0, 1, At, B1); PG8_BAR;
            PG8_LDA(At, 1, 1); PG8_STAGE(PG8_SA(1, 0), a3, vA2);
            PG8_BAR; PG8_WAIT_L(0); PG8_MMA(1, 0, At, B0); PG8_BAR; PG8_SCHED;
            PG8_STAGE(PG8_SB(1, 1), b3 + hB2, vB2);
            PG8_WAIT_V(6); PG8_BAR; PG8_MMA(1, 1, At, B1); PG8_BAR;
            }
        }
        if constexpr (ALIGN_EPI) { if (wr == 0) PG8_BAR; }
        if constexpr (!Epi::AFTER_DRAIN) { E(acc, cur, wr, wc, fr, fq); S.done(cur); }
        if (!has_next) break;
#pragma unroll
        for (int a = 0; a < 2; ++a)
#pragma unroll
            for (int b = 0; b < 2; ++b)
#pragma unroll
                for (int m = 0; m < 4; ++m)
#pragma unroll
                    for (int n = 0; n < 2; ++n) acc[a][b][m][n] = (f32x4){0.f, 0.f, 0.f, 0.f};
        cur = nxt; cA = nA; cB = nB; ++ui;
#pragma unroll
        for (int i = 0; i < 2; ++i) { voffA[i] = voffAn[i]; voffB[i] = voffBn[i]; }
        hstepA = hstepAn; hstepB = hstepBn; nt = ntn;
        if constexpr (ALIGN_EPI) { if (wr == 1) PG8_BAR; }
    }
    PG8_WAIT_V(0);
    if constexpr (!ALIGN_EPI) { if (wr == 0) PG8_BAR; }
    PG8_BAR;
    if constexpr (Epi::AFTER_DRAIN) { E.fused(acc, cur, wr, wc, fr, fq, lds, wid, lane); S.done(cur); }
#undef PG8_KIND
#undef PG8_SA
#undef PG8_SB
#undef PG8_STAGE
#undef PG8_LDA
#undef PG8_LDB
#undef PG8_MMA
#undef PG8_WAIT_V
#undef PG8_WAIT_L
#undef PG8_BAR
#undef PG8_SCHED
}
template <class Epi, class Sched, bool ALIGN_EPI = false, bool SP2 = false>
__device__ __forceinline__ void gemm_phase_gather(PG8_LAS unsigned char* lds, const Gemm g, const int* rowidx, const Sched& S, const Epi& E) {
    const int wid = g.wv, lane = hw_lane(), tid = (wid << 6) | lane,
              wr = wid >> 2, wc = wid & 3, fr = lane & 15, fq = lane >> 4;
    const int K = g.K, nt = K / BK;
    unsigned voffB[2]; int stR[2], stC[2];
#pragma unroll
    for (int i = 0; i < 2; ++i) { int R, C; stage_rc(tid * 16 + i * 8192, R, C); const int Rb = Epi::PERM ? ((R & ~31) + perm32(R & 31)) : R;
        stR[i] = R; stC[i] = C; voffB[i] = (unsigned)(Rb * g.ldb + C) * 2u; }
    unsigned vA0[2], vA1[2], vA0n[2], vA1n[2];
#define PG8_ROWS(pm_, v0, v1) do { _Pragma("unroll") for (int i = 0; i < 2; ++i) { const int s0_ = rowidx[(pm_) * BM + stR[i]], s1_ = rowidx[(pm_) * BM + HALF + stR[i]]; const int r0_ = (s0_ < 0 ? 0 : s0_) >> 1, r1_ = (s1_ < 0 ? 0 : s1_) >> 1;     \
        v0[i] = (unsigned)(r0_ * g.lda + stC[i]) * 2u; v1[i] = (unsigned)(r1_ * g.lda + stC[i]) * 2u; } } while (0)
    const size_t kstep = (size_t)(BK * 2);
    const size_t hstepB = (size_t)HALF * g.ldb * 2;
    const size_t tstepB = 2 * hstepB;
    const unsigned ldsw = (unsigned)wid * 1024u;
    const int aoff = lds_byte(wr * 64 + fr, fq * 8), boff = lds_byte(wc * 32 + fr, fq * 8);
#define PG8_SA(b, h) (((b) * 2 + (h)) * HTB)
#define PG8_SB(b, h) ((4 + (b) * 2 + (h)) * HTB)
#define PG8_STAGE(bufoff, gbase, voff) do { _Pragma("unroll") for (int _i = 0; _i < 2; ++_i) \
        __builtin_amdgcn_global_load_lds((const unsigned*)((const char*)(gbase) + (voff)[_i]), (PG8_LAS unsigned*)(lds + (bufoff) + ldsw + _i * 8192), 16, 0, 0); } while (0)
#define PG8_LDA(dst, b, h) do { _Pragma("unroll") for (int m = 0; m < 4; ++m) _Pragma("unroll") for (int k = 0; k < 2; ++k) dst[m][k] = *(const PG8_LAS bf16x8*)(lds + PG8_SA(b, h) + aoff + m * 2048 + k * 1024); } while (0)
#define PG8_LDB(dst, b, h) do { _Pragma("unroll") for (int n = 0; n < 2; ++n) _Pragma("unroll") for (int k = 0; k < 2; ++k) dst[n][k] = *(const PG8_LAS bf16x8*)(lds + PG8_SB(b, h) + boff + n * 2048 + k * 1024); } while (0)
#define PG8_MMA(ai, bj, At, Bt) do { __builtin_amdgcn_s_setprio(1); _Pragma("unroll") for (int m = 0; m < 4; ++m) _Pragma("unroll") for (int n = 0; n < 2; ++n) _Pragma("unroll") for (int k = 0; k < 2; ++k) \
        acc[ai][bj][m][n] = __builtin_amdgcn_mfma_f32_16x16x32_bf16(Bt[n][k], At[m][k], acc[ai][bj][m][n], 0, 0, 0); __builtin_amdgcn_s_setprio(0); } while (0)
#define PG8_WAIT_V(n) asm volatile("s_waitcnt vmcnt(" #n ")" ::: "memory")
#define PG8_WAIT_L(n) asm volatile("s_waitcnt lgkmcnt(" #n ")" ::: "memory")
#define PG8_BAR __builtin_amdgcn_s_barrier()
#define PG8_SCHED __builtin_amdgcn_sched_barrier(0)
    Unit cur, nxt; int ui = 0;
    if (!S.next(0, cur)) return;
    f32x4 acc[2][2][4][2];
#pragma unroll
    for (int a = 0; a < 2; ++a)
#pragma unroll
        for (int b = 0; b < 2; ++b)
#pragma unroll
            for (int m = 0; m < 4; ++m)
#pragma unroll
                for (int n = 0; n < 2; ++n) acc[a][b][m][n] = (f32x4){0.f, 0.f, 0.f, 0.f};
    bf16x8 At[4][2] = {}, B0[2][2] = {}, B1[2][2] = {};
    PG8_ROWS(cur.pm, vA0, vA1);
    const char* cA = (const char*)g.A; const char* cB = (const char*)g.Bt + (size_t)cur.pn * tstepB;
    S.a_ready(cur);
    if constexpr (SP2) {
        PG8_STAGE(PG8_SB(0, 0), cB, voffB); PG8_STAGE(PG8_SB(0, 1), cB + hstepB, voffB); PG8_STAGE(PG8_SA(0, 0), cA, vA0); PG8_STAGE(PG8_SA(0, 1), cA, vA1);
        if (wr == 1) PG8_BAR;
        PG8_WAIT_V(2); PG8_BAR;
        PG8_STAGE(PG8_SB(1, 0), cB + kstep, voffB); PG8_STAGE(PG8_SA(1, 0), cA + kstep, vA0); PG8_STAGE(PG8_SB(1, 1), cB + hstepB + kstep, voffB);
        PG8_WAIT_V(6); PG8_BAR;
    } else {
        PG8_STAGE(PG8_SB(0, 0), cB, voffB); PG8_STAGE(PG8_SA(0, 0), cA, vA0); PG8_STAGE(PG8_SB(0, 1), cB + hstepB, voffB); PG8_STAGE(PG8_SA(0, 1), cA, vA1);
        if (wr == 1) PG8_BAR;
        PG8_WAIT_V(4); PG8_BAR;
        PG8_STAGE(PG8_SB(1, 0), cB + kstep, voffB); PG8_STAGE(PG8_SA(1, 0), cA + kstep, vA0); PG8_STAGE(PG8_SB(1, 1), cB + hstepB + kstep, voffB);
        PG8_WAIT_V(6); PG8_BAR;
    }
    for (;;) {
        const bool has_next = S.next(ui + 1, nxt);
        PG8_ROWS((has_next ? nxt.pm : cur.pm), vA0n, vA1n);
        const char* nA = cA; const char* nB = has_next ? (const char*)g.Bt + (size_t)nxt.pn * tstepB : cB;
        if constexpr (Epi::PREFETCH) E.prefetch(cur, lds + STAGE_BYTES + 16384 + 13312 + wid * 256, wid, lane);
        for (int t = 0; t < nt; t += 2) {
            const bool last = (t == nt - 2);
            const char* a1 = cA + (size_t)(t + 1) * kstep;
            const char* a2 = last ? nA : cA + (size_t)(t + 2) * kstep; const char* b2 = last ? nB : cB + (size_t)(t + 2) * kstep;
            const char* a3 = a2 + kstep; const char* b3 = b2 + kstep;
            unsigned wA0[2], wA1[2];
#pragma unroll
            for (int i = 0; i < 2; ++i) { wA0[i] = last ? vA0n[i] : vA0[i]; wA1[i] = last ? vA1n[i] : vA1[i]; }
            if (last && has_next) S.a_ready(nxt);
            if constexpr (SP2) {
            PG8_LDB(B0, 0, 0); PG8_LDB(B1, 0, 1); PG8_SCHED; PG8_LDA(At, 0, 0); PG8_STAGE(PG8_SA(1, 1), a1, vA1);
            PG8_WAIT_V(8); PG8_WAIT_L(0); PG8_BAR; PG8_MMA(0, 0, At, B0); PG8_MMA(0, 1, At, B1); PG8_BAR; PG8_SCHED;
            PG8_LDA(At, 0, 1); PG8_STAGE(PG8_SB(0, 0), b2, voffB); PG8_STAGE(PG8_SB(0, 1), b2 + hstepB, voffB); PG8_STAGE(PG8_SA(0, 0), a2, wA0);
            PG8_WAIT_V(8); PG8_WAIT_L(0); PG8_BAR; PG8_MMA(1, 0, At, B0); PG8_MMA(1, 1, At, B1); PG8_BAR; PG8_SCHED;
            PG8_LDB(B0, 1, 0); PG8_LDB(B1, 1, 1); PG8_SCHED; PG8_LDA(At, 1, 0); PG8_STAGE(PG8_SA(0, 1), a2, wA1);
            PG8_WAIT_V(8); PG8_WAIT_L(0); PG8_BAR; PG8_MMA(0, 0, At, B0); PG8_MMA(0, 1, At, B1); PG8_BAR; PG8_SCHED;
            PG8_LDA(At, 1, 1); PG8_STAGE(PG8_SB(1, 0), b3, voffB); PG8_STAGE(PG8_SB(1, 1), b3 + hstepB, voffB); PG8_STAGE(PG8_SA(1, 0), a3, wA0);
            PG8_WAIT_V(8); PG8_WAIT_L(0); PG8_BAR; PG8_MMA(1, 0, At, B0); PG8_MMA(1, 1, At, B1); PG8_BAR; PG8_SCHED;
            } else {
            PG8_LDB(B0, 0, 0); PG8_SCHED; PG8_LDA(At, 0, 0); PG8_STAGE(PG8_SA(1, 1), a1, vA1);
            PG8_WAIT_L(8); PG8_BAR; PG8_WAIT_L(0); PG8_MMA(0, 0, At, B0); PG8_BAR; PG8_SCHED;
            PG8_LDB(B1, 0, 1); PG8_STAGE(PG8_SB(0, 0), b2, voffB);
            PG8_BAR; PG8_WAIT_L(0); PG8_MMA(0, 1, At, B1); PG8_BAR;
            PG8_LDA(At, 0, 1); PG8_STAGE(PG8_SA(0, 0), a2, wA0);
            PG8_BAR; PG8_WAIT_L(0); PG8_MMA(1, 0, At, B0); PG8_BAR; PG8_SCHED;
            PG8_STAGE(PG8_SB(0, 1), b2 + hstepB, voffB);
            PG8_WAIT_V(6); PG8_BAR; PG8_MMA(1, 1, At, B1); PG8_BAR;
            PG8_LDB(B0, 1, 0); PG8_SCHED; PG8_LDA(At, 1, 0); PG8_STAGE(PG8_SA(0, 1), a2, wA1);
            PG8_WAIT_L(8); PG8_BAR; PG8_WAIT_L(0); PG8_MMA(0, 0, At, B0); PG8_BAR; PG8_SCHED;
            PG8_LDB(B1, 1, 1); PG8_STAGE(PG8_SB(1, 0), b3, voffB);
            PG8_BAR; PG8_WAIT_L(0); PG8_MMA(0, 1, At, B1); PG8_BAR;
            PG8_LDA(At, 1, 1); PG8_STAGE(PG8_SA(1, 0), a3, wA0);
            PG8_BAR; PG8_WAIT_L(0); PG8_MMA(1, 0, At, B0); PG8_BAR; PG8_SCHED;
            PG8_STAGE(PG8_SB(1, 1), b3 + hstepB, voffB);
            PG8_WAIT_V(6); PG8_BAR; PG8_MMA(1, 1, At, B1); PG8_BAR;
            }
        }
        if constexpr (ALIGN_EPI) { if (wr == 0) PG8_BAR; }
        if constexpr (!Epi::AFTER_DRAIN) { E(acc, cur, wr, wc, fr, fq); S.done(cur); }
        if (!has_next) break;
#pragma unroll
        for (int a = 0; a < 2; ++a)
#pragma unroll
            for (int b = 0; b < 2; ++b)
#pragma unroll
                for (int m = 0; m < 4; ++m)
#pragma unroll
                    for (int n = 0; n < 2; ++n) acc[a][b][m][n] = (f32x4){0.f, 0.f, 0.f, 0.f};
        cur = nxt; cA = nA; cB = nB; ++ui;
#pragma unroll
        for (int i = 0; i < 2; ++i) { vA0[i] = vA0n[i]; vA1[i] = vA1n[i]; }
        if constexpr (ALIGN_EPI) { if (wr == 1) PG8_BAR; }
    }
    PG8_WAIT_V(0);
    if constexpr (!ALIGN_EPI) { if (wr == 0) PG8_BAR; }
    PG8_BAR;
    if constexpr (Epi::AFTER_DRAIN) { E.fused(acc, cur, wr, wc, fr, fq, lds, wid, lane); S.done(cur); }
#undef PG8_ROWS
#undef PG8_SA
#undef PG8_SB
#undef PG8_STAGE
#undef PG8_LDA
#undef PG8_LDB
#undef PG8_MMA
#undef PG8_WAIT_V
#undef PG8_WAIT_L
#undef PG8_BAR
#undef PG8_SCHED
}
}

typedef unsigned short bf16;
typedef unsigned u32x4 __attribute__((ext_vector_type(4)));
typedef unsigned u32x2 __attribute__((ext_vector_type(2)));
typedef float f32x4 __attribute__((ext_vector_type(4)));
typedef float f32x2 __attribute__((ext_vector_type(2)));
typedef float f32x16 __attribute__((ext_vector_type(16)));
typedef short bf16x8 __attribute__((ext_vector_type(8)));
typedef short s16x4 __attribute__((ext_vector_type(4)));
#define LAS __attribute__((address_space(3)))

constexpr int NT = 512, NW = 8;
constexpr int T = 32768, D = 1024, SEQ = 2048, NB = 16;
constexpr int IN_COLS = 6944;
constexpr float EPS = 1e-6f;
constexpr float LOG2E = 1.4426950408889634f;
constexpr float SC_HD = 0.125f * LOG2E;
constexpr float SC_MLA = 0.10206207261596575f * LOG2E;
constexpr int XS_ROWS = 73728;

constexpr size_t MiB = 1u << 20;
constexpr size_t OFF_MOD = 64 * 1024, OFF_WRT = 1 * MiB, OFF_RE = 3 * MiB / 2, OFF_RG = 7 * MiB / 4, OFF_RD = 2 * MiB, OFF_BCNT = 9 * MiB / 4, OFF_LSE = 5 * MiB / 2;
constexpr size_t WS_WIN = 4 * MiB, WS_WUQ = 18 * MiB, WS_WUKV = WS_WUQ + 3 * MiB / 4, WS_WBM = WS_WUKV + MiB / 2, WS_WBD = WS_WBM + MiB, WS_WBW = WS_WBD + MiB / 2, WS_WOUT = WS_WBW + MiB;
constexpr size_t WS_W13 = 24 * MiB, WS_W2 = 72 * MiB;
constexpr size_t WS_XN = 96 * MiB, WS_CLAT = 160 * MiB, WS_QKV = 224 * MiB, WS_QM = 416 * MiB, WS_KVM = 464 * MiB, WS_END = 528 * MiB;
static_assert(WS_WOUT + 2 * MiB <= WS_W13, "weight map");
constexpr int LDS_BYTES = 163840, MISC_OFF = 147456;

struct Params {
    const float *x, *c; const int* pos;
    const float *w_ada, *b_ada, *g_norm1, *w_in, *g_cq, *w_uq, *g_ckv, *w_ukv, *g_q_mla, *g_k_mla, *g_q_dil, *g_k_dil, *g_q_win, *g_k_win, *sink_win;
    const float *w_br_mla, *w_br_dil, *w_br_win, *w_out, *g_norm2, *w_gr, *b_gr, *w_er, *b_er, *w1, *w3, *w2;
    float* out; unsigned char* ws;
};

typedef const __attribute__((address_space(4))) Params* KP;
__device__ __forceinline__ KP kparams() { KP k = (KP)__builtin_amdgcn_kernarg_segment_ptr(); asm volatile("" : "+s"(k)); return k; }
__device__ __forceinline__ int otid(int wv) { return (wv << 6) | pg8::hw_lane(); }
#define WAVE_IDS() const int tid = otid(wv), lane = tid & 63, wave = wv, gw = (int)blockIdx.x * NW + wave, NGW = (int)gridDim.x * NW; (void)gw; (void)NGW; (void)lane; (void)wave
__device__ __forceinline__ unsigned f2bf(float f) { unsigned u = __builtin_bit_cast(unsigned, f); return (u + 0x7fffu + ((u >> 16) & 1u)) >> 16; }
__device__ __forceinline__ unsigned pk2(float lo, float hi) { return pg8::cvt_pk_bf16(lo, hi); }
__device__ __forceinline__ float bflo(unsigned w) { return __uint_as_float(w << 16); }
__device__ __forceinline__ float bfhi(unsigned w) { return __uint_as_float(w & 0xffff0000u); }
__device__ __forceinline__ float shflx(float v, int m, int lane) { return __builtin_bit_cast(float, __builtin_amdgcn_ds_bpermute((lane ^ m) << 2, __builtin_bit_cast(int, v))); }
__device__ __forceinline__ float wave_sum(float v, int lane) {
#pragma unroll
    for (int o = 1; o < 64; o <<= 1) v += shflx(v, o, lane);
    return v;
}
__device__ __forceinline__ float sum8(float v, int lane) { v += shflx(v, 1, lane); v += shflx(v, 2, lane); v += shflx(v, 4, lane); return v; }
__device__ __forceinline__ void unpack8(const u32x4 w, float (&f)[8]) { f[0] = bflo(w.x); f[1] = bfhi(w.x); f[2] = bflo(w.y); f[3] = bfhi(w.y); f[4] = bflo(w.z); f[5] = bfhi(w.z); f[6] = bflo(w.w); f[7] = bfhi(w.w); }
__device__ __forceinline__ u32x4 pack8(const float (&f)[8]) { u32x4 w; w.x = pk2(f[0], f[1]); w.y = pk2(f[2], f[3]); w.z = pk2(f[4], f[5]); w.w = pk2(f[6], f[7]); return w; }
__device__ __forceinline__ float rope_inv_freq(int i, int half) { return __builtin_amdgcn_exp2f(-(float)i / (float)half * 13.287712379549449f); }

#define XB_TMO      128
#define XB_XCNT(j)  (256  + 64 * (j))
#define XB_XSUB(j)  (1280 + 64 * (j))
#define XB_XGEN(j)  (2304 + 64 * (j))
#define XB_TOP      3328
#define XB_TOPGEN   3392
#define XCD_BAR_WORDS 3456
#define XB_SPIN_CAP (1u << 18)

__device__ __forceinline__ unsigned xb_ld(unsigned* p)              { return __hip_atomic_load(p, __ATOMIC_RELAXED, __HIP_MEMORY_SCOPE_AGENT); }
__device__ __forceinline__ unsigned xb_add(unsigned* p, unsigned v) { return __hip_atomic_fetch_add(p, v, __ATOMIC_RELAXED, __HIP_MEMORY_SCOPE_AGENT); }
__device__ __forceinline__ unsigned xb_xcc_id() { return (unsigned)__builtin_amdgcn_s_getreg((3 << 11) | 20) & 0xFu; }
#define XB_SPIN(cond, bar) do { unsigned _sp = 0; while (cond) { __builtin_amdgcn_s_sleep(1); \
    if ((++_sp & 255u) == 0u) { if (xb_ld(&(bar)[XB_TMO])) break; if (_sp > XB_SPIN_CAP) { atomicAdd(&(bar)[XB_TMO], 1u); break; } } } } while (0)

struct XcdBarrier {
    int wv;
    unsigned* bar; unsigned x;
    volatile LAS unsigned* st;
};

__device__ __forceinline__ XcdBarrier xcd_barrier_post(unsigned* bar, volatile LAS unsigned* st, int wv) {
    XcdBarrier b; b.wv = wv; b.bar = bar; b.x = xb_xcc_id(); b.st = st;
    if (wv == 0 && pg8::hw_lane() == 0) (void)xb_add(&bar[XB_XCNT(b.x)], 1u);
    return b;
}
__device__ __forceinline__ void xcd_barrier_complete(unsigned* bar, unsigned x, unsigned& nloc, unsigned& nx) {
    const unsigned G = gridDim.x * gridDim.y * gridDim.z;
    unsigned sum, cnt, mine, sp = 0u;
    for (;;) {
        sum = 0u; cnt = 0u; mine = 0u;
#pragma unroll
        for (unsigned j = 0; j < 16; ++j) { const unsigned c = xb_ld(&bar[XB_XCNT(j)]); sum += c; cnt += (c > 0u) ? 1u : 0u; mine = (j == x) ? c : mine; }
        if (sum == G) break;
        __builtin_amdgcn_s_sleep(1);
        if ((++sp & 255u) == 0u) { if (xb_ld(&bar[XB_TMO])) break; if (sp > XB_SPIN_CAP) { atomicAdd(&bar[XB_TMO], 1u); break; } }
    }
    nloc = mine > 0u ? mine : 1u; nx = cnt > 0u ? cnt : 1u;
}

__device__ __forceinline__ void xcd_barrier(const XcdBarrier& b) {
    asm volatile("s_waitcnt vmcnt(0)" ::: "memory");
    __syncthreads();
    if (b.wv == 0 && pg8::hw_lane() == 0) {
        unsigned* bar = b.bar;
        __builtin_amdgcn_s_waitcnt(0);
        unsigned nloc = b.st[0], nx = b.st[1];
        if (nloc == 0u) { xcd_barrier_complete(bar, b.x, nloc, nx); b.st[0] = nloc; b.st[1] = nx; }
        const unsigned old = xb_add(&bar[XB_XSUB(b.x)], 1u);
        const unsigned gen = old / nloc;
        if (old + 1u == (gen + 1u) * nloc) {
            __builtin_amdgcn_fence(__ATOMIC_RELEASE, "agent");
            asm volatile("s_waitcnt vmcnt(0)" ::: "memory");
            const unsigned og = xb_add(&bar[XB_TOP], 1u);
            const unsigned tg = og / nx;
            if (og + 1u == (tg + 1u) * nx) xb_add(&bar[XB_TOPGEN], 1u);
            else XB_SPIN(xb_ld(&bar[XB_TOPGEN]) == tg, bar);
            __builtin_amdgcn_fence(__ATOMIC_ACQUIRE, "agent");
            xb_add(&bar[XB_XGEN(b.x)], 1u);
            asm volatile("s_waitcnt vmcnt(0)" ::: "memory");
        } else {
            XB_SPIN(xb_ld(&bar[XB_XGEN(b.x)]) == gen, bar);
            __builtin_amdgcn_fence(__ATOMIC_ACQUIRE, "agent");
            asm volatile("s_waitcnt vmcnt(0)" ::: "memory");
        }
    }
    __syncthreads();
}


__device__ __forceinline__ void phase_mod(KP p, LAS unsigned char* lds, int wv) {
    LAS float* cond = (LAS float*)lds;
    LAS float* red = (LAS float*)(lds + 65536);
    const int tid = otid(wv);
    float* mod = (float*)(p->ws + OFF_MOD);
    if ((int)blockIdx.x < 192) {
        for (int i = tid; i < NB * D; i += NT) { const float v = p->c[i]; cond[i] = v / (1.0f + __expf(-v)); }
        __syncthreads();
        for (int u = blockIdx.x; u < 192; u += gridDim.x) {
            const int l = u / 96, n0 = (u % 96) * 64, col = tid & 63, ks = wv;
            float acc[NB];
#pragma unroll
            for (int b = 0; b < NB; ++b) acc[b] = 0.f;
            const float* w = p->w_ada + (size_t)l * D * 6144 + n0;
#pragma unroll 1
            for (int k = ks * 128; k < ks * 128 + 128; k += 16) { float wr[16]; int kl = k; asm volatile("" : "+v"(kl));
#pragma unroll
                for (int i = 0; i < 16; ++i) { const float* wk = w + (size_t)(k + i) * 6144; wr[i] = wk[col]; }
#pragma unroll
                for (int i = 0; i < 16; i += 4) {
#pragma unroll
                    for (int b = 0; b < NB; ++b) { const f32x4 c4 = *(const LAS f32x4*)(cond + b * D + kl + i); acc[b] += (c4.x * wr[i] + c4.y * wr[i + 1]) + (c4.z * wr[i + 2] + c4.w * wr[i + 3]); } } }
#pragma unroll
            for (int b = 0; b < NB; ++b) red[(ks * NB + b) * 64 + col] = acc[b];
            __syncthreads();
            for (int i = tid; i < NB * 64; i += NT) { const int b = i >> 6, cc = i & 63; float s = 0.f;
#pragma unroll
                for (int k8 = 0; k8 < 8; ++k8) s += red[(k8 * NB + b) * 64 + cc];
                mod[(size_t)(l * NB + b) * 6144 + n0 + cc] = s + p->b_ada[l * 6144 + n0 + cc]; }
            __syncthreads();
        }
    }
}
struct CItem { const float* W; int ldw, k0, n0; bf16* WT; int ldt, drow; const float* gk; };
__device__ __forceinline__ CItem conv_decode(KP p, int l, unsigned char* ws, int it) {
    constexpr int I_IN = 16 * 217, I_UQ = 8 * 24, I_UKV = 4 * 32, I_BM = 8 * 32, I_BD = 4 * 32, I_BW = 8 * 32, I_OUT = 16 * 32, I_E1 = 32 * 16 * 12;
    CItem c; c.gk = nullptr; int r = it;
    if (r < I_IN) { const int kb = r / 217, nb = r % 217, n0 = nb * 32; int drow; if (n0 < 800) drow = 3072 + n0; else if (n0 < 3872) { const int c0 = n0 - 800, hq = c0 >> 6, dh = (c0 >> 5) & 1; drow = 256 * (hq >> 2) + 128 * dh + 32 * (hq & 3); } else drow = 4096 + n0 - 3872;
        c.W = p->w_in + (size_t)l * D * IN_COLS; c.ldw = IN_COLS; c.k0 = kb * 64; c.n0 = n0; c.WT = (bf16*)(ws + WS_WIN); c.ldt = 1024; c.drow = drow; return c; } r -= I_IN;
    if (r < I_UQ) { const int nb = r % 24, h = nb / 3, part = nb % 3;
        c.W = p->w_uq + (size_t)l * 512 * 768; c.ldw = 768; c.k0 = (r / 24) * 64; c.n0 = nb * 32; c.WT = (bf16*)(ws + WS_WUQ); c.ldt = 512; c.gk = p->g_cq + l * 512;
        c.drow = part < 2 ? 256 * (h >> 2) + 128 * part + 32 * (h & 3) : 512 + 128 * (h & 1) + 32 * (h >> 1); return c; } r -= I_UQ;
    if (r < I_UKV) { const int nb = r % 32, h16 = nb >> 1, dh = nb & 1;
        c.W = p->w_ukv + (size_t)l * 256 * 1024; c.ldw = 1024; c.k0 = (r / 32) * 64; c.n0 = nb * 32; c.WT = (bf16*)(ws + WS_WUKV); c.ldt = 256; c.gk = p->g_ckv + l * 256; c.drow = 256 * (h16 >> 2) + 128 * dh + 32 * (h16 & 3); return c; } r -= I_UKV;
    if (r < I_BM) { c.W = p->w_br_mla + (size_t)l * 512 * 1024; c.ldw = 1024; c.k0 = (r / 32) * 64; c.n0 = (r % 32) * 32; c.WT = (bf16*)(ws + WS_WBM); c.ldt = 512; c.drow = c.n0; return c; } r -= I_BM;
    if (r < I_BD) { c.W = p->w_br_dil + (size_t)l * 256 * 1024; c.ldw = 1024; c.k0 = (r / 32) * 64; c.n0 = (r % 32) * 32; c.WT = (bf16*)(ws + WS_WBD); c.ldt = 256; c.drow = c.n0; return c; } r -= I_BD;
    if (r < I_BW) { c.W = p->w_br_win + (size_t)l * 512 * 1024; c.ldw = 1024; c.k0 = (r / 32) * 64; c.n0 = (r % 32) * 32; c.WT = (bf16*)(ws + WS_WBW); c.ldt = 512; c.drow = c.n0; return c; } r -= I_BW;
    if (r < I_OUT) { c.W = p->w_out + (size_t)l * 1024 * 1024; c.ldw = 1024; c.k0 = (r / 32) * 64; c.n0 = (r % 32) * 32; c.WT = (bf16*)(ws + WS_WOUT); c.ldt = 1024; c.drow = c.n0; return c; } r -= I_OUT;
    if (r < 2 * I_E1) { const int which = r / I_E1; r -= which * I_E1; const int e = r / 192, q = r % 192, kb = q / 12, nb = q % 12, n0 = nb * 32;
        c.W = (which ? p->w3 : p->w1) + ((size_t)l * 32 + e) * 1024 * 384; c.ldw = 384; c.k0 = kb * 64; c.n0 = n0; c.WT = (bf16*)(ws + WS_W13); c.ldt = 1024; c.drow = e * 768 + 256 * (n0 >> 7) + which * 128 + (n0 & 127); return c; } r -= 2 * I_E1;
    { const int e = r / 192, q = r % 192, kb = q / 32, nb = q % 32;
      c.W = p->w2 + ((size_t)l * 32 + e) * 384 * 1024; c.ldw = 1024; c.k0 = kb * 64; c.n0 = nb * 32; c.WT = (bf16*)(ws + WS_W2); c.ldt = 384; c.drow = e * 1024 + nb * 32; return c; }
}
__device__ __forceinline__ void conv_load(const CItem& c, int lane, float (&wv)[32]) {
#pragma unroll
    for (int i = 0; i < 32; ++i) wv[i] = c.W[(size_t)(c.k0 + 2 * i + (lane >> 5)) * c.ldw + c.n0 + (lane & 31)];
}
__device__ __forceinline__ void conv_finish(const CItem& c, float (&wv)[32], LAS float* scr, int lane) {
    if (c.gk) {
#pragma unroll
        for (int i = 0; i < 32; ++i) wv[i] *= c.gk[c.k0 + 2 * i + (lane >> 5)]; }
#pragma unroll
    for (int i = 0; i < 32; ++i) scr[(2 * i + (lane >> 5)) * 33 + (lane & 31)] = wv[i];
    asm volatile("s_waitcnt lgkmcnt(0)" ::: "memory");
    const int cidx = lane & 7;
#pragma unroll
    for (int j = 0; j < 4; ++j) { const int n = (lane >> 3) + 8 * j; const LAS float* s = scr + (8 * cidx) * 33 + n;
        u32x4 o; o.x = pk2(s[0 * 33], s[1 * 33]); o.y = pk2(s[2 * 33], s[3 * 33]); o.z = pk2(s[4 * 33], s[5 * 33]); o.w = pk2(s[6 * 33], s[7 * 33]);
        *(u32x4*)(c.WT + (size_t)(c.drow + n) * c.ldt + c.k0 + 8 * cidx) = o; }
    asm volatile("s_waitcnt lgkmcnt(0)" ::: "memory");
}
constexpr int CONV_NONMOE = 16 * 217 + 8 * 24 + 4 * 32;
__device__ __forceinline__ void phase_convert(KP p, int l, LAS unsigned char* lds, int wv, const bool moe, const int cgw = -1, const int cngw = 0) {
    WAVE_IDS();
    const int GW = cgw < 0 ? gw : cgw, NG = cgw < 0 ? NGW : cngw;
    LAS float* scr = (LAS float*)(lds + wave * 16384);
    unsigned char* ws = p->ws;
    constexpr int NITEMS = 16 * 217 + 8 * 24 + 4 * 32 + 8 * 32 + 4 * 32 + 8 * 32 + 16 * 32 + 2 * 32 * 16 * 12 + 32 * 6 * 32;
    const int IT1 = moe ? NITEMS : CONV_NONMOE;
    int it = (moe ? CONV_NONMOE : 0) + GW; float va[32], vb[32]; CItem ca, cb;
    if (it < IT1) { ca = conv_decode(p, l, ws, it); conv_load(ca, lane, va); }
    while (it < IT1) {
        const int itb = it + NG; if (itb < IT1) { cb = conv_decode(p, l, ws, itb); conv_load(cb, lane, vb); }
        conv_finish(ca, va, scr, lane);
        if (itb >= IT1) break;
        const int ita = itb + NG; if (ita < IT1) { ca = conv_decode(p, l, ws, ita); conv_load(ca, lane, va); }
        conv_finish(cb, vb, scr, lane);
        it = ita;
    }
    if (moe) return;
    { u32x4* z = (u32x4*)((bf16*)(ws + WS_WIN) + (size_t)3872 * 1024); const u32x4 zero = {0u, 0u, 0u, 0u};
      for (int i = GW * 64 + lane; i < 224 * 128; i += NG * 64) z[i] = zero; }
    { float* wrt = (float*)(ws + OFF_WRT) + (size_t)l * 36 * 1024;
      for (int i = GW * 64 + lane; i < 36 * 1024; i += NG * 64) { const int j = i >> 10, k = i & 1023;
          wrt[i] = j < 4 ? p->w_gr[((size_t)l * 1024 + k) * 4 + j] : p->w_er[((size_t)l * 1024 + k) * 32 + (j - 4)]; } }
}

__device__ __forceinline__ void norm_row(const float* xrow, bf16* orow, const float* g, const float* sh, const float* sc, int lane) {
    f32x4 v[4]; float ss = 0.f;
#pragma unroll
    for (int j = 0; j < 4; ++j) { v[j] = *(const f32x4*)(xrow + 4 * lane + 256 * j); ss += (v[j].x * v[j].x + v[j].y * v[j].y) + (v[j].z * v[j].z + v[j].w * v[j].w); }
    const float rstd = __builtin_amdgcn_rsqf(wave_sum(ss, lane) * (1.0f / D) + EPS);
#pragma unroll
    for (int j = 0; j < 4; ++j) { const int cidx = 4 * lane + 256 * j; const f32x4 gg = *(const f32x4*)(g + cidx), s1 = *(const f32x4*)(sc + cidx), s0 = *(const f32x4*)(sh + cidx);
        const f32x4 y = v[j] * rstd * gg * (s1 + 1.0f) + s0;
        u32x2 o; o.x = pk2(y.x, y.y); o.y = pk2(y.z, y.w); *(u32x2*)(orow + cidx) = o; }
}
__device__ __forceinline__ void norm_row2(const float* xa, bf16* oa, const float* xb, bf16* ob, const float* g, const float* moda, const float* modb, int lane) {
    f32x4 va[4], vb[4]; float sa = 0.f, sb = 0.f;
#pragma unroll
    for (int j = 0; j < 4; ++j) { va[j] = *(const f32x4*)(xa + 4 * lane + 256 * j); vb[j] = *(const f32x4*)(xb + 4 * lane + 256 * j); }
#pragma unroll
    for (int j = 0; j < 4; ++j) { sa += (va[j].x * va[j].x + va[j].y * va[j].y) + (va[j].z * va[j].z + va[j].w * va[j].w); sb += (vb[j].x * vb[j].x + vb[j].y * vb[j].y) + (vb[j].z * vb[j].z + vb[j].w * vb[j].w); }
    const float ra = __builtin_amdgcn_rsqf(wave_sum(sa, lane) * (1.0f / D) + EPS), rb = __builtin_amdgcn_rsqf(wave_sum(sb, lane) * (1.0f / D) + EPS);
    f32x4 gg[4], s1a[4], s0a[4], s1b[4], s0b[4];
#pragma unroll
    for (int j = 0; j < 4; ++j) { const int cidx = 4 * lane + 256 * j; gg[j] = *(const f32x4*)(g + cidx); s1a[j] = *(const f32x4*)(moda + 1024 + cidx); s0a[j] = *(const f32x4*)(moda + cidx); s1b[j] = *(const f32x4*)(modb + 1024 + cidx); s0b[j] = *(const f32x4*)(modb + cidx); }
#pragma unroll
    for (int j = 0; j < 4; ++j) { const int cidx = 4 * lane + 256 * j;
        { const f32x4 y = va[j] * ra * gg[j] * (s1a[j] + 1.0f) + s0a[j]; u32x2 o; o.x = pk2(y.x, y.y); o.y = pk2(y.z, y.w); *(u32x2*)(oa + cidx) = o; }
        { const f32x4 y = vb[j] * rb * gg[j] * (s1b[j] + 1.0f) + s0b[j]; u32x2 o; o.x = pk2(y.x, y.y); o.y = pk2(y.z, y.w); *(u32x2*)(ob + cidx) = o; } }
}
__device__ __forceinline__ void phase_norm1(KP p, int l, const float* xin, int wv) {
    WAVE_IDS();
    const float* mod = (const float*)(p->ws + OFF_MOD) + (size_t)l * NB * 6144;
    bf16* XN = (bf16*)(p->ws + WS_XN);
    for (int m = gw; m < T; m += 2 * NGW) {
        const int m1 = m + NGW;
        norm_row2(xin + (size_t)m * D, XN + (size_t)m * D, xin + (size_t)m1 * D, XN + (size_t)m1 * D, p->g_norm1 + l * D, mod + (m >> 11) * 6144, mod + (m1 >> 11) * 6144, lane); }
}
__device__ __forceinline__ void phase_norms_a(KP p, int l, int wv) {
    WAVE_IDS();
    bf16* CLAT = (bf16*)(p->ws + WS_CLAT); bf16* QKV = (bf16*)(p->ws + WS_QKV);
    for (int m = gw; m < T; m += NGW) {
        bf16* cl = CLAT + (size_t)m * 1024; bf16* qk = QKV + (size_t)m * 3072;
        const int pos = p->pos[m];
        const u32x4 wq = *(const u32x4*)(cl + 8 * lane);
        const u32x2 wkv = *(const u32x2*)(cl + 512 + 4 * lane);
        const bf16 wr = lane < 32 ? cl[768 + lane] : (bf16)0;
        u32x4 wd[3];
#pragma unroll
        for (int it = 0; it < 3; ++it) wd[it] = *(const u32x4*)(qk + it * 512 + 8 * lane);
        const u32x4 ww0 = *(const u32x4*)(qk + 2304 + 8 * lane);
        u32x4 ww1 = {0u, 0u, 0u, 0u}; if (lane < 16) ww1 = *(const u32x4*)(qk + 2816 + 8 * lane);
        { float f[8]; unpack8(wq, f); float ss = 0.f;
#pragma unroll
          for (int i = 0; i < 8; ++i) ss += f[i] * f[i];
          const float rstd = __builtin_amdgcn_rsqf(wave_sum(ss, lane) * (1.0f / 512) + EPS); const float* g = p->g_cq + l * 512 + 8 * lane;
#pragma unroll
          for (int i = 0; i < 8; ++i) f[i] *= rstd * g[i];
          *(u32x4*)(cl + 8 * lane) = pack8(f); }
        { float f0 = bflo(wkv.x), f1 = bfhi(wkv.x), f2 = bflo(wkv.y), f3 = bfhi(wkv.y);
          const float rstd = __builtin_amdgcn_rsqf(wave_sum(f0 * f0 + f1 * f1 + f2 * f2 + f3 * f3, lane) * (1.0f / 256) + EPS); const float* g = p->g_ckv + l * 256 + 4 * lane;
          u32x2 o; o.x = pk2(f0 * rstd * g[0], f1 * rstd * g[1]); o.y = pk2(f2 * rstd * g[2], f3 * rstd * g[3]); *(u32x2*)(cl + 512 + 4 * lane) = o; }
        { const float v = __uint_as_float((unsigned)wr << 16);
          const float rstd = __builtin_amdgcn_rsqf(wave_sum(v * v, lane) * (1.0f / 32) + EPS);
          const float vn = v * rstd * p->g_k_mla[l * 96 + 64 + (lane & 31)];
          const float pr = shflx(vn, 16, lane);
          const float ang = (float)pos * rope_inv_freq(lane & 15, 16); float sn, cs; sincosf(ang, &sn, &cs);
          const float o = (lane & 16) ? (pr * sn + vn * cs) : (vn * cs - pr * sn);
          if (lane < 32) cl[768 + lane] = (bf16)f2bf(o); }
#pragma unroll
        for (int it = 0; it < 3; ++it) { const int col0 = it * 512 + 8 * lane; const bool isq = col0 < 768; const int d0 = col0 & 63;
            float f[8]; unpack8(wd[it], f); float ss = 0.f;
#pragma unroll
            for (int i = 0; i < 8; ++i) ss += f[i] * f[i];
            const float rstd = __builtin_amdgcn_rsqf(sum8(ss, lane) * (1.0f / 64) + EPS) * (isq ? SC_HD : 1.0f);
            const float* g = (isq ? p->g_q_dil : p->g_k_dil) + l * 64 + d0;
#pragma unroll
            for (int i = 0; i < 8; ++i) f[i] *= rstd * g[i];
            *(u32x4*)(qk + col0) = pack8(f); }
        { float f[8]; unpack8(ww0, f); float ss = 0.f;
#pragma unroll
          for (int i = 0; i < 8; ++i) ss += f[i] * f[i];
          const float rstd = __builtin_amdgcn_rsqf(sum8(ss, lane) * (1.0f / 64) + EPS) * SC_HD; const float* g = p->g_q_win + l * 64 + ((8 * lane) & 63);
#pragma unroll
          for (int i = 0; i < 8; ++i) f[i] *= rstd * g[i];
          *(u32x4*)(qk + 2304 + 8 * lane) = pack8(f); }
        { float f[8]; unpack8(ww1, f); float ss = 0.f;
#pragma unroll
          for (int i = 0; i < 8; ++i) ss += f[i] * f[i];
          const float rstd = __builtin_amdgcn_rsqf(sum8(ss, lane) * (1.0f / 64) + EPS); const float* g = p->g_k_win + l * 64 + ((8 * lane) & 63);
#pragma unroll
          for (int i = 0; i < 8; ++i) f[i] *= rstd * g[i];
          if (lane < 16) *(u32x4*)(qk + 2816 + 8 * lane) = pack8(f); }
    }
}
__device__ __forceinline__ void phase_norms_b(KP p, int l, int wv) {
    WAVE_IDS();
    bf16* QM = (bf16*)(p->ws + WS_QM); bf16* KVM = (bf16*)(p->ws + WS_KVM);
    const int h = lane >> 3, j = lane & 7;
    for (int m = gw; m < T; m += NGW) {
        bf16* qn = QM + (size_t)m * 768 + h * 96 + 8 * j; bf16* qr = QM + (size_t)m * 768 + h * 96 + 64 + 4 * j; bf16* kn = KVM + (size_t)m * 1024 + h * 128 + 8 * j;
        const int pos = p->pos[m];
        const u32x4 wn = *(const u32x4*)qn; const u32x2 wr = *(const u32x2*)qr; const u32x4 wk = *(const u32x4*)kn;
        { float f[8]; unpack8(wn, f); float ss = 0.f;
#pragma unroll
          for (int i = 0; i < 8; ++i) ss += f[i] * f[i];
          const float rstd = __builtin_amdgcn_rsqf(sum8(ss, lane) * (1.0f / 64) + EPS) * SC_MLA; const float* g = p->g_q_mla + l * 96 + 8 * j;
#pragma unroll
          for (int i = 0; i < 8; ++i) f[i] *= rstd * g[i];
          *(u32x4*)qn = pack8(f); }
        { float f[4] = {bflo(wr.x), bfhi(wr.x), bflo(wr.y), bfhi(wr.y)};
          const float rstd = __builtin_amdgcn_rsqf(sum8(f[0] * f[0] + f[1] * f[1] + f[2] * f[2] + f[3] * f[3], lane) * (1.0f / 32) + EPS); const float* g = p->g_q_mla + l * 96 + 64 + 4 * j;
          float o[4];
#pragma unroll
          for (int e = 0; e < 4; ++e) { const float vn = f[e] * rstd * g[e]; const float pr = shflx(vn, 4, lane);
              const float ang = (float)pos * rope_inv_freq(4 * (j & 3) + e, 16); float sn, cs; sincosf(ang, &sn, &cs);
              o[e] = ((j & 4) ? (pr * sn + vn * cs) : (vn * cs - pr * sn)) * SC_MLA; }
          u32x2 w; w.x = pk2(o[0], o[1]); w.y = pk2(o[2], o[3]); *(u32x2*)qr = w; }
        { float f[8]; unpack8(wk, f); float ss = 0.f;
#pragma unroll
          for (int i = 0; i < 8; ++i) ss += f[i] * f[i];
          const float rstd = __builtin_amdgcn_rsqf(sum8(ss, lane) * (1.0f / 64) + EPS); const float* g = p->g_k_mla + l * 96 + 8 * j;
#pragma unroll
          for (int i = 0; i < 8; ++i) f[i] *= rstd * g[i];
          *(u32x4*)kn = pack8(f); }
    }
}
__device__ __forceinline__ int crow(int r, int hi) { return (r & 3) + 8 * (r >> 2) + 4 * hi; }
__device__ __forceinline__ s16x4 vtr(const LAS unsigned char* ptr) { return __builtin_bit_cast(s16x4, __builtin_amdgcn_ds_read_tr16_b64_v4i16((LAS s16x4*)ptr)); }
__device__ __forceinline__ unsigned cvtpk(float lo, float hi) { return pg8::cvt_pk_bf16(lo, hi); }

__device__ __forceinline__ float fmax2(float a, float b) { return __builtin_amdgcn_fmed3f(a, b, INFINITY); }
__device__ __forceinline__ float max3f(float a, float b, float c) { float r; asm("v_max3_f32 %0, %1, %2, %3" : "=v"(r) : "v"(a), "v"(b), "v"(c)); return r; }
constexpr float SM_THR = 8.0f;
template <bool MFMA_DIRECT>
__device__ __forceinline__ void softmax_tile(f32x16& s0, f32x16& s1, float& m_run, float& l_run, bool& seen, f32x16& negm, f32x16 (&o)[2], bf16x8 (&pb)[4], int lane) {
    if (MFMA_DIRECT) asm volatile("s_nop 15\n\ts_nop 7" : "+v"(s0), "+v"(s1));
    float ma = max3f(s0[0], s0[1], s1[0]), mb = max3f(s0[2], s0[3], s1[1]); ma = max3f(ma, s1[2], s1[3]);
#pragma unroll
    for (int r = 4; r < 16; r += 4) { ma = max3f(ma, s0[r], s0[r + 1]); mb = max3f(mb, s0[r + 2], s0[r + 3]); ma = max3f(ma, s1[r], s1[r + 1]); mb = max3f(mb, s1[r + 2], s1[r + 3]); }
    const float mh_ = max3f(ma, mb, mb);
    const auto rr_ = __builtin_amdgcn_permlane32_swap(__float_as_uint(mh_), __float_as_uint(mh_), false, false);
    float mx = max3f(__uint_as_float(rr_[0]), __uint_as_float(rr_[1]), mh_);
    const bool has = mx > -INFINITY;
    const bool need = seen ? (mx > SM_THR) : has;
    if (__any(need)) {
        const float delta = seen ? fmax2(mx, 0.f) : (has ? mx : 0.f);
        const float alpha = seen ? __builtin_amdgcn_exp2f(-delta) : 1.0f;
        m_run += delta; l_run *= alpha;
#pragma unroll
        for (int r = 0; r < 16; ++r) { s0[r] -= delta; s1[r] -= delta; o[0][r] *= alpha; o[1][r] *= alpha; negm[r] = -m_run; }
    }
    seen = seen || has;
    float rs0 = 0.f, rs1 = 0.f, rs2 = 0.f, rs3 = 0.f;
#pragma unroll
    for (int r = 0; r < 16; ++r) { s0[r] = __builtin_amdgcn_exp2f(s0[r]); s1[r] = __builtin_amdgcn_exp2f(s1[r]); }
#pragma unroll
    for (int r = 0; r < 16; r += 2) { rs0 += s0[r]; rs1 += s0[r + 1]; rs2 += s1[r]; rs3 += s1[r + 1]; }
    l_run += (rs0 + rs1) + (rs2 + rs3);
#pragma unroll
    for (int ks = 0; ks < 4; ++ks) { u32x4 w;
        if (ks < 2) { const int b = 8 * ks; w.x = cvtpk(s0[b], s0[b + 1]); w.y = cvtpk(s0[b + 2], s0[b + 3]); w.z = cvtpk(s0[b + 4], s0[b + 5]); w.w = cvtpk(s0[b + 6], s0[b + 7]); }
        else { const int b = 8 * (ks - 2); w.x = cvtpk(s1[b], s1[b + 1]); w.y = cvtpk(s1[b + 2], s1[b + 3]); w.z = cvtpk(s1[b + 4], s1[b + 5]); w.w = cvtpk(s1[b + 6], s1[b + 7]); }
        pb[ks] = __builtin_bit_cast(bf16x8, w); }
}
template <bool MFMA_DIRECT>
__device__ __forceinline__ void softmax_tile4(f32x16& s0, f32x16& s1, f32x16& s2, f32x16& s3, float& m_run, float& l_run, bool& seen, f32x16& negm, f32x16 (&o)[2], bf16x8 (&pa)[4], bf16x8 (&pb)[4], int lane) {
    if (MFMA_DIRECT) asm volatile("s_nop 15\n\ts_nop 7" : "+v"(s0), "+v"(s1), "+v"(s2), "+v"(s3));
    float ma = max3f(s0[0], s0[1], s1[0]), mb = max3f(s0[2], s0[3], s1[1]); ma = max3f(ma, s1[2], s1[3]);
#pragma unroll
    for (int r = 4; r < 16; r += 4) { ma = max3f(ma, s0[r], s0[r + 1]); mb = max3f(mb, s0[r + 2], s0[r + 3]); ma = max3f(ma, s1[r], s1[r + 1]); mb = max3f(mb, s1[r + 2], s1[r + 3]); }
#pragma unroll
    for (int r = 0; r < 16; r += 4) { ma = max3f(ma, s2[r], s2[r + 1]); mb = max3f(mb, s2[r + 2], s2[r + 3]); ma = max3f(ma, s3[r], s3[r + 1]); mb = max3f(mb, s3[r + 2], s3[r + 3]); }
    const float mh_ = max3f(ma, mb, mb);
    const auto rr_ = __builtin_amdgcn_permlane32_swap(__float_as_uint(mh_), __float_as_uint(mh_), false, false);
    float mx = max3f(__uint_as_float(rr_[0]), __uint_as_float(rr_[1]), mh_);
    const bool has = mx > -INFINITY;
    const bool need = seen ? (mx > SM_THR) : has;
    if (__any(need)) {
        const float delta = seen ? fmax2(mx, 0.f) : (has ? mx : 0.f);
        const float alpha = seen ? __builtin_amdgcn_exp2f(-delta) : 1.0f;
        m_run += delta; l_run *= alpha;
#pragma unroll
        for (int r = 0; r < 16; ++r) { s0[r] -= delta; s1[r] -= delta; s2[r] -= delta; s3[r] -= delta; o[0][r] *= alpha; o[1][r] *= alpha; negm[r] = -m_run; }
    }
    seen = seen || has;
    float rs0 = 0.f, rs1 = 0.f, rs2 = 0.f, rs3 = 0.f;
#pragma unroll
    for (int r = 0; r < 16; ++r) { s0[r] = __builtin_amdgcn_exp2f(s0[r]); s1[r] = __builtin_amdgcn_exp2f(s1[r]); s2[r] = __builtin_amdgcn_exp2f(s2[r]); s3[r] = __builtin_amdgcn_exp2f(s3[r]); }
#pragma unroll
    for (int r = 0; r < 16; ++r) { rs0 += s0[r]; rs1 += s1[r]; rs2 += s2[r]; rs3 += s3[r]; }
    l_run += (rs0 + rs1) + (rs2 + rs3);
#pragma unroll
    for (int ks = 0; ks < 4; ++ks) { u32x4 w, v;
        if (ks < 2) { const int b = 8 * ks; w.x = cvtpk(s0[b], s0[b + 1]); w.y = cvtpk(s0[b + 2], s0[b + 3]); w.z = cvtpk(s0[b + 4], s0[b + 5]); w.w = cvtpk(s0[b + 6], s0[b + 7]);
                                            v.x = cvtpk(s2[b], s2[b + 1]); v.y = cvtpk(s2[b + 2], s2[b + 3]); v.z = cvtpk(s2[b + 4], s2[b + 5]); v.w = cvtpk(s2[b + 6], s2[b + 7]); }
        else { const int b = 8 * (ks - 2); w.x = cvtpk(s1[b], s1[b + 1]); w.y = cvtpk(s1[b + 2], s1[b + 3]); w.z = cvtpk(s1[b + 4], s1[b + 5]); w.w = cvtpk(s1[b + 6], s1[b + 7]);
                                            v.x = cvtpk(s3[b], s3[b + 1]); v.y = cvtpk(s3[b + 2], s3[b + 3]); v.z = cvtpk(s3[b + 4], s3[b + 5]); v.w = cvtpk(s3[b + 6], s3[b + 7]); }
        pa[ks] = __builtin_bit_cast(bf16x8, w); pb[ks] = __builtin_bit_cast(bf16x8, v); }
}
__device__ __forceinline__ void pv_tile(f32x16 (&o)[2], const LAS unsigned char* vt, int vlane, const bf16x8 (&pb)[4]) {
#pragma unroll
    for (int d0 = 0; d0 < 2; ++d0) { const LAS unsigned char* vb = vt + (d0 ? (vlane ^ 64) : vlane);
#pragma unroll
        for (int ks = 0; ks < 4; ++ks) { const s16x4 lo = vtr(vb + ks * 2048), hi4 = vtr(vb + ks * 2048 + 1024);
            const bf16x8 vf = {lo[0], lo[1], lo[2], lo[3], hi4[0], hi4[1], hi4[2], hi4[3]};
            o[d0] = __builtin_amdgcn_mfma_f32_32x32x16_bf16(vf, pb[ks], o[d0], 0, 0, 0); } }
}
__device__ __forceinline__ void store_o(bf16* orow, const f32x16 (&o)[2], float inv, int hi) {
#pragma unroll
    for (int d0 = 0; d0 < 2; ++d0)
#pragma unroll
        for (int gq = 0; gq < 4; ++gq) { u32x2 w; w.x = pk2(o[d0][4 * gq] * inv, o[d0][4 * gq + 1] * inv); w.y = pk2(o[d0][4 * gq + 2] * inv, o[d0][4 * gq + 3] * inv);
            *(u32x2*)(orow + 32 * d0 + 8 * gq + 4 * hi) = w; }
}

constexpr int MLA_KP = 208;
constexpr int MLA_SK = 128 * MLA_KP, MLA_STAGE = MLA_SK + 128 * 128;
__device__ __forceinline__ void mla_unit(KP p, int b, int h, int qb, LAS unsigned char* lds, int wv) {
    const int tid = otid(wv), lane = tid & 63, wid = tid >> 6, r32 = lane & 31, hi = lane >> 5;
    const bf16* QM = (const bf16*)(p->ws + WS_QM); const bf16* KVM = (const bf16*)(p->ws + WS_KVM); bf16* CLAT = (bf16*)(p->ws + WS_CLAT);
    const size_t row0 = (size_t)b * SEQ;
    const size_t qtok = row0 + qb * 256 + wid * 32 + r32;
    bf16x8 qf[6];
#pragma unroll
    for (int s = 0; s < 6; ++s) qf[s] = *(const bf16x8*)(QM + qtok * 768 + h * 96 + 16 * s + 8 * hi);
    const int skey = tid >> 3, sch = tid & 7, rkey = tid >> 2, rch = tid & 3;
    const bf16* gkn = KVM + (row0 + skey) * 1024 + h * 128 + 8 * sch;
    const bf16* gkr = CLAT + (row0 + rkey) * 1024 + 768 + 8 * rch;
    const int lkn = skey * MLA_KP + 16 * sch, lkr = rkey * MLA_KP + 128 + 16 * rch, lv = MLA_SK + skey * 128 + ((sch ^ (((skey >> 1) & 1) << 2)) * 16);
    const int q4 = (lane & 15) >> 2, p4 = lane & 3, G1 = (lane >> 4) & 1;
    const int vlane = (4 * hi + q4) * 128 + (4 * ((q4 >> 1) & 1) + 2 * G1 + (p4 >> 1)) * 16 + 8 * (p4 & 1);
    const int klane = r32 * MLA_KP + 16 * hi;
    f32x16 o[2]; o[0] = f32x16{}; o[1] = f32x16{};
    float m_run = 0.f, l_run = 0.f; bool seen = false; f32x16 negm = f32x16{};
    u32x4 rk0, rk1, rv0, rv1, rkr;
#define MLA_LOAD(t) do { const size_t adv = (size_t)(t) * 128 * 1024; rk0 = *(const u32x4*)(gkn + adv); rk1 = *(const u32x4*)(gkn + adv + 64 * 1024); rv0 = *(const u32x4*)(gkn + adv + 64); rv1 = *(const u32x4*)(gkn + adv + 64 * 1024 + 64); rkr = *(const u32x4*)(gkr + adv); } while (0)
#define MLA_WRITE(buf) do { LAS unsigned char* B_ = lds + (buf) * MLA_STAGE; *(LAS u32x4*)(B_ + lkn) = rk0; *(LAS u32x4*)(B_ + lkn + 64 * MLA_KP) = rk1; *(LAS u32x4*)(B_ + lv) = rv0; *(LAS u32x4*)(B_ + lv + 64 * 128) = rv1; *(LAS u32x4*)(B_ + lkr) = rkr; } while (0)
    const bool grpB = wv >= 4;
#define PP_BAR() do { __builtin_amdgcn_sched_barrier(0); __syncthreads(); __builtin_amdgcn_sched_barrier(0); } while (0)
    MLA_LOAD(0); MLA_WRITE(0); MLA_LOAD(1);
    constexpr int NS = SEQ / 128;
    PP_BAR();
    if (grpB) PP_BAR();
    bf16x8 pa[4] = {}, pb[4] = {};
    int bc = 0, bn = 1, bp = 2;
    for (int t = 0; t < NS; ++t) {
        if (t + 1 < NS) MLA_WRITE(bn);
        if (t + 2 < NS) MLA_LOAD(t + 2);
        const LAS unsigned char* Kb = lds + bc * MLA_STAGE; const LAS unsigned char* Vp = lds + bp * MLA_STAGE + MLA_SK;
        if (t > 0) { pv_tile(o, Vp, vlane, pa); pv_tile(o, Vp + 64 * 128, vlane, pb); }
        f32x16 s0 = negm, s1 = negm, s2 = negm, s3 = negm;
#pragma unroll
        for (int s = 0; s < 6; ++s) { const bf16x8 a0 = *(const LAS bf16x8*)(Kb + klane + 32 * s), a1 = *(const LAS bf16x8*)(Kb + klane + 32 * MLA_KP + 32 * s);
            const bf16x8 a2 = *(const LAS bf16x8*)(Kb + klane + 64 * MLA_KP + 32 * s), a3 = *(const LAS bf16x8*)(Kb + klane + 96 * MLA_KP + 32 * s);
            s0 = __builtin_amdgcn_mfma_f32_32x32x16_bf16(a0, qf[s], s0, 0, 0, 0); s1 = __builtin_amdgcn_mfma_f32_32x32x16_bf16(a1, qf[s], s1, 0, 0, 0);
            s2 = __builtin_amdgcn_mfma_f32_32x32x16_bf16(a2, qf[s], s2, 0, 0, 0); s3 = __builtin_amdgcn_mfma_f32_32x32x16_bf16(a3, qf[s], s3, 0, 0, 0); }
        PP_BAR();
        softmax_tile4<true>(s0, s1, s2, s3, m_run, l_run, seen, negm, o, pa, pb, lane);
        PP_BAR();
        const int tmp = bp; bp = bc; bc = bn; bn = tmp;
    }
    { const LAS unsigned char* Vp = lds + bp * MLA_STAGE + MLA_SK; pv_tile(o, Vp, vlane, pa); pv_tile(o, Vp + 64 * 128, vlane, pb); }
    if (!grpB) PP_BAR();
#undef PP_BAR
#undef MLA_LOAD
#undef MLA_WRITE
    l_run += shflx(l_run, 32, lane);
    store_o(CLAT + qtok * 1024 + h * 64, o, 1.0f / l_run, hi);
    __syncthreads();
}
__device__ __forceinline__ int conv_group() { return (int)((blockIdx.x >> 3) % 6u); }
__device__ __forceinline__ void phase_attn_mla(KP p, int l, LAS unsigned char* lds, int wv) {
    const int G = gridDim.x, bx = blockIdx.x; const int vcu = (G % 8 == 0) ? (bx % 8) * (G / 8) + bx / 8 : bx;
    const int grp = conv_group(); int k = 0;
    for (int u = vcu; u < NB * 8 * 8; u += G, ++k) { if (k == grp) { phase_convert(p, l, lds, wv, true); __syncthreads(); } mla_unit(p, u >> 6, (u >> 3) & 7, u & 7, lds, wv); }
    if (k <= grp && grp < 4) { phase_convert(p, l, lds, wv, true); __syncthreads(); }
}

constexpr int W_KP = 144;
constexpr int W_TILE = 64 * W_KP + 64 * 128 + 256;
struct WinDesc {
    int ntile, dil, Lsub, tokbase, kcol, vcol;
    int kind, sbase, rbase;
    int qsub, posq, tlo, tn, ksub_lo, radius;
    float slope2, sink2; bool sink; bf16* qrow; float* lse_out;
    __device__ __forceinline__ int sub0(int t) const { return kind == 0 ? sbase + 64 * t : 64 * (t & 1); }
    __device__ __forceinline__ int res(int t) const { return kind == 0 ? rbase : rbase + (t >> 1); }
    __device__ __forceinline__ bool on(int t) const { const int s0 = sub0(t); return t < ntile && s0 >= 0 && s0 < Lsub; }
};
__device__ __forceinline__ void win_make_desc(KP p, int l, int u, int wid, int r32, WinDesc& D) {
    bf16* QKV = (bf16*)(p->ws + WS_QKV); float* LSE = (float*)(p->ws + OFF_LSE);
    if (u < 1536) {
        const int g = u >> 9, v = u & 511, b = v >> 5, h = (v >> 3) & 3, w8 = v & 7;
        const int dil = g == 0 ? 1 : (g == 1 ? 4 : 16);
        D.dil = dil; D.Lsub = SEQ / dil; D.tokbase = b * SEQ; D.kcol = 768 + g * 256 + h * 64; D.vcol = 1536 + g * 256 + h * 64;
        int rq, qs0;
        if (g == 0) { D.ntile = 6; D.kind = 0; D.sbase = 256 * w8 - 64; D.rbase = 0; rq = 0; qs0 = 256 * w8 + 32 * wid; D.tlo = wid >> 1; D.tn = 3; D.ksub_lo = 256 * w8 - 64 + 64 * D.tlo; }
        else if (g == 1) { const int rr = w8 >> 1, uu = w8 & 1; D.ntile = 6; D.kind = 0; D.sbase = 256 * uu - 64; D.rbase = rr; rq = rr; qs0 = 256 * uu + 32 * wid; D.tlo = wid >> 1; D.tn = 3; D.ksub_lo = 256 * uu - 64 + 64 * D.tlo; }
        else { D.ntile = 4; D.kind = 1; D.sbase = 0; D.rbase = 2 * w8; rq = 2 * w8 + (wid >> 2); qs0 = 32 * (wid & 3); D.tlo = 2 * (wid >> 2); D.tn = 2; D.ksub_lo = 0; }
        D.qsub = qs0 + r32; const size_t tok = (size_t)b * SEQ + (size_t)D.qsub * dil + rq;
        D.qrow = QKV + tok * 3072 + g * 256 + h * 64; D.posq = p->pos[tok]; D.radius = 64;
        D.slope2 = __builtin_amdgcn_exp2f(-8.0f * (float)(4 * g + h + 1) / 12.0f) * LOG2E; D.sink2 = 0.f; D.sink = false;
        D.lse_out = LSE + tok * 12 + g * 4 + h;
    } else {
        const int v = u - 1536, b = v >> 6, kvh = (v >> 5) & 1, blk = v & 31;
        D.dil = 1; D.Lsub = SEQ; D.tokbase = b * SEQ; D.kcol = 2816 + kvh * 64; D.vcol = 2944 + kvh * 64; D.ntile = 5; D.kind = 0; D.sbase = 64 * blk - 128; D.rbase = 0;
        const int rep = wid >> 1, head = kvh * 4 + rep;
        D.qsub = 64 * blk + 32 * (wid & 1) + r32; const size_t tok = (size_t)b * SEQ + D.qsub;
        D.qrow = QKV + tok * 3072 + 2304 + head * 64; D.posq = p->pos[tok]; D.radius = 128; D.tlo = 0; D.tn = 5; D.ksub_lo = 64 * blk - 128;
        D.slope2 = __builtin_amdgcn_exp2f(-(float)(head + 1)) * LOG2E; D.sink2 = p->sink_win[l * 8 + head] * LOG2E; D.sink = true; D.lse_out = nullptr;
    }
}
struct WinRegs { u32x4 rk[6], rv[6]; int rp[6]; bf16x8 qf[4]; };
__device__ __forceinline__ void win_issue(KP p, const WinDesc& D, int tid, int hi, WinRegs& R) {
    const bf16* QKV = (const bf16*)(p->ws + WS_QKV); const int key = tid >> 3, ch = tid & 7;
#pragma unroll
    for (int t = 0; t < 6; ++t) { if (D.on(t)) { const size_t tok = (size_t)D.tokbase + (size_t)(D.sub0(t) + key) * D.dil + D.res(t);
            R.rk[t] = *(const u32x4*)(QKV + tok * 3072 + D.kcol + 8 * ch); R.rv[t] = *(const u32x4*)(QKV + tok * 3072 + D.vcol + 8 * ch);
            R.rp[t] = (tid < 64) ? p->pos[(size_t)D.tokbase + (size_t)(D.sub0(t) + tid) * D.dil + D.res(t)] : 0; } }
#pragma unroll
    for (int s = 0; s < 4; ++s) R.qf[s] = *(const bf16x8*)(D.qrow + 16 * s + 8 * hi);
}
__device__ __forceinline__ void win_write(LAS unsigned char* lds, const WinDesc& D, int tid, const WinRegs& R) {
    const int key = tid >> 3, ch = tid & 7;
#pragma unroll
    for (int t = 0; t < 6; ++t) { if (D.on(t)) { LAS unsigned char* Kt = lds + t * W_TILE;
            *(LAS u32x4*)(Kt + key * W_KP + 16 * ch) = R.rk[t];
            *(LAS u32x4*)(Kt + 64 * W_KP + key * 128 + ((ch ^ (((key >> 1) & 1) << 2)) * 16)) = R.rv[t];
            if (tid < 64) *(LAS float*)(Kt + 64 * W_KP + 64 * 128 + 4 * tid) = (float)R.rp[t]; } }
}
template <bool SINK>
__device__ __forceinline__ void win_wave(LAS unsigned char* lds, const WinDesc& D, const bf16x8 (&qf)[4], int lane) {
    const int r32 = lane & 31, hi = lane >> 5;
    const int q4 = (lane & 15) >> 2, p4 = lane & 3, G1 = (lane >> 4) & 1;
    const int vlane = (4 * hi + q4) * 128 + (4 * ((q4 >> 1) & 1) + 2 * G1 + (p4 >> 1)) * 16 + 8 * (p4 & 1);
    const int klane = r32 * W_KP + 16 * hi;
    f32x16 o[2]; o[0] = f32x16{}; o[1] = f32x16{};
    float m_run = SINK ? D.sink2 : 0.f, l_run = SINK ? (hi == 0 ? 1.0f : 0.0f) : 0.f; bool seen = SINK; f32x16 negm;
#pragma unroll
    for (int r = 0; r < 16; ++r) negm[r] = -m_run;
    const int qsub = D.qsub, radius = D.radius; const float slope2 = D.slope2, posqf = (float)D.posq;
    for (int tt = 0; tt < D.tn; ++tt) {
        const int ks0 = D.ksub_lo + 64 * tt;
        if (ks0 < 0 || ks0 >= D.Lsub) continue;
        const LAS unsigned char* Kt = lds + (D.tlo + tt) * W_TILE; const LAS unsigned char* Vt = Kt + 64 * W_KP; const LAS float* pkf = (const LAS float*)(Vt + 64 * 128);
        f32x16 s0 = negm, s1 = negm;
#pragma unroll
        for (int s = 0; s < 4; ++s) { const bf16x8 a0 = *(const LAS bf16x8*)(Kt + klane + 32 * s), a1 = *(const LAS bf16x8*)(Kt + klane + 32 * W_KP + 32 * s);
            s0 = __builtin_amdgcn_mfma_f32_32x32x16_bf16(a0, qf[s], s0, 0, 0, 0); s1 = __builtin_amdgcn_mfma_f32_32x32x16_bf16(a1, qf[s], s1, 0, 0, 0); }
        const int c0 = ks0 - qsub + 4 * hi + radius; const unsigned lim = 2u * (unsigned)radius;
#pragma unroll
        for (int gq = 0; gq < 4; ++gq) { const f32x4 pa = *(const LAS f32x4*)(pkf + 8 * gq + 4 * hi), pb4 = *(const LAS f32x4*)(pkf + 32 + 8 * gq + 4 * hi);
#pragma unroll
            for (int e = 0; e < 4; ++e) { const int r = 4 * gq + e;
                s0[r] = (unsigned)(c0 + 8 * gq + e) <= lim ? s0[r] - slope2 * fabsf(posqf - pa[e]) : -INFINITY;
                s1[r] = (unsigned)(c0 + 8 * gq + e + 32) <= lim ? s1[r] - slope2 * fabsf(posqf - pb4[e]) : -INFINITY; } }
        bf16x8 pb[4];
        softmax_tile<false>(s0, s1, m_run, l_run, seen, negm, o, pb, lane);
        pv_tile(o, Vt, vlane, pb);
    }
    l_run += shflx(l_run, 32, lane);
    store_o(D.qrow, o, 1.0f / l_run, hi);
    if (!SINK && hi == 0) *D.lse_out = m_run + __log2f(l_run);
}
__device__ __forceinline__ void phase_attn_win(KP p, int l, LAS unsigned char* lds, int wv) {
    const int tid = otid(wv), lane = tid & 63, wid = wv, r32 = lane & 31, hi = lane >> 5;
    const int G = gridDim.x, bx = blockIdx.x;
    int u = (G % 8 == 0) ? (bx % 8) * (G / 8) + bx / 8 : bx;
    WinDesc Dn; WinRegs Rn;
    if (u < 2560) { win_make_desc(p, l, u, wid, r32, Dn); win_issue(p, Dn, tid, hi, Rn); }
    for (; u < 2560; u += G) {
        const WinDesc D = Dn;
        __syncthreads();
        win_write(lds, D, tid, Rn);
        bf16x8 qf[4];
#pragma unroll
        for (int s = 0; s < 4; ++s) qf[s] = Rn.qf[s];
        __syncthreads();
        if (u + G < 2560) { win_make_desc(p, l, u + G, wid, r32, Dn); win_issue(p, Dn, tid, hi, Rn); }
        if (wv >= 4) __builtin_amdgcn_s_sleep(12);
        if (D.sink) win_wave<true>(lds, D, qf, lane); else win_wave<false>(lds, D, qf, lane);
    }
    __syncthreads();
}
__device__ __forceinline__ void phase_dil_combine(KP p, int wv) {
    WAVE_IDS();
    const bf16* QKV = (const bf16*)(p->ws + WS_QKV); const float* LSE = (const float*)(p->ws + OFF_LSE); bf16* CLAT = (bf16*)(p->ws + WS_CLAT);
    const int h = lane >> 4, d0 = (lane & 15) * 4;
    for (int m0 = gw; m0 < T; m0 += 4 * NGW) {
        float ls[4][3]; u32x2 w[4][3];
#pragma unroll
        for (int q = 0; q < 4; ++q) { const int m = m0 + q * NGW;
#pragma unroll
            for (int g = 0; g < 3; ++g) { ls[q][g] = LSE[(size_t)m * 12 + g * 4 + h]; w[q][g] = *(const u32x2*)(QKV + (size_t)m * 3072 + g * 256 + h * 64 + d0); } }
#pragma unroll
        for (int q = 0; q < 4; ++q) { const int m = m0 + q * NGW;
            const float mx = fmaxf(ls[q][0], fmaxf(ls[q][1], ls[q][2]));
            float e[3], es = 0.f;
#pragma unroll
            for (int g = 0; g < 3; ++g) { e[g] = __builtin_amdgcn_exp2f(ls[q][g] - mx); es += e[g]; }
            const float inv = 1.0f / es; float o[4] = {0.f, 0.f, 0.f, 0.f};
#pragma unroll
            for (int g = 0; g < 3; ++g) { const float wg = e[g] * inv; o[0] += wg * bflo(w[q][g].x); o[1] += wg * bfhi(w[q][g].x); o[2] += wg * bflo(w[q][g].y); o[3] += wg * bfhi(w[q][g].y); }
            u32x2 ow; ow.x = pk2(o[0], o[1]); ow.y = pk2(o[2], o[3]);
            *(u32x2*)(CLAT + (size_t)m * 1024 + 512 + h * 64 + d0) = ow; }
    }
}
__device__ __forceinline__ void split3(const f32x4 w, u32x2& hi, u32x2& mid, u32x2& lo) {
    hi.x = pg8::cvt_pk_bf16(w.x, w.y); hi.y = pg8::cvt_pk_bf16(w.z, w.w);
    const f32x4 r1 = {w.x - bflo(hi.x), w.y - bfhi(hi.x), w.z - bflo(hi.y), w.w - bfhi(hi.y)};
    mid.x = pg8::cvt_pk_bf16(r1.x, r1.y); mid.y = pg8::cvt_pk_bf16(r1.z, r1.w);
    const f32x4 r2 = {r1.x - bflo(mid.x), r1.y - bfhi(mid.x), r1.z - bflo(mid.y), r1.w - bfhi(mid.y)};
    lo.x = pg8::cvt_pk_bf16(r2.x, r2.y); lo.y = pg8::cvt_pk_bf16(r2.z, r2.w);
}
__device__ __forceinline__ void phase_norm2_route(KP p, int l, LAS unsigned char* lds, int wv) {
    WAVE_IDS();
    constexpr int WPITCH = 1040;
    constexpr int GS_OFF = 112640, SH_OFF = GS_OFF + 4096, CB_OFF = SH_OFF + 4096, LG_OFF = CB_OFF + 1024;
    static_assert(3 * 36 * WPITCH <= GS_OFF && LG_OFF + 8 * 2304 <= MISC_OFF, "router LDS map");
    const float* mod = (const float*)(p->ws + OFF_MOD) + (size_t)l * NB * 6144;
    const float* wrt = (const float*)(p->ws + OFF_WRT) + (size_t)l * 36 * 1024;
    bf16* XN = (bf16*)(p->ws + WS_XN);
    int* RE = (int*)(p->ws + OFF_RE); float* RG = (float*)(p->ws + OFF_RG); int* BCNT = (int*)(p->ws + OFF_BCNT);
    LAS int* hist = (LAS int*)(lds + MISC_OFF + 4096);
    LAS float* ssl = (LAS float*)(lds + MISC_OFF + 4608) + wave * 16;
    LAS float* lgw = (LAS float*)(lds + LG_OFF) + wave * 16 * 36;
    LAS float* cbp = (LAS float*)(lds + CB_OFF);
    { int* tokidx = (int*)(p->ws + OFF_LSE); for (int i = (int)blockIdx.x * NT + tid; i < XS_ROWS; i += (int)gridDim.x * NT) tokidx[i] = -1; }
    for (int chunk = blockIdx.x; chunk < T / 128; chunk += gridDim.x) {
        int tl = tid; asm volatile("" : "+v"(tl));
        const int r = tl & 15, q = (tl >> 4) & 3;
        const int k4 = tl & 127, j0 = tl >> 7;
        const int b = chunk >> 4;
        const int row = chunk * 128 + wave * 16 + r;
        f32x4 wst[9];
#pragma unroll
        for (int it = 0; it < 9; ++it) wst[it] = *(const f32x4*)(wrt + (j0 + 4 * it) * 1024 + 4 * k4);
        const f32x2 gn = *(const f32x2*)(p->g_norm2 + l * D + 2 * tid), sc = *(const f32x2*)(mod + b * 6144 + 4096 + 2 * tid), sh = *(const f32x2*)(mod + b * 6144 + 3072 + 2 * tid);
        u32x4 xa[32];
        { const bf16* xrow = (const bf16*)(p->ws + WS_CLAT) + (size_t)row * D + 8 * q;
#pragma unroll
          for (int s = 0; s < 32; ++s) xa[s] = *(const u32x4*)(xrow + 32 * s); }
        if (tid < 32) hist[tid] = 0;
        *(LAS f32x2*)(lds + GS_OFF + 8 * tid) = gn * (sc + 1.0f); *(LAS f32x2*)(lds + SH_OFF + 8 * tid) = sh;
        __syncthreads();
        f32x4 acc[3] = {{0.f, 0.f, 0.f, 0.f}, {0.f, 0.f, 0.f, 0.f}, {0.f, 0.f, 0.f, 0.f}}, ssa = {0.f, 0.f, 0.f, 0.f};
#pragma unroll
        for (int h = 0; h < 2; ++h) {
            { const int col = 512 * h + 4 * k4;
              const f32x4 g4 = *(const LAS f32x4*)(lds + GS_OFF + 4 * col), s4 = *(const LAS f32x4*)(lds + SH_OFF + 4 * col);
#pragma unroll
              for (int it = 0; it < 9; ++it) { const int j = j0 + 4 * it; const f32x4 w = wst[it];
                  float cp = (s4.x * w.x + s4.y * w.y) + (s4.z * w.z + s4.w * w.w);
                  cp = wave_sum(cp, lane);
                  if (lane == 0) cbp[(2 * h + (wave & 1)) * 36 + j] = cp + ((h == 0 && (wave & 1) == 0) ? (j < 4 ? p->b_gr[l * 4 + j] : p->b_er[l * 32 + j - 4]) : 0.f);
                  u32x2 hi, mid, lo; split3(w * g4, hi, mid, lo);
                  *(LAS u32x2*)(lds + (0 * 36 + j) * WPITCH + 8 * k4) = hi; *(LAS u32x2*)(lds + (1 * 36 + j) * WPITCH + 8 * k4) = mid; *(LAS u32x2*)(lds + (2 * 36 + j) * WPITCH + 8 * k4) = lo; } }
            __syncthreads();
#pragma unroll
            for (int s2 = 0; s2 < 16; ++s2) { const bf16x8 a = __builtin_bit_cast(bf16x8, xa[16 * h + s2]);
                ssa = __builtin_amdgcn_mfma_f32_16x16x32_bf16(a, a, ssa, 0, 0, 0);
#pragma unroll
                for (int nt = 0; nt < 3; ++nt) { const int jr = (16 * nt + r) < 35 ? (16 * nt + r) : 35;
#pragma unroll
                    for (int t = 0; t < 3; ++t) { const bf16x8 bw = *(const LAS bf16x8*)(lds + (t * 36 + jr) * WPITCH + 64 * s2 + 16 * q);
                        acc[nt] = __builtin_amdgcn_mfma_f32_16x16x32_bf16(a, bw, acc[nt], 0, 0, 0); } }
                __builtin_amdgcn_sched_barrier(0); }
            if (h == 0) {
#pragma unroll
                for (int it = 0; it < 9; ++it) wst[it] = *(const f32x4*)(wrt + (j0 + 4 * it) * 1024 + 512 + 4 * k4); }
            __syncthreads();
        }
#pragma unroll
        for (int nt = 0; nt < 3; ++nt) if (16 * nt + r < 36) {
#pragma unroll
            for (int i = 0; i < 4; ++i) lgw[(4 * q + i) * 36 + 16 * nt + r] = acc[nt][i]; }
        if ((r >> 2) == q) { const int i = r & 3; ssl[r] = i == 0 ? ssa.x : (i == 1 ? ssa.y : (i == 2 ? ssa.z : ssa.w)); }
        asm volatile("s_waitcnt lgkmcnt(0)" ::: "memory");
        const float rstd = __builtin_amdgcn_rsqf(ssl[r] * (1.0f / D) + EPS);
        if (lane < 16) { const int m = row; const LAS float* Lr = lgw + lane * 36;
#define LGT(j) (Lr[j] * rstd + ((cbp[j] + cbp[36 + (j)]) + (cbp[72 + (j)] + cbp[108 + (j)])))
            float Lg[4];
#pragma unroll
            for (int g = 0; g < 4; ++g) Lg[g] = LGT(g);
            float gm = Lg[0]; int gi = 0;
#pragma unroll
            for (int g = 1; g < 4; ++g) if (Lg[g] > gm) { gm = Lg[g]; gi = g; }
            float gs = 0.f;
#pragma unroll
            for (int g = 0; g < 4; ++g) gs += __expf(Lg[g] - gm);
            const float gw_ = 1.0f / gs;
            float el[8]; float em = -INFINITY;
#pragma unroll
            for (int e = 0; e < 8; ++e) { el[e] = LGT(4 + gi * 8 + e); em = fmaxf(em, el[e]); }
#undef LGT
            float es = 0.f;
#pragma unroll
            for (int e = 0; e < 8; ++e) { el[e] = __expf(el[e] - em); es += el[e]; }
            int i1 = 0; float p1 = el[0];
#pragma unroll
            for (int e = 1; e < 8; ++e) if (el[e] > p1) { p1 = el[e]; i1 = e; }
            int i2 = -1; float p2 = -1.f;
#pragma unroll
            for (int e = 0; e < 8; ++e) if (e != i1 && el[e] > p2) { p2 = el[e]; i2 = e; }
            const float inv = gw_ / (p1 + p2);
            const int e1 = gi * 8 + i1, e2 = gi * 8 + i2;
            RE[2 * m] = e1; RE[2 * m + 1] = e2; RG[2 * m] = p1 * inv; RG[2 * m + 1] = p2 * inv;
            __hip_atomic_fetch_add(&hist[e1], 1, __ATOMIC_RELAXED, __HIP_MEMORY_SCOPE_WORKGROUP); __hip_atomic_fetch_add(&hist[e2], 1, __ATOMIC_RELAXED, __HIP_MEMORY_SCOPE_WORKGROUP);
        }
        { bf16* xo = XN + (size_t)row * D + 8 * q;
#pragma unroll
          for (int s = 0; s < 32; ++s) { const int col = 32 * s + 8 * q; const u32x4 w = xa[s];
              const f32x4 g0 = *(const LAS f32x4*)(lds + GS_OFF + 4 * col), g1 = *(const LAS f32x4*)(lds + GS_OFF + 4 * col + 16), h0 = *(const LAS f32x4*)(lds + SH_OFF + 4 * col), h1 = *(const LAS f32x4*)(lds + SH_OFF + 4 * col + 16);
              const f32x4 y0 = (f32x4){bflo(w.x), bfhi(w.x), bflo(w.y), bfhi(w.y)} * rstd * g0 + h0, y1 = (f32x4){bflo(w.z), bfhi(w.z), bflo(w.w), bfhi(w.w)} * rstd * g1 + h1;
              u32x4 o; o.x = pg8::cvt_pk_bf16(y0.x, y0.y); o.y = pg8::cvt_pk_bf16(y0.z, y0.w); o.z = pg8::cvt_pk_bf16(y1.x, y1.y); o.w = pg8::cvt_pk_bf16(y1.z, y1.w);
              *(u32x4*)(xo + 32 * s) = o; __builtin_amdgcn_sched_barrier(0); } }
        __syncthreads();
        if (tid < 32) BCNT[chunk * 32 + tid] = hist[tid];
        __syncthreads();
    }
}
__device__ __forceinline__ void phase_dispatch(KP p, LAS unsigned char* lds, int wv) {
    WAVE_IDS();
    const int* BCNT = (const int*)(p->ws + OFF_BCNT); const int* RE = (const int*)(p->ws + OFF_RE); int* RD = (int*)(p->ws + OFF_RD);
    int* tokidx = (int*)(p->ws + OFF_LSE);
    LAS int* part = (LAS int*)lds;
    LAS int* tot = (LAS int*)(lds + 4096);
    LAS int* earr = (LAS int*)(lds + 8192);
    LAS int* darr = (LAS int*)(lds + 8192 + 1024);
    LAS int* misc = (LAS int*)(lds + MISC_OFF);
    for (int chunk = blockIdx.x; chunk < T / 128; chunk += gridDim.x) {
        { const int e = tid & 31, pt = tid >> 5; int s = 0, sb = 0;
          for (int c = pt * 16; c < pt * 16 + 16; ++c) { const int v = BCNT[c * 32 + e]; s += v; if (c < chunk) sb += v; }
          part[pt * 32 + e] = s; part[512 + pt * 32 + e] = sb; }
        if (tid < 256) earr[tid] = RE[chunk * 256 + tid];
        __syncthreads();
        if (tid < 32) { int s = 0, sb = 0;
            for (int pt = 0; pt < 16; ++pt) { s += part[pt * 32 + tid]; sb += part[512 + pt * 32 + tid]; }
            tot[tid] = s; tot[32 + tid] = sb; }
        __syncthreads();
        if (tid < 32) { int base = 0; for (int e = 0; e < tid; ++e) base += (tot[e] + 255) & ~255; tot[64 + tid] = base; }
        __syncthreads();
        if (tid == 0) { int nt = 0; for (int e = 0; e < 32; ++e) { const int k = (tot[e] + 255) >> 8; for (int i = 0; i < k; ++i) misc[16 + nt + i] = e; nt += k; } misc[0] = nt; }
        if (tid < 256) { const int e = earr[tid]; int rank = 0; for (int a = 0; a < tid; ++a) rank += (earr[a] == e) ? 1 : 0;
            const int dest = tot[64 + e] + tot[32 + e] + rank; darr[tid] = dest; RD[chunk * 256 + tid] = dest; }
        __syncthreads();
        if (tid < 256) tokidx[darr[tid]] = chunk * 256 + tid;
        __syncthreads();
    }
}
template <int NJ> struct MoeOrder {
    const LAS int* misc; int G, c;
    __device__ __forceinline__ bool next(int i, pg8::Unit& u) const {
        const int L = i * G + c; const int nt = misc[0];
        if (L >= nt * NJ) return false;
        const int tile = L / NJ, j = L - tile * NJ; u.pm = tile; u.pn = misc[16 + tile] * NJ + j; return true;
    }
    __device__ __forceinline__ void a_ready(const pg8::Unit&) const {}
    __device__ __forceinline__ void done(const pg8::Unit&) const {}
};
__device__ __forceinline__ void phase_combine(KP p, int l, bool next_norm, int wv) {
    WAVE_IDS();
    const float* mod = (const float*)(p->ws + OFF_MOD) + (size_t)l * NB * 6144;
    const float* modn = (const float*)(p->ws + OFF_MOD) + (size_t)(l + 1) * NB * 6144;
    const int* RD = (const int*)(p->ws + OFF_RD); const float* RG = (const float*)(p->ws + OFF_RG);
    const bf16* Y = (const bf16*)(p->ws + WS_QKV); bf16* XN = (bf16*)(p->ws + WS_XN);
    for (int m0 = gw; m0 < T; m0 += 2 * NGW) {
        int dd[2][2]; float gg[2][2];
#pragma unroll
        for (int q = 0; q < 2; ++q) { const int m = m0 + q * NGW; dd[q][0] = 2 * m; dd[q][1] = 2 * m + 1;
            gg[q][0] = RG[2 * m]; gg[q][1] = RG[2 * m + 1];
        }
        f32x4 xv[2][4]; u32x2 y0[2][4], y1[2][4];
#pragma unroll
        for (int q = 0; q < 2; ++q) { const int m = m0 + q * NGW; const bf16* xrow = (const bf16*)(p->ws + WS_CLAT) + (size_t)m * D;
#pragma unroll
            for (int j = 0; j < 4; ++j) { const int cidx = 4 * lane + 256 * j; { const u32x2 w = *(const u32x2*)(xrow + cidx); xv[q][j] = (f32x4){bflo(w.x), bfhi(w.x), bflo(w.y), bfhi(w.y)}; }
                y0[q][j] = *(const u32x2*)(Y + (size_t)dd[q][0] * D + cidx); y1[q][j] = *(const u32x2*)(Y + (size_t)dd[q][1] * D + cidx); } }
        f32x4 gtv[2][4], gnv[4], s1v[2][4], s0v[2][4];
#pragma unroll
        for (int q = 0; q < 2; ++q) { const int b = (m0 + q * NGW) >> 11;
#pragma unroll
            for (int j = 0; j < 4; ++j) { const int cidx = 4 * lane + 256 * j; gtv[q][j] = *(const f32x4*)(mod + b * 6144 + 5120 + cidx);
                if (next_norm) { s1v[q][j] = *(const f32x4*)(modn + b * 6144 + 1024 + cidx); s0v[q][j] = *(const f32x4*)(modn + b * 6144 + cidx); if (q == 0) gnv[j] = *(const f32x4*)(p->g_norm1 + (l + 1) * D + cidx); } } }
#pragma unroll
        for (int q = 0; q < 2; ++q) { const int m = m0 + q * NGW; float* xrow = p->out + (size_t)m * D; bf16* xrow16 = (bf16*)p->out + (size_t)m * D; const float g0 = gg[q][0], g1 = gg[q][1]; f32x4 v[4]; float ss = 0.f;
#pragma unroll
            for (int j = 0; j < 4; ++j) { const int cidx = 4 * lane + 256 * j; const f32x4 gt = gtv[q][j];
                f32x4 yy; yy.x = g0 * bflo(y0[q][j].x) + g1 * bflo(y1[q][j].x); yy.y = g0 * bfhi(y0[q][j].x) + g1 * bfhi(y1[q][j].x); yy.z = g0 * bflo(y0[q][j].y) + g1 * bflo(y1[q][j].y); yy.w = g0 * bfhi(y0[q][j].y) + g1 * bfhi(y1[q][j].y);
                v[j] = xv[q][j] + gt * yy;
                if (next_norm) { u32x2 o; o.x = pk2(v[j].x, v[j].y); o.y = pk2(v[j].z, v[j].w); *(u32x2*)(xrow16 + cidx) = o; }
                else *(f32x4*)(xrow + cidx) = v[j];
                ss += (v[j].x * v[j].x + v[j].y * v[j].y) + (v[j].z * v[j].z + v[j].w * v[j].w); }
            if (next_norm) { const float rstd = __builtin_amdgcn_rsqf(wave_sum(ss, lane) * (1.0f / D) + EPS);
#pragma unroll
                for (int j = 0; j < 4; ++j) { const int cidx = 4 * lane + 256 * j;
                    const f32x4 y = v[j] * rstd * gnv[j] * (s1v[q][j] + 1.0f) + s0v[q][j]; u32x2 o; o.x = pk2(y.x, y.y); o.y = pk2(y.z, y.w); *(u32x2*)(XN + (size_t)m * D + cidx) = o; } } }
    }
}

#ifndef ALIGN_SMALLK
#define ALIGN_SMALLK true
#endif
template <int l> __device__ __forceinline__ void layer_body(LAS unsigned char* lds, const XcdBarrier& xbar, int wv) {
    const int G = gridDim.x, bx = blockIdx.x;
    unsigned char* ws = kparams()->ws;
    bf16* XN = (bf16*)(ws + WS_XN); bf16* CLAT = (bf16*)(ws + WS_CLAT); bf16* QKV = (bf16*)(ws + WS_QKV); bf16* QM = (bf16*)(ws + WS_QM); bf16* KVM = (bf16*)(ws + WS_KVM);
    const float* modall = (const float*)(ws + OFF_MOD);
    const bf16* Win_t = (const bf16*)(ws + WS_WIN);
    {
        const float* xin = l == 0 ? kparams()->x : kparams()->out;
        { pg8::Gemm g{XN, Win_t, 1024, 1024, 1024, wv}; pg8::StaticOrder S; S.init(T, 4096, G, bx);
          KP p = kparams();
          pg8::EpiProj E{QKV, CLAT, (float*)(ws + OFF_LSE), p->pos, p->g_q_dil + l * 64, p->g_k_dil + l * 64, p->g_q_win + l * 64, p->g_k_win + l * 64, p->g_k_mla + l * 96 + 64, SC_HD};
          pg8::gemm_phase<pg8::EpiProj, pg8::StaticOrder, true, true>(lds, g, S, E); }
        xcd_barrier(xbar);
        { pg8::Gemm g{CLAT, (const bf16*)(ws + WS_WUQ), 1024, 512, 512, wv}; pg8::StaticOrder S; S.init(T, 768, G, bx);
          KP p = kparams();
          pg8::EpiQ E{QM, (const float*)(ws + OFF_LSE), p->pos, p->g_q_mla + l * 96, SC_MLA};
          pg8::gemm_phase<pg8::EpiQ, pg8::StaticOrder, ALIGN_SMALLK, true>(lds, g, S, E); }
        { pg8::Gemm g{CLAT + 512, (const bf16*)(ws + WS_WUKV), 1024, 256, 256, wv}; pg8::StaticOrder S; S.init(T, 1024, G, bx);
          KP p = kparams();
          pg8::EpiKV E{KVM, (const float*)(ws + OFF_LSE), p->g_k_mla + l * 96};
          pg8::gemm_phase<pg8::EpiKV, pg8::StaticOrder, ALIGN_SMALLK, true>(lds, g, S, E); }
        xcd_barrier(xbar);
        phase_attn_mla(kparams(), l, lds, wv);
        if (conv_group() == 4) { phase_convert(kparams(), l, lds, wv, true); __syncthreads(); }
        phase_attn_win(kparams(), l, lds, wv);
        if (conv_group() == 5) { phase_convert(kparams(), l, lds, wv, true); }
        xcd_barrier(xbar);
        phase_dil_combine(kparams(), wv);
        xcd_barrier(xbar);
        { unsigned char* G8 = ws + WS_KVM; bf16* MERGED = QKV + 1024;
          pg8::GemmM g{XN, Win_t + (size_t)4096 * 1024, CLAT, CLAT + 512, QKV + 2304, (const bf16*)(ws + WS_WBM), (const bf16*)(ws + WS_WBD), (const bf16*)(ws + WS_WBW), 1024, 1024, 3072, 512, 256, 512, wv};
          pg8::MultiOrder<6> S; S.S.init(T, 1024, G, bx); pg8::EpiGateBranch E{G8, MERGED, 3072};
          pg8::gemm_phase_multi<pg8::EpiGateBranch, pg8::MultiOrder<6>, true, true>(lds, g, S, E); }
        xcd_barrier(xbar);
        { pg8::Gemm g{QKV + 1024, (const bf16*)(ws + WS_WOUT), 3072, 1024, 1024, wv}; pg8::StaticOrder S; S.init(T, 1024, G, bx);
          pg8::EpiResidual<l == 0> E{kparams()->x, (const bf16*)kparams()->out, CLAT, modall + (size_t)l * NB * 6144 + 2048};
          pg8::gemm_phase<pg8::EpiResidual<l == 0>, pg8::StaticOrder, true, true>(lds, g, S, E); }
        xcd_barrier(xbar);
        phase_norm2_route(kparams(), l, lds, wv);
        xcd_barrier(xbar);
        phase_dispatch(kparams(), lds, wv);
        xcd_barrier(xbar);
        { pg8::Gemm g{XN, (const bf16*)(ws + WS_W13), 1024, 1024, 1024, wv}; MoeOrder<3> S{(const LAS int*)(lds + MISC_OFF), G, (G % 8 == 0) ? (bx % 8) * (G / 8) + bx / 8 : bx};
          pg8::EpiSwiGLU E{KVM};
          pg8::gemm_phase_gather<pg8::EpiSwiGLU, MoeOrder<3>, true, true>(lds, g, (const int*)(ws + OFF_LSE), S, E); }
        xcd_barrier(xbar);
        { pg8::Gemm g{KVM, (const bf16*)(ws + WS_W2), 384, 384, 384, wv}; MoeOrder<4> S{(const LAS int*)(lds + MISC_OFF), G, (G % 8 == 0) ? (bx % 8) * (G / 8) + bx / 8 : bx};
          pg8::EpiScatterY E{QKV, (const int*)(ws + OFF_LSE)};
          pg8::gemm_phase<pg8::EpiScatterY, MoeOrder<4>, true, true>(lds, g, S, E); }
        xcd_barrier(xbar);
        phase_combine(kparams(), l, l == 0, wv);
        if (l == 0) phase_convert(kparams(), 1, lds, wv, false);
        xcd_barrier(xbar);
    }
}

__global__ void __launch_bounds__(NT, 2) mega_fwd(Params p_unused) {
    extern __shared__ __attribute__((aligned(16))) unsigned char lds_raw[];
    LAS unsigned char* lds = (LAS unsigned char*)lds_raw;
    cg::grid_group grid = cg::this_grid();
    const int wv = __builtin_amdgcn_readfirstlane(threadIdx.x >> 6);
    { volatile LAS unsigned* st = (volatile LAS unsigned*)(lds + MISC_OFF + 12288); const int t0_ = otid(wv); if (t0_ < 4) st[t0_] = 0u; }
    __syncthreads();
    const XcdBarrier xbar = xcd_barrier_post((unsigned*)kparams()->ws, (volatile LAS unsigned*)(lds + MISC_OFF + 12288), wv);

    phase_mod(kparams(), lds, wv);
    if ((int)gridDim.x >= 224) { if ((int)blockIdx.x >= 192) phase_convert(kparams(), 0, lds, wv, false, ((int)blockIdx.x - 192) * NW + wv, ((int)gridDim.x - 192) * NW); }
    else phase_convert(kparams(), 0, lds, wv, false);
    if (gridDim.x == 0x7fffff) grid.sync();
    xcd_barrier(xbar);
    phase_norm1(kparams(), 0, kparams()->x, wv);
    xcd_barrier(xbar);
    layer_body<0>(lds, xbar, wv);
    layer_body<1>(lds, xbar, wv);
}

extern "C" void kernel_launch(void* const* d_in, const int* in_sizes, int n_in, void* d_out, int out_size, void* d_ws, size_t ws_size, hipStream_t stream) {
    static int grid = 0;
    if (grid == 0) {
        int dev = 0, cus = 0, per_cu = 0;
        (void)hipGetDevice(&dev);
        (void)hipDeviceGetAttribute(&cus, hipDeviceAttributeMultiprocessorCount, dev);
        (void)hipFuncSetAttribute((const void*)mega_fwd, hipFuncAttributeMaxDynamicSharedMemorySize, LDS_BYTES);
        (void)hipOccupancyMaxActiveBlocksPerMultiprocessor(&per_cu, (const void*)mega_fwd, NT, LDS_BYTES);
        grid = cus;
        if (per_cu < 1 || n_in != 30 || out_size != T * D || ws_size < WS_END) { fprintf(stderr, "kernel_launch: per_cu %d n_in %d out %d ws %zu (need %zu)\n", per_cu, n_in, out_size, ws_size, (size_t)WS_END); }
        if (ws_size < WS_END) grid = -1;
    }
    if (grid < 0) return;
    Params hp{};
    const float** fp = (const float**)&hp;
    for (int i = 0; i < 30; ++i) fp[i] = (const float*)d_in[i];
    hp.out = (float*)d_out; hp.ws = (unsigned char*)d_ws;
    (void)hipMemsetAsync(d_ws, 0, 16384, stream);
    void* args[] = {&hp};
    hipError_t e = hipLaunchCooperativeKernel((const void*)mega_fwd, dim3(grid), dim3(NT), args, LDS_BYTES, stream);
    if (e != hipSuccess) fprintf(stderr, "cooperative launch failed: %s (grid %d)\n", hipGetErrorString(e), grid);
}
```

```cpp
#include <hip/hip_runtime.h>
#include <hip/hip_cooperative_groups.h>
#include <cstdio>
#include <cstdint>
namespace cg = cooperative_groups;

namespace pg8 {
#define PG8_LAS __attribute__((address_space(3)))
typedef unsigned short bf16_t;
typedef short bf16x8 __attribute__((ext_vector_type(8)));
typedef float f32x4 __attribute__((ext_vector_type(4)));
typedef unsigned u32x4 __attribute__((ext_vector_type(4)));
typedef unsigned u32x2 __attribute__((ext_vector_type(2)));
constexpr int BM = 256, BK = 64, HALF = 128, HTB = HALF * BK * 2  , STAGE_BYTES = 8 * HTB, NXCD = 8, WGM = 8;

__host__ __device__ __forceinline__ int lds_byte(int r, int c) { const int st = (r >> 4) * 2 + (c >> 5), rr = r & 15, cc = c & 31, ob = rr * 64 + cc * 2; return st * 1024 + (ob ^ (((ob >> 9) & 1) << 5)); }
__host__ __device__ __forceinline__ void stage_rc(int b, int& R, int& C) { const int st = b / 1024, sb = b % 1024, swz = sb ^ (((sb >> 9) & 1) << 5); R = (st >> 1) * 16 + swz / 64; C = (st & 1) * 32 + (swz % 64) / 2; }
__host__ __device__ __forceinline__ int perm32(int rho) { const int n = rho >> 4, i = rho & 15; return 8 * (i >> 2) + 4 * n + (i & 3); }

struct Unit { int pm, pn, kind; };
struct Gemm { const bf16_t* A; const bf16_t* Bt; int lda, ldb, K; int wv; };

template <class T_> __device__ __forceinline__ T_ sel3(int k, T_ a, T_ b, T_ c) { return k == 0 ? a : (k == 1 ? b : c); }
struct GemmM { const bf16_t* gA; const bf16_t* gB; const bf16_t *A0, *A1, *A2; const bf16_t *B0, *B1, *B2; int lda0, lda1, lda2, K0, K1, K2; int wv;
    __device__ __forceinline__ int lda(int k) const { return (k & 1) ? sel3(k >> 1, lda0, lda1, lda2) : 1024; }
    __device__ __forceinline__ int ldb(int k) const { return (k & 1) ? sel3(k >> 1, K0, K1, K2) : 1024; }
    __device__ __forceinline__ int K(int k) const { return (k & 1) ? sel3(k >> 1, K0, K1, K2) : 1024; }
    __device__ __forceinline__ const bf16_t* Ap(int k) const { return (k & 1) ? sel3(k >> 1, A0, A1, A2) : gA; }
    __device__ __forceinline__ const bf16_t* Bp(int k) const { return (k & 1) ? sel3(k >> 1, B0, B1, B2) : gB + (size_t)(k >> 1) * 1024 * 1024; }
};
struct StaticOrder {
    int nM, nN, nwg, G, c;
    __device__ void init(int M, int N, int G_, int c_) { nM = M / BM; nN = N / BM; nwg = nM * nN; G = G_; c = c_; }
    __device__ bool next(int i, Unit& u) const {
        const long L = (long)i * G + c; if (L >= nwg) return false;
        int wgid = (int)L; { const int q = nwg / NXCD, r = nwg % NXCD, xcd = wgid % NXCD, off = wgid / NXCD; wgid = (xcd < r ? xcd * (q + 1) : r * (q + 1) + (xcd - r) * q) + off; }
        const int nig = WGM * nN, gid = wgid / nig, fm = gid * WGM, gsz = (nM - fm) < WGM ? (nM - fm) : WGM;
        u.pm = fm + ((wgid % nig) % gsz); u.pn = (wgid % nig) / gsz; return true;
    }
    __device__ __forceinline__ void a_ready(const Unit&) const {}
    __device__ __forceinline__ void done(const Unit&) const {}
};

typedef float f32x2_t __attribute__((ext_vector_type(2))); typedef __bf16 bf16x2_t __attribute__((ext_vector_type(2)));
__device__ __forceinline__ unsigned cvt_pk_bf16(float lo, float hi) { f32x2_t v = {lo, hi}; bf16x2_t b = __builtin_convertvector(v, bf16x2_t); return __builtin_bit_cast(unsigned, b); }

__device__ __forceinline__ int hw_lane() { int l; asm volatile("v_mbcnt_lo_u32_b32 %0, -1, 0\n\tv_mbcnt_hi_u32_b32 %0, -1, %0" : "=v"(l)); return l; }
__device__ __forceinline__ float fast_sigmoid(float x) { return __builtin_amdgcn_rcpf(1.0f + __builtin_amdgcn_exp2f(-1.4426950408889634f * x)); }
__device__ __forceinline__ float bf_lo(unsigned w) { return __uint_as_float(w << 16); }
__device__ __forceinline__ float bf_hi(unsigned w) { return __uint_as_float(w & 0xffff0000u); }

template <int ACT> struct EpiStore {
    static constexpr bool PERM = true, AFTER_DRAIN = false, PREFETCH = false;
    bf16_t* O; int ldc; bf16_t* O2; int ldc2; int split_pn; int pn_mod;
    __device__ __forceinline__ void operator()(const f32x4 (&acc)[2][2][4][2], const Unit& u, int wr, int wc, int, int) const {
        const int ln_ = hw_lane(), fr = ln_ & 15, fq = ln_ >> 4;
        const int row0 = u.pm * BM + wr * 64 + fr;
        bf16_t* base = O; int ld = ldc; int pn = pn_mod ? (u.pn % pn_mod) : u.pn;
        if (pn >= split_pn) { base = O2; ld = ldc2; pn -= split_pn; }
        const int col0 = pn * BM + wc * 32 + 8 * fq;
#pragma unroll
        for (int ai = 0; ai < 2; ++ai)
#pragma unroll
            for (int m = 0; m < 4; ++m) { bf16_t* rowp = base + (size_t)(row0 + ai * HALF + m * 16) * ld + col0;
#pragma unroll
                for (int bj = 0; bj < 2; ++bj) { f32x4 v0 = acc[ai][bj][m][0], v1 = acc[ai][bj][m][1];
                    if (ACT == 1) {
#pragma unroll
                        for (int e = 0; e < 4; ++e) { v0[e] = fast_sigmoid(v0[e]); v1[e] = fast_sigmoid(v1[e]); } }
                    u32x4 w; w.x = cvt_pk_bf16(v0[0], v0[1]); w.y = cvt_pk_bf16(v0[2], v0[3]); w.z = cvt_pk_bf16(v1[0], v1[1]); w.w = cvt_pk_bf16(v1[2], v1[3]);
                    *(u32x4*)(rowp + bj * HALF) = w; } }
    }
};
template <bool XF32> struct EpiResidual {
    static constexpr bool PERM = true, AFTER_DRAIN = false, PREFETCH = false;
    const float* xf; const bf16_t* xb; bf16_t* out; const float* gate;
    __device__ __forceinline__ void operator()(const f32x4 (&acc)[2][2][4][2], const Unit& u, int wr, int wc, int, int) const {
        const int ln_ = hw_lane(), fr = ln_ & 15, fq = ln_ >> 4;
        const int row0 = u.pm * BM + wr * 64 + fr, col0 = u.pn * BM + wc * 32 + 8 * fq;
        const float* gp = gate + (size_t)((u.pm * BM) >> 11) * 6144 + col0;
        f32x4 gv[2][2];
#pragma unroll
        for (int bj = 0; bj < 2; ++bj)
#pragma unroll
            for (int n = 0; n < 2; ++n) gv[bj][n] = *(const f32x4*)(gp + bj * HALF + n * 4);
#pragma unroll
        for (int ai = 0; ai < 2; ++ai) {
            f32x4 xv[4][2][2];
#pragma unroll
            for (int m = 0; m < 4; ++m) { const size_t off = (size_t)(row0 + ai * HALF + m * 16) * 1024 + col0;
#pragma unroll
                for (int bj = 0; bj < 2; ++bj) {
                    if (XF32) { xv[m][bj][0] = *(const f32x4*)(xf + off + bj * HALF); xv[m][bj][1] = *(const f32x4*)(xf + off + bj * HALF + 4); }
                    else { const u32x4 w = *(const u32x4*)(xb + off + bj * HALF); xv[m][bj][0] = (f32x4){bf_lo(w.x), bf_hi(w.x), bf_lo(w.y), bf_hi(w.y)}; xv[m][bj][1] = (f32x4){bf_lo(w.z), bf_hi(w.z), bf_lo(w.w), bf_hi(w.w)}; } } }
#pragma unroll
            for (int m = 0; m < 4; ++m) { const size_t off = (size_t)(row0 + ai * HALF + m * 16) * 1024 + col0;
#pragma unroll
                for (int bj = 0; bj < 2; ++bj) { const f32x4 v0 = xv[m][bj][0] + gv[bj][0] * acc[ai][bj][m][0], v1 = xv[m][bj][1] + gv[bj][1] * acc[ai][bj][m][1];
                    u32x4 w; w.x = cvt_pk_bf16(v0[0], v0[1]); w.y = cvt_pk_bf16(v0[2], v0[3]); w.z = cvt_pk_bf16(v1[0], v1[1]); w.w = cvt_pk_bf16(v1[2], v1[3]);
                    *(u32x4*)(out + off + bj * HALF) = w; } } }
    }
};
struct EpiSwiGLU {
    static constexpr bool PERM = true, AFTER_DRAIN = false, PREFETCH = false;
    bf16_t* O;
    __device__ __forceinline__ void operator()(const f32x4 (&acc)[2][2][4][2], const Unit& u, int wr, int wc, int, int) const {
        const int ln_ = hw_lane(), fr = ln_ & 15, fq = ln_ >> 4;
        const int row0 = u.pm * BM + wr * 64 + fr, col0 = (u.pn % 3) * HALF + wc * 32 + 8 * fq;
#pragma unroll
        for (int ai = 0; ai < 2; ++ai)
#pragma unroll
            for (int m = 0; m < 4; ++m) { float o[8];
#pragma unroll
                for (int n = 0; n < 2; ++n)
#pragma unroll
                    for (int e = 0; e < 4; ++e) { const float a = acc[ai][0][m][n][e], b = acc[ai][1][m][n][e]; o[n * 4 + e] = a * fast_sigmoid(a) * b; }
                u32x4 w; w.x = cvt_pk_bf16(o[0], o[1]); w.y = cvt_pk_bf16(o[2], o[3]); w.z = cvt_pk_bf16(o[4], o[5]); w.w = cvt_pk_bf16(o[6], o[7]);
                *(u32x4*)(O + (size_t)(row0 + ai * HALF + m * 16) * 384 + col0) = w; }
    }
};

struct EpiGateBranch {
    static constexpr bool PERM = true, AFTER_DRAIN = false, PREFETCH = false;
    unsigned char* G; bf16_t* Mo; int ldm;
    __device__ __forceinline__ void operator()(const f32x4 (&acc)[2][2][4][2], const Unit& u, int wr, int wc, int, int) const {
        const int ln_ = hw_lane(), fr = ln_ & 15, fq = ln_ >> 4;
        const int row0 = u.pm * BM + wr * 64 + fr, col0 = u.pn * BM + wc * 32 + 8 * fq;
        if ((u.kind & 1) == 0) {
#pragma unroll
            for (int ai = 0; ai < 2; ++ai)
#pragma unroll
                for (int m = 0; m < 4; ++m) { unsigned char* rowp = G + (size_t)(row0 + ai * HALF + m * 16) * 1024 + col0;
#pragma unroll
                    for (int bj = 0; bj < 2; ++bj) { unsigned q[8];
#pragma unroll
                        for (int e = 0; e < 4; ++e) { q[e] = (unsigned)(fast_sigmoid(acc[ai][bj][m][0][e]) * 255.0f + 0.5f); q[4 + e] = (unsigned)(fast_sigmoid(acc[ai][bj][m][1][e]) * 255.0f + 0.5f); }
                        u32x2 w; w.x = q[0] | (q[1] << 8) | (q[2] << 16) | (q[3] << 24); w.y = q[4] | (q[5] << 8) | (q[6] << 16) | (q[7] << 24);
                        *(u32x2*)(rowp + bj * HALF) = w; } }
        } else {
            const bool accum = u.kind != 1;
#pragma unroll
            for (int ai = 0; ai < 2; ++ai) {
                u32x2 gq[4][2]; u32x4 pm[4][2];
#pragma unroll
                for (int m = 0; m < 4; ++m) { const size_t r = (size_t)(row0 + ai * HALF + m * 16);
#pragma unroll
                    for (int bj = 0; bj < 2; ++bj) { gq[m][bj] = *(const u32x2*)(G + r * 1024 + col0 + bj * HALF);
                        if (accum) pm[m][bj] = *(const u32x4*)(Mo + r * ldm + col0 + bj * HALF); else pm[m][bj] = (u32x4){0u, 0u, 0u, 0u}; } }
#pragma unroll
                for (int m = 0; m < 4; ++m) { const size_t r = (size_t)(row0 + ai * HALF + m * 16);
#pragma unroll
                    for (int bj = 0; bj < 2; ++bj) { const f32x4 v0 = acc[ai][bj][m][0], v1 = acc[ai][bj][m][1]; const u32x2 g = gq[m][bj]; const u32x4 p = pm[m][bj];
                        constexpr float q_ = 1.0f / 255.0f; float o[8];
                        o[0] = v0[0] * (float)(g.x & 255u) * q_ + bf_lo(p.x); o[1] = v0[1] * (float)((g.x >> 8) & 255u) * q_ + bf_hi(p.x); o[2] = v0[2] * (float)((g.x >> 16) & 255u) * q_ + bf_lo(p.y); o[3] = v0[3] * (float)(g.x >> 24) * q_ + bf_hi(p.y);
                        o[4] = v1[0] * (float)(g.y & 255u) * q_ + bf_lo(p.z); o[5] = v1[1] * (float)((g.y >> 8) & 255u) * q_ + bf_hi(p.z); o[6] = v1[2] * (float)((g.y >> 16) & 255u) * q_ + bf_lo(p.w); o[7] = v1[3] * (float)(g.y >> 24) * q_ + bf_hi(p.w);
                        u32x4 w; w.x = cvt_pk_bf16(o[0], o[1]); w.y = cvt_pk_bf16(o[2], o[3]); w.z = cvt_pk_bf16(o[4], o[5]); w.w = cvt_pk_bf16(o[6], o[7]);
                        *(u32x4*)(Mo + r * ldm + col0 + bj * HALF) = w; } } }
        }
    }
};
template <int NK> struct MultiOrder {
    StaticOrder S;
    __device__ __forceinline__ bool next(int i, Unit& u) const { const int ti = i / NK; if (!S.next(ti, u)) return false; u.kind = i - ti * NK; return true; }
    __device__ __forceinline__ void a_ready(const Unit&) const {}
    __device__ __forceinline__ void done(const Unit&) const {}
};
__device__ __forceinline__ float shfl_x(float v, int m, int ln) { return __builtin_bit_cast(float, __builtin_amdgcn_ds_bpermute((ln ^ m) << 2, __builtin_bit_cast(int, v))); }
__device__ __forceinline__ void fast_sincos(float ang, float& sn, float& cs) { float rv = ang * 0.15915494309189535f; rv = rv - floorf(rv); sn = __builtin_amdgcn_sinf(rv); cs = __builtin_amdgcn_cosf(rv); }
__device__ __forceinline__ float inv_freq16(int i) { return __builtin_amdgcn_exp2f(-(float)i * (13.287712379549449f / 16.0f)); }
struct HeadRow { float t[2][2][4]; };
struct EpiProj {
    static constexpr bool PERM = true, AFTER_DRAIN = false, PREFETCH = false;
    bf16_t* QKV; bf16_t* CLAT; float* SSQ; const int* pos; const float *g_q_dil, *g_k_dil, *g_q_win, *g_k_win, *g_kr; float qscale;
    __device__ __forceinline__ void operator()(const f32x4 (&acc)[2][2][4][2], const Unit& u, int wr, int wc, int, int) const {
        const int ln = hw_lane(), fr = ln & 15, fq = ln >> 4;
        const int row0 = u.pm * BM + wr * 64 + fr;
        if (u.pn < 12) {
            const int hq = 4 * u.pn + wc;
            const float* g = nullptr; float post = 1.0f;
            if (hq < 12) { g = g_q_dil; post = qscale; } else if (hq < 24) g = g_k_dil; else if (hq >= 36 && hq < 44) { g = g_q_win; post = qscale; } else if (hq >= 44 && hq < 46) g = g_k_win;
            f32x4 gv[2][2];
#pragma unroll
            for (int bj = 0; bj < 2; ++bj)
#pragma unroll
                for (int n = 0; n < 2; ++n) gv[bj][n] = g ? *(const f32x4*)(g + 32 * bj + 8 * fq + 4 * n) : (f32x4){1.f, 1.f, 1.f, 1.f};
#pragma unroll
            for (int ai = 0; ai < 2; ++ai)
#pragma unroll
                for (int m = 0; m < 4; ++m) { float r = 1.0f;
                    if (g) { float ss = 0.f;
#pragma unroll
                        for (int bj = 0; bj < 2; ++bj)
#pragma unroll
                            for (int n = 0; n < 2; ++n) { const f32x4 v = acc[ai][bj][m][n]; ss += (v[0] * v[0] + v[1] * v[1]) + (v[2] * v[2] + v[3] * v[3]); }
                        ss += shfl_x(ss, 16, ln); ss += shfl_x(ss, 32, ln);
                        r = __builtin_amdgcn_rsqf(ss * (1.0f / 64) + 1e-6f) * post; }
                    bf16_t* rowp = QKV + (size_t)(row0 + ai * HALF + m * 16) * 3072 + hq * 64 + 8 * fq;
#pragma unroll
                    for (int bj = 0; bj < 2; ++bj) { const f32x4 v0 = acc[ai][bj][m][0] * gv[bj][0] * r, v1 = acc[ai][bj][m][1] * gv[bj][1] * r;
                        u32x4 w; w.x = cvt_pk_bf16(v0[0], v0[1]); w.y = cvt_pk_bf16(v0[2], v0[3]); w.z = cvt_pk_bf16(v1[0], v1[1]); w.w = cvt_pk_bf16(v1[2], v1[3]);
                        *(u32x4*)(rowp + 32 * bj) = w; } }
        } else if (u.pn < 15) {
            const int ct = u.pn - 12, col0 = ct * BM + wc * 32 + 8 * fq;
#pragma unroll
            for (int ai = 0; ai < 2; ++ai)
#pragma unroll
                for (int m = 0; m < 4; ++m) { const int row = row0 + ai * HALF + m * 16; float ss = 0.f;
#pragma unroll
                    for (int bj = 0; bj < 2; ++bj) { const f32x4 v0 = acc[ai][bj][m][0], v1 = acc[ai][bj][m][1];
                        ss += (v0[0] * v0[0] + v0[1] * v0[1]) + (v0[2] * v0[2] + v0[3] * v0[3]) + (v1[0] * v1[0] + v1[1] * v1[1]) + (v1[2] * v1[2] + v1[3] * v1[3]);
                        u32x4 w; w.x = cvt_pk_bf16(v0[0], v0[1]); w.y = cvt_pk_bf16(v0[2], v0[3]); w.z = cvt_pk_bf16(v1[0], v1[1]); w.w = cvt_pk_bf16(v1[2], v1[3]);
                        *(u32x4*)(CLAT + (size_t)row * 1024 + col0 + bj * HALF) = w; }
                    ss += shfl_x(ss, 16, ln); ss += shfl_x(ss, 32, ln);
                    if (fq == 0) SSQ[(size_t)row * 12 + ct * 4 + wc] = ss; }
        } else if (wc == 0) {
            const float i0 = inv_freq16(8 * (fq & 1) + 0), i1 = inv_freq16(8 * (fq & 1) + 1), i2 = inv_freq16(8 * (fq & 1) + 2), i3 = inv_freq16(8 * (fq & 1) + 3);
            const float i4 = inv_freq16(8 * (fq & 1) + 4), i5 = inv_freq16(8 * (fq & 1) + 5), i6 = inv_freq16(8 * (fq & 1) + 6), i7 = inv_freq16(8 * (fq & 1) + 7);
            const float ifr[8] = {i0, i1, i2, i3, i4, i5, i6, i7};
            const f32x4 g0 = *(const f32x4*)(g_kr + 8 * fq), g1 = *(const f32x4*)(g_kr + 8 * fq + 4);
            float psv[2][4];
#pragma unroll
            for (int ai = 0; ai < 2; ++ai)
#pragma unroll
                for (int m = 0; m < 4; ++m) psv[ai][m] = (float)pos[row0 + ai * HALF + m * 16];
#pragma unroll
            for (int ai = 0; ai < 2; ++ai)
#pragma unroll
                for (int m = 0; m < 4; ++m) { const int row = row0 + ai * HALF + m * 16; const f32x4 v0 = acc[ai][0][m][0], v1 = acc[ai][0][m][1];
                    float ss = (v0[0] * v0[0] + v0[1] * v0[1]) + (v0[2] * v0[2] + v0[3] * v0[3]) + (v1[0] * v1[0] + v1[1] * v1[1]) + (v1[2] * v1[2] + v1[3] * v1[3]);
                    ss += shfl_x(ss, 16, ln); ss += shfl_x(ss, 32, ln);
                    const float r = __builtin_amdgcn_rsqf(ss * (1.0f / 32) + 1e-6f); const float ps = psv[ai][m];
                    const f32x4 a0 = v0 * g0 * r, a1 = v1 * g1 * r; float o[8];
#pragma unroll
                    for (int e = 0; e < 8; ++e) { const float vn = e < 4 ? a0[e] : a1[e - 4]; const float pr = shfl_x(vn, 32, ln); float sn, cs; fast_sincos(ps * ifr[e], sn, cs);
                        o[e] = (fq & 2) ? (pr * sn + vn * cs) : (vn * cs - pr * sn); }
                    u32x4 w; w.x = cvt_pk_bf16(o[0], o[1]); w.y = cvt_pk_bf16(o[2], o[3]); w.z = cvt_pk_bf16(o[4], o[5]); w.w = cvt_pk_bf16(o[6], o[7]);
                    *(u32x4*)(CLAT + (size_t)row * 1024 + 768 + 8 * fq) = w; }
        }
    }
};
struct EpiQ {
    static constexpr bool PERM = true, AFTER_DRAIN = false, PREFETCH = false;
    bf16_t* QM; const float* SSQ; const int* pos; const float* g_q; float qscale;
    __device__ __forceinline__ void operator()(const f32x4 (&acc)[2][2][4][2], const Unit& u, int wr, int wc, int, int) const {
        const int ln = hw_lane(), fr = ln & 15, fq = ln >> 4;
        const int row0 = u.pm * BM + wr * 64 + fr;
        float rqv[2][4];
#pragma unroll
        for (int ai = 0; ai < 2; ++ai)
#pragma unroll
            for (int m = 0; m < 4; ++m) { const int row = row0 + ai * HALF + m * 16; const f32x4 s0 = *(const f32x4*)(SSQ + (size_t)row * 12), s1 = *(const f32x4*)(SSQ + (size_t)row * 12 + 4);
                rqv[ai][m] = __builtin_amdgcn_rsqf(((s0[0] + s0[1]) + (s0[2] + s0[3]) + (s1[0] + s1[1]) + (s1[2] + s1[3])) * (1.0f / 512) + 1e-6f); }
        if (u.pn < 2) {
            const int h = 4 * u.pn + wc; f32x4 gv[2][2];
#pragma unroll
            for (int bj = 0; bj < 2; ++bj)
#pragma unroll
                for (int n = 0; n < 2; ++n) gv[bj][n] = *(const f32x4*)(g_q + 32 * bj + 8 * fq + 4 * n);
#pragma unroll
            for (int ai = 0; ai < 2; ++ai)
#pragma unroll
                for (int m = 0; m < 4; ++m) { const int row = row0 + ai * HALF + m * 16;
                    const float rq = rqv[ai][m];
                    float ss = 0.f;
#pragma unroll
                    for (int bj = 0; bj < 2; ++bj)
#pragma unroll
                        for (int n = 0; n < 2; ++n) { const f32x4 v = acc[ai][bj][m][n] * rq; ss += (v[0] * v[0] + v[1] * v[1]) + (v[2] * v[2] + v[3] * v[3]); }
                    ss += shfl_x(ss, 16, ln); ss += shfl_x(ss, 32, ln);
                    const float r = __builtin_amdgcn_rsqf(ss * (1.0f / 64) + 1e-6f) * rq * qscale;
                    bf16_t* rowp = QM + (size_t)row * 768 + h * 96 + 8 * fq;
#pragma unroll
                    for (int bj = 0; bj < 2; ++bj) { const f32x4 v0 = acc[ai][bj][m][0] * gv[bj][0] * r, v1 = acc[ai][bj][m][1] * gv[bj][1] * r;
                        u32x4 w; w.x = cvt_pk_bf16(v0[0], v0[1]); w.y = cvt_pk_bf16(v0[2], v0[3]); w.z = cvt_pk_bf16(v1[0], v1[1]); w.w = cvt_pk_bf16(v1[2], v1[3]);
                        *(u32x4*)(rowp + 32 * bj) = w; } }
        } else {
            float ifr[8];
#pragma unroll
            for (int e = 0; e < 8; ++e) ifr[e] = inv_freq16(8 * (fq & 1) + e);
            const f32x4 g0 = *(const f32x4*)(g_q + 64 + 8 * fq), g1 = *(const f32x4*)(g_q + 64 + 8 * fq + 4);
            float psv[2][4];
#pragma unroll
            for (int ai = 0; ai < 2; ++ai)
#pragma unroll
                for (int m = 0; m < 4; ++m) psv[ai][m] = (float)pos[row0 + ai * HALF + m * 16];
#pragma unroll
            for (int ai = 0; ai < 2; ++ai)
#pragma unroll
                for (int m = 0; m < 4; ++m) { const int row = row0 + ai * HALF + m * 16;
                    const float rq = rqv[ai][m];
                    const float ps = psv[ai][m]; float sn[8], cs[8];
#pragma unroll
                    for (int e = 0; e < 8; ++e) fast_sincos(ps * ifr[e], sn[e], cs[e]);
#pragma unroll
                    for (int bj = 0; bj < 2; ++bj) { const int h = 2 * wc + bj; const f32x4 v0 = acc[ai][bj][m][0] * rq, v1 = acc[ai][bj][m][1] * rq;
                        float ss = (v0[0] * v0[0] + v0[1] * v0[1]) + (v0[2] * v0[2] + v0[3] * v0[3]) + (v1[0] * v1[0] + v1[1] * v1[1]) + (v1[2] * v1[2] + v1[3] * v1[3]);
                        ss += shfl_x(ss, 16, ln); ss += shfl_x(ss, 32, ln);
                        const float r = __builtin_amdgcn_rsqf(ss * (1.0f / 32) + 1e-6f); const f32x4 a0 = v0 * g0 * r, a1 = v1 * g1 * r; float o[8];
#pragma unroll
                        for (int e = 0; e < 8; ++e) { const float vn = e < 4 ? a0[e] : a1[e - 4]; const float pr = shfl_x(vn, 32, ln);
                            o[e] = ((fq & 2) ? (pr * sn[e] + vn * cs[e]) : (vn * cs[e] - pr * sn[e])) * qscale; }
                        u32x4 w; w.x = cvt_pk_bf16(o[0], o[1]); w.y = cvt_pk_bf16(o[2], o[3]); w.z = cvt_pk_bf16(o[4], o[5]); w.w = cvt_pk_bf16(o[6], o[7]);
                        *(u32x4*)(QM + (size_t)row * 768 + h * 96 + 64 + 8 * fq) = w; } }
        }
    }
};
struct EpiKV {
    static constexpr bool PERM = true, AFTER_DRAIN = false, PREFETCH = false;
    bf16_t* KVM; const float* SSQ; const float* g_k;
    __device__ __forceinline__ void operator()(const f32x4 (&acc)[2][2][4][2], const Unit& u, int wr, int wc, int, int) const {
        const int ln = hw_lane(), fr = ln & 15, fq = ln >> 4;
        const int row0 = u.pm * BM + wr * 64 + fr; const int h16 = 4 * u.pn + wc; const bool isk = (h16 & 1) == 0;
        f32x4 gv[2][2];
#pragma unroll
        for (int bj = 0; bj < 2; ++bj)
#pragma unroll
            for (int n = 0; n < 2; ++n) gv[bj][n] = isk ? *(const f32x4*)(g_k + 32 * bj + 8 * fq + 4 * n) : (f32x4){1.f, 1.f, 1.f, 1.f};
        float rkv[2][4];
#pragma unroll
        for (int ai = 0; ai < 2; ++ai)
#pragma unroll
            for (int m = 0; m < 4; ++m) { const int row = row0 + ai * HALF + m * 16; const f32x4 s2 = *(const f32x4*)(SSQ + (size_t)row * 12 + 8);
                rkv[ai][m] = __builtin_amdgcn_rsqf(((s2[0] + s2[1]) + (s2[2] + s2[3])) * (1.0f / 256) + 1e-6f); }
#pragma unroll
        for (int ai = 0; ai < 2; ++ai)
#pragma unroll
            for (int m = 0; m < 4; ++m) { const int row = row0 + ai * HALF + m * 16;
                const float rk = rkv[ai][m];
                float r = rk;
                if (isk) { float ss = 0.f;
#pragma unroll
                    for (int bj = 0; bj < 2; ++bj)
#pragma unroll
                        for (int n = 0; n < 2; ++n) { const f32x4 v = acc[ai][bj][m][n] * rk; ss += (v[0] * v[0] + v[1] * v[1]) + (v[2] * v[2] + v[3] * v[3]); }
                    ss += shfl_x(ss, 16, ln); ss += shfl_x(ss, 32, ln);
                    r = __builtin_amdgcn_rsqf(ss * (1.0f / 64) + 1e-6f) * rk; }
                bf16_t* rowp = KVM + (size_t)row * 1024 + h16 * 64 + 8 * fq;
#pragma unroll
                for (int bj = 0; bj < 2; ++bj) { const f32x4 v0 = acc[ai][bj][m][0] * gv[bj][0] * r, v1 = acc[ai][bj][m][1] * gv[bj][1] * r;
                    u32x4 w; w.x = cvt_pk_bf16(v0[0], v0[1]); w.y = cvt_pk_bf16(v0[2], v0[3]); w.z = cvt_pk_bf16(v1[0], v1[1]); w.w = cvt_pk_bf16(v1[2], v1[3]);
                    *(u32x4*)(rowp + 32 * bj) = w; }
                }
    }
};


struct EpiScatterY {
    static constexpr bool PERM = true, AFTER_DRAIN = false, PREFETCH = false;
    bf16_t* Y; const int* slot;
    __device__ __forceinline__ void operator()(const f32x4 (&acc)[2][2][4][2], const Unit& u, int wr, int wc, int, int) const {
        const int ln_ = hw_lane(), fr = ln_ & 15, fq = ln_ >> 4;
        const int row0 = u.pm * BM + wr * 64 + fr, col0 = (u.pn & 3) * BM + wc * 32 + 8 * fq;
        int sl[2][4];
#pragma unroll
        for (int ai = 0; ai < 2; ++ai)
#pragma unroll
            for (int m = 0; m < 4; ++m) sl[ai][m] = slot[row0 + ai * HALF + m * 16];
#pragma unroll
        for (int ai = 0; ai < 2; ++ai)
#pragma unroll
            for (int m = 0; m < 4; ++m) { if (sl[ai][m] >= 0) { bf16_t* rowp = Y + (size_t)sl[ai][m] * 1024 + col0;
#pragma unroll
                    for (int bj = 0; bj < 2; ++bj) { const f32x4 v0 = acc[ai][bj][m][0], v1 = acc[ai][bj][m][1];
                        u32x4 w; w.x = cvt_pk_bf16(v0[0], v0[1]); w.y = cvt_pk_bf16(v0[2], v0[3]); w.z = cvt_pk_bf16(v1[0], v1[1]); w.w = cvt_pk_bf16(v1[2], v1[3]);
                        *(u32x4*)(rowp + bj * HALF) = w; } } }
    }
};
template <class Epi, class Sched, bool ALIGN_EPI = false, bool SP2 = false>
__device__ __forceinline__ void gemm_phase(PG8_LAS unsigned char* lds, const Gemm g, const Sched& S, const Epi& E) {
    const int wid = g.wv, lane = hw_lane(), tid = (wid << 6) | lane,
              wr = wid >> 2, wc = wid & 3, fr = lane & 15, fq = lane >> 4;
    const int K = g.K, nt = K / BK;
    unsigned voffA[2], voffB[2];
#pragma unroll
    for (int i = 0; i < 2; ++i) { int R, C; stage_rc(tid * 16 + i * 8192, R, C); const int Rb = Epi::PERM ? ((R & ~31) + perm32(R & 31)) : R;
        voffA[i] = (unsigned)(R * g.lda + C) * 2u; voffB[i] = (unsigned)(Rb * g.ldb + C) * 2u; }
    const size_t kstep = (size_t)(BK * 2);
    const size_t hstepA = (size_t)HALF * g.lda * 2, hstepB = (size_t)HALF * g.ldb * 2;
    const size_t tstepA = 2 * hstepA, tstepB = 2 * hstepB;
    const unsigned ldsw = (unsigned)wid * 1024u;
    const int aoff = lds_byte(wr * 64 + fr, fq * 8), boff = lds_byte(wc * 32 + fr, fq * 8);
#define PG8_SA(b, h) (((b) * 2 + (h)) * HTB)
#define PG8_SB(b, h) ((4 + (b) * 2 + (h)) * HTB)
#define PG8_STAGE(bufoff, gbase, voff) do { _Pragma("unroll") for (int _i = 0; _i < 2; ++_i) \
        __builtin_amdgcn_global_load_lds((const unsigned*)((const char*)(gbase) + (voff)[_i]), (PG8_LAS unsigned*)(lds + (bufoff) + ldsw + _i * 8192), 16, 0, 0); } while (0)
#define PG8_LDA(dst, b, h) do { _Pragma("unroll") for (int m = 0; m < 4; ++m) _Pragma("unroll") for (int k = 0; k < 2; ++k) dst[m][k] = *(const PG8_LAS bf16x8*)(lds + PG8_SA(b, h) + aoff + m * 2048 + k * 1024); } while (0)
#define PG8_LDB(dst, b, h) do { _Pragma("unroll") for (int n = 0; n < 2; ++n) _Pragma("unroll") for (int k = 0; k < 2; ++k) dst[n][k] = *(const PG8_LAS bf16x8*)(lds + PG8_SB(b, h) + boff + n * 2048 + k * 1024); } while (0)
#define PG8_MMA(ai, bj, At, Bt) do { __builtin_amdgcn_s_setprio(1); _Pragma("unroll") for (int m = 0; m < 4; ++m) _Pragma("unroll") for (int n = 0; n < 2; ++n) _Pragma("unroll") for (int k = 0; k < 2; ++k) \
        acc[ai][bj][m][n] = __builtin_amdgcn_mfma_f32_16x16x32_bf16(Bt[n][k], At[m][k], acc[ai][bj][m][n], 0, 0, 0); __builtin_amdgcn_s_setprio(0); } while (0)
#define PG8_WAIT_V(n) asm volatile("s_waitcnt vmcnt(" #n ")" ::: "memory")
#define PG8_WAIT_L(n) asm volatile("s_waitcnt lgkmcnt(" #n ")" ::: "memory")
#define PG8_BAR __builtin_amdgcn_s_barrier()
#define PG8_SCHED __builtin_amdgcn_sched_barrier(0)
    Unit cur, nxt; int ui = 0;
    if (!S.next(0, cur)) return;
    f32x4 acc[2][2][4][2];
#pragma unroll
    for (int a = 0; a < 2; ++a)
#pragma unroll
        for (int b = 0; b < 2; ++b)
#pragma unroll
            for (int m = 0; m < 4; ++m)
#pragma unroll
                for (int n = 0; n < 2; ++n) acc[a][b][m][n] = (f32x4){0.f, 0.f, 0.f, 0.f};
    bf16x8 At[4][2] = {}, B0[2][2] = {}, B1[2][2] = {};
    const char* cA = (const char*)g.A + (size_t)cur.pm * tstepA; const char* cB = (const char*)g.Bt + (size_t)cur.pn * tstepB;
    S.a_ready(cur);
    if constexpr (SP2) {
        PG8_STAGE(PG8_SB(0, 0), cB, voffB); PG8_STAGE(PG8_SB(0, 1), cB + hstepB, voffB); PG8_STAGE(PG8_SA(0, 0), cA, voffA); PG8_STAGE(PG8_SA(0, 1), cA + hstepA, voffA);
        if (wr == 1) PG8_BAR;
        PG8_WAIT_V(2); PG8_BAR;
        PG8_STAGE(PG8_SB(1, 0), cB + kstep, voffB); PG8_STAGE(PG8_SA(1, 0), cA + kstep, voffA); PG8_STAGE(PG8_SB(1, 1), cB + hstepB + kstep, voffB);
        PG8_WAIT_V(6); PG8_BAR;
    } else {
        PG8_STAGE(PG8_SB(0, 0), cB, voffB); PG8_STAGE(PG8_SA(0, 0), cA, voffA); PG8_STAGE(PG8_SB(0, 1), cB + hstepB, voffB); PG8_STAGE(PG8_SA(0, 1), cA + hstepA, voffA);
        if (wr == 1) PG8_BAR;
        PG8_WAIT_V(4); PG8_BAR;
        PG8_STAGE(PG8_SB(1, 0), cB + kstep, voffB); PG8_STAGE(PG8_SA(1, 0), cA + kstep, voffA); PG8_STAGE(PG8_SB(1, 1), cB + hstepB + kstep, voffB);
        PG8_WAIT_V(6); PG8_BAR;
    }
    for (;;) {
        const bool has_next = S.next(ui + 1, nxt);
        const char* nA = has_next ? (const char*)g.A + (size_t)nxt.pm * tstepA : cA; const char* nB = has_next ? (const char*)g.Bt + (size_t)nxt.pn * tstepB : cB;
        if constexpr (Epi::PREFETCH) E.prefetch(cur, lds + STAGE_BYTES + 16384 + 13312 + wid * 256, wid, lane);
        for (int t = 0; t < nt; t += 2) {
            const bool last = (t == nt - 2);
            const char* a1 = cA + (size_t)(t + 1) * kstep;
            const char* a2 = last ? nA : cA + (size_t)(t + 2) * kstep; const char* b2 = last ? nB : cB + (size_t)(t + 2) * kstep;
            const char* a3 = a2 + kstep; const char* b3 = b2 + kstep;
            if (last && has_next) S.a_ready(nxt);
            if constexpr (SP2) {
            PG8_LDB(B0, 0, 0); PG8_LDB(B1, 0, 1); PG8_SCHED; PG8_LDA(At, 0, 0); PG8_STAGE(PG8_SA(1, 1), a1 + hstepA, voffA);
            PG8_WAIT_V(8); PG8_WAIT_L(0); PG8_BAR; PG8_MMA(0, 0, At, B0); PG8_MMA(0, 1, At, B1); PG8_BAR; PG8_SCHED;
            PG8_LDA(At, 0, 1); PG8_STAGE(PG8_SB(0, 0), b2, voffB); PG8_STAGE(PG8_SB(0, 1), b2 + hstepB, voffB); PG8_STAGE(PG8_SA(0, 0), a2, voffA);
            PG8_WAIT_V(8); PG8_WAIT_L(0); PG8_BAR; PG8_MMA(1, 0, At, B0); PG8_MMA(1, 1, At, B1); PG8_BAR; PG8_SCHED;
            PG8_LDB(B0, 1, 0); PG8_LDB(B1, 1, 1); PG8_SCHED; PG8_LDA(At, 1, 0); PG8_STAGE(PG8_SA(0, 1), a2 + hstepA, voffA);
            PG8_WAIT_V(8); PG8_WAIT_L(0); PG8_BAR; PG8_MMA(0, 0, At, B0); PG8_MMA(0, 1, At, B1); PG8_BAR; PG8_SCHED;
            PG8_LDA(At, 1, 1); PG8_STAGE(PG8_SB(1, 0), b3, voffB); PG8_STAGE(PG8_SB(1, 1), b3 + hstepB, voffB); PG8_STAGE(PG8_SA(1, 0), a3, voffA);
            PG8_WAIT_V(8); PG8_WAIT_L(0); PG8_BAR; PG8_MMA(1, 0, At, B0); PG8_MMA(1, 1, At, B1); PG8_BAR; PG8_SCHED;
            } else {
            PG8_LDB(B0, 0, 0); PG8_SCHED; PG8_LDA(At, 0, 0); PG8_STAGE(PG8_SA(1, 1), a1 + hstepA, voffA);
            PG8_WAIT_L(8); PG8_BAR; PG8_WAIT_L(0); PG8_MMA(0, 0, At, B0); PG8_BAR; PG8_SCHED;
            PG8_LDB(B1, 0, 1); PG8_STAGE(PG8_SB(0, 0), b2, voffB);
            PG8_BAR; PG8_WAIT_L(0); PG8_MMA(0, 1, At, B1); PG8_BAR;
            PG8_LDA(At, 0, 1); PG8_STAGE(PG8_SA(0, 0), a2, voffA);
            PG8_BAR; PG8_WAIT_L(0); PG8_MMA(1, 0, At, B0); PG8_BAR; PG8_SCHED;
            PG8_STAGE(PG8_SB(0, 1), b2 + hstepB, voffB);
            PG8_WAIT_V(6); PG8_BAR; PG8_MMA(1, 1, At, B1); PG8_BAR;
            PG8_LDB(B0, 1, 0); PG8_SCHED; PG8_LDA(At, 1, 0); PG8_STAGE(PG8_SA(0, 1), a2 + hstepA, voffA);
            PG8_WAIT_L(8); PG8_BAR; PG8_WAIT_L(0); PG8_MMA(0, 0, At, B0); PG8_BAR; PG8_SCHED;
            PG8_LDB(B1, 1, 1); PG8_STAGE(PG8_SB(1, 0), b3, voffB);
            PG8_BAR; PG8_WAIT_L(0); PG8_MMA(0, 1, At, B1); PG8_BAR;
            PG8_LDA(At, 1, 1); PG8_STAGE(PG8_SA(1, 0), a3, voffA);
            PG8_BAR; PG8_WAIT_L(0); PG8_MMA(1, 0, At, B0); PG8_BAR; PG8_SCHED;
            PG8_STAGE(PG8_SB(1, 1), b3 + hstepB, voffB);
            PG8_WAIT_V(6); PG8_BAR; PG8_MMA(1, 1, At, B1); PG8_BAR;
            }
        }
        if constexpr (ALIGN_EPI) { if (wr == 0) PG8_BAR; }
        if constexpr (!Epi::AFTER_DRAIN) { E(acc, cur, wr, wc, fr, fq); S.done(cur); }
        if (!has_next) break;
#pragma unroll
        for (int a = 0; a < 2; ++a)
#pragma unroll
            for (int b = 0; b < 2; ++b)
#pragma unroll
                for (int m = 0; m < 4; ++m)
#pragma unroll
                    for (int n = 0; n < 2; ++n) acc[a][b][m][n] = (f32x4){0.f, 0.f, 0.f, 0.f};
        cur = nxt; cA = nA; cB = nB; ++ui;
        if constexpr (ALIGN_EPI) { if (wr == 1) PG8_BAR; }
    }
    PG8_WAIT_V(0);
    if constexpr (!ALIGN_EPI) { if (wr == 0) PG8_BAR; }
    PG8_BAR;
    if constexpr (Epi::AFTER_DRAIN) { E.fused(acc, cur, wr, wc, fr, fq, lds, wid, lane); S.done(cur); }
#undef PG8_SA
#undef PG8_SB
#undef PG8_STAGE
#undef PG8_LDA
#undef PG8_LDB
#undef PG8_MMA
#undef PG8_WAIT_V
#undef PG8_WAIT_L
#undef PG8_BAR
#undef PG8_SCHED
}
template <class Epi, class Sched, bool ALIGN_EPI = false, bool SP2 = false>
__device__ __forceinline__ void gemm_phase_multi(PG8_LAS unsigned char* lds, const GemmM g, const Sched& S, const Epi& E) {
    const int wid = g.wv, lane = hw_lane(), tid = (wid << 6) | lane,
              wr = wid >> 2, wc = wid & 3, fr = lane & 15, fq = lane >> 4;
    int stR[2], stRb[2], stC[2];
#pragma unroll
    for (int i = 0; i < 2; ++i) { int R, C; stage_rc(tid * 16 + i * 8192, R, C); stR[i] = R; stRb[i] = Epi::PERM ? ((R & ~31) + perm32(R & 31)) : R; stC[i] = C; }
    unsigned voffA[2], voffB[2], voffAn[2], voffBn[2]; size_t hstepA, hstepB, hstepAn, hstepBn; int nt, ntn;
#define PG8_KIND(kd, vA, vB, hA, hB, ntk) do { const int la_ = g.lda(kd), lb_ = g.ldb(kd); _Pragma("unroll") for (int i = 0; i < 2; ++i) { vA[i] = (unsigned)(stR[i] * la_ + stC[i]) * 2u; vB[i] = (unsigned)(stRb[i] * lb_ + stC[i]) * 2u; } \
        hA = (size_t)HALF * la_ * 2; hB = (size_t)HALF * lb_ * 2; ntk = g.K(kd) / BK; } while (0)
    const size_t kstep = (size_t)(BK * 2);
    const unsigned ldsw = (unsigned)wid * 1024u;
    const int aoff = lds_byte(wr * 64 + fr, fq * 8), boff = lds_byte(wc * 32 + fr, fq * 8);
#define PG8_SA(b, h) (((b) * 2 + (h)) * HTB)
#define PG8_SB(b, h) ((4 + (b) * 2 + (h)) * HTB)
#define PG8_STAGE(bufoff, gbase, voff) do { _Pragma("unroll") for (int _i = 0; _i < 2; ++_i) \
        __builtin_amdgcn_global_load_lds((const unsigned*)((const char*)(gbase) + (voff)[_i]), (PG8_LAS unsigned*)(lds + (bufoff) + ldsw + _i * 8192), 16, 0, 0); } while (0)
#define PG8_LDA(dst, b, h) do { _Pragma("unroll") for (int m = 0; m < 4; ++m) _Pragma("unroll") for (int k = 0; k < 2; ++k) dst[m][k] = *(const PG8_LAS bf16x8*)(lds + PG8_SA(b, h) + aoff + m * 2048 + k * 1024); } while (0)
#define PG8_LDB(dst, b, h) do { _Pragma("unroll") for (int n = 0; n < 2; ++n) _Pragma("unroll") for (int k = 0; k < 2; ++k) dst[n][k] = *(const PG8_LAS bf16x8*)(lds + PG8_SB(b, h) + boff + n * 2048 + k * 1024); } while (0)
#define PG8_MMA(ai, bj, At, Bt) do { __builtin_amdgcn_s_setprio(1); _Pragma("unroll") for (int m = 0; m < 4; ++m) _Pragma("unroll") for (int n = 0; n < 2; ++n) _Pragma("unroll") for (int k = 0; k < 2; ++k) \
        acc[ai][bj][m][n] = __builtin_amdgcn_mfma_f32_16x16x32_bf16(Bt[n][k], At[m][k], acc[ai][bj][m][n], 0, 0, 0); __builtin_amdgcn_s_setprio(0); } while (0)
#define PG8_WAIT_V(n) asm volatile("s_waitcnt vmcnt(" #n ")" ::: "memory")
#define PG8_WAIT_L(n) asm volatile("s_waitcnt lgkmcnt(" #n ")" ::: "memory")
#define PG8_BAR __builtin_amdgcn_s_barrier()
#define PG8_SCHED __builtin_amdgcn_sched_barrier(0)
    Unit cur, nxt; int ui = 0;
    if (!S.next(0, cur)) return;
    f32x4 acc[2][2][4][2];
#pragma unroll
    for (int a = 0; a < 2; ++a)
#pragma unroll
        for (int b = 0; b < 2; ++b)
#pragma unroll
            for (int m = 0; m < 4; ++m)
#pragma unroll
                for (int n = 0; n < 2; ++n) acc[a][b][m][n] = (f32x4){0.f, 0.f, 0.f, 0.f};
    bf16x8 At[4][2] = {}, B0[2][2] = {}, B1[2][2] = {};
    PG8_KIND(cur.kind, voffA, voffB, hstepA, hstepB, nt);
    const char* cA = (const char*)g.Ap(cur.kind) + (size_t)cur.pm * 2 * hstepA; const char* cB = (const char*)g.Bp(cur.kind) + (size_t)cur.pn * 2 * hstepB;
    S.a_ready(cur);
    if constexpr (SP2) {
        PG8_STAGE(PG8_SB(0, 0), cB, voffB); PG8_STAGE(PG8_SB(0, 1), cB + hstepB, voffB); PG8_STAGE(PG8_SA(0, 0), cA, voffA); PG8_STAGE(PG8_SA(0, 1), cA + hstepA, voffA);
        if (wr == 1) PG8_BAR;
        PG8_WAIT_V(2); PG8_BAR;
        PG8_STAGE(PG8_SB(1, 0), cB + kstep, voffB); PG8_STAGE(PG8_SA(1, 0), cA + kstep, voffA); PG8_STAGE(PG8_SB(1, 1), cB + hstepB + kstep, voffB);
        PG8_WAIT_V(6); PG8_BAR;
    } else {
        PG8_STAGE(PG8_SB(0, 0), cB, voffB); PG8_STAGE(PG8_SA(0, 0), cA, voffA); PG8_STAGE(PG8_SB(0, 1), cB + hstepB, voffB); PG8_STAGE(PG8_SA(0, 1), cA + hstepA, voffA);
        if (wr == 1) PG8_BAR;
        PG8_WAIT_V(4); PG8_BAR;
        PG8_STAGE(PG8_SB(1, 0), cB + kstep, voffB); PG8_STAGE(PG8_SA(1, 0), cA + kstep, voffA); PG8_STAGE(PG8_SB(1, 1), cB + hstepB + kstep, voffB);
        PG8_WAIT_V(6); PG8_BAR;
    }
    for (;;) {
        const bool has_next = S.next(ui + 1, nxt);
        const int nkind = has_next ? nxt.kind : cur.kind;
        PG8_KIND(nkind, voffAn, voffBn, hstepAn, hstepBn, ntn);
        const char* nA = has_next ? (const char*)g.Ap(nkind) + (size_t)nxt.pm * 2 * hstepAn : cA; const char* nB = has_next ? (const char*)g.Bp(nkind) + (size_t)nxt.pn * 2 * hstepBn : cB;
        if constexpr (Epi::PREFETCH) E.prefetch(cur, lds + STAGE_BYTES + 16384 + 13312 + wid * 256, wid, lane);
        for (int t = 0; t < nt; t += 2) {
            const bool last = (t == nt - 2);
            const char* a1 = cA + (size_t)(t + 1) * kstep;
            const char* a2 = last ? nA : cA + (size_t)(t + 2) * kstep; const char* b2 = last ? nB : cB + (size_t)(t + 2) * kstep;
            const char* a3 = a2 + kstep; const char* b3 = b2 + kstep;
            unsigned vA2[2], vB2[2];
#pragma unroll
            for (int i = 0; i < 2; ++i) { vA2[i] = last ? voffAn[i] : voffA[i]; vB2[i] = last ? voffBn[i] : voffB[i]; }
            const size_t hA2 = last ? hstepAn : hstepA, hB2 = last ? hstepBn : hstepB;
            if (last && has_next) S.a_ready(nxt);
            if constexpr (SP2) {
            PG8_LDB(B0, 0, 0); PG8_LDB(B1, 0, 1); PG8_SCHED; PG8_LDA(At, 0, 0); PG8_STAGE(PG8_SA(1, 1), a1 + hstepA, voffA);
            PG8_WAIT_V(8); PG8_WAIT_L(0); PG8_BAR; PG8_MMA(0, 0, At, B0); PG8_MMA(0, 1, At, B1); PG8_BAR; PG8_SCHED;
            PG8_LDA(At, 0, 1); PG8_STAGE(PG8_SB(0, 0), b2, vB2); PG8_STAGE(PG8_SB(0, 1), b2 + hB2, vB2); PG8_STAGE(PG8_SA(0, 0), a2, vA2);
            PG8_WAIT_V(8); PG8_WAIT_L(0); PG8_BAR; PG8_MMA(1, 0, At, B0); PG8_MMA(1, 1, At, B1); PG8_BAR; PG8_SCHED;
            PG8_LDB(B0, 1, 0); PG8_LDB(B1, 1, 1); PG8_SCHED; PG8_LDA(At, 1, 0); PG8_STAGE(PG8_SA(0, 1), a2 + hA2, vA2);
            PG8_WAIT_V(8); PG8_WAIT_L(0); PG8_BAR; PG8_MMA(0, 0, At, B0); PG8_MMA(0, 1, At, B1); PG8_BAR; PG8_SCHED;
            PG8_LDA(At, 1, 1); PG8_STAGE(PG8_SB(1, 0), b3, vB2); PG8_STAGE(PG8_SB(1, 1), b3 + hB2, vB2); PG8_STAGE(PG8_SA(1, 0), a3, vA2);
            PG8_WAIT_V(8); PG8_WAIT_L(0); PG8_BAR; PG8_MMA(1, 0, At, B0); PG8_MMA(1, 1, At, B1); PG8_BAR; PG8_SCHED;
            } else {
            PG8_LDB(B0, 0, 0); PG8_SCHED; PG8_LDA(At, 0, 0); PG8_STAGE(PG8_SA(1, 1), a1 + hstepA, voffA);
            PG8_WAIT_L(8); PG8_BAR; PG8_WAIT_L(0); PG8_MMA(0, 0, At, B0); PG8_BAR; PG8_SCHED;
            PG8_LDB(B1, 0, 1); PG8_STAGE(PG8_SB(0, 0), b2, vB2);
            PG8_BAR; PG8_WAIT_L(0); PG8_MMA(0, 1, At, B1); PG8_BAR;
            PG8_LDA(At, 0, 1); PG8_STAGE(PG8_SA(0, 0), a2, vA2);
            PG8_BAR; PG8_WAIT_L(0); PG8_MMA(1, 0, At, B0); PG8_BAR; PG8_SCHED;
            PG8_STAGE(PG8_SB(0, 1), b2 + hB2, vB2);
            PG8_WAIT_V(6); PG8_BAR; PG8_MMA(1, 1, At, B1); PG8_BAR;
            PG8_LDB(B0, 1, 0); PG8_SCHED; PG8_LDA(At, 1, 0); PG8_STAGE(PG8_SA(0, 1), a2 + hA2, vA2);
            PG8_WAIT_L(8); PG8_BAR; PG8_WAIT_L(0); PG8_MMA(0, 0, At, B0); PG8_BAR; PG8_SCHED;
            PG8_LDB(B1, 1, 1); PG8_STAGE(PG8_SB(1, 0), b3, vB2);
            PG8_BAR; PG8_WAIT_L(0); PG8_MMA(0, 1, At, B1); PG8_BAR;
            PG8_LDA(At, 1, 1); PG8_STAGE(PG8_SA(1, 0), a3, vA2);
            PG8_BAR; PG8_WAIT_L(0); PG8_MMA(1, 0, At, B0); PG8_BAR; PG8_SCHED;
            PG8_STAGE(PG8_SB(1, 1), b3 + hB2, vB2);
            PG8_WAIT_V(6); PG8_BAR; PG8_MMA(1, 1, At, B1); PG8_BAR;
            }
        }
        if constexpr (ALIGN_EPI) { if (wr == 0) PG8_BAR; }
        if constexpr (!Epi::AFTER_DRAIN) { E(acc, cur, wr, wc, fr, fq); S.done(cur); }
        if (!has_next) break;
#pragma unroll
        for (int a = 0; a < 2; ++a)
#pragma unroll
            for (int b = 0; b < 2; ++b)
#pragma unroll
                for (int m = 0; m < 4; ++m)
#pragma unroll
                    for (int n = 0; n < 2; ++n) acc[a][b][m][n] = (f32x4){0.f, 0.f, 0.f, 0.f};
        cur = nxt; cA = nA; cB = nB; ++ui;
#pragma unroll
        for (int i = 0; i < 2; ++i) { voffA[i] = voffAn[i]; voffB[i] = voffBn[i]; }
        hstepA = hstepAn; hstepB = hstepBn; nt = ntn;
        if constexpr (ALIGN_EPI) { if (wr == 1) PG8_BAR; }
    }
    PG8_WAIT_V(0);
    if constexpr (!ALIGN_EPI) { if (wr == 0) PG8_BAR; }
    PG8_BAR;
    if constexpr (Epi::AFTER_DRAIN) { E.fused(acc, cur, wr, wc, fr, fq, lds, wid, lane); S.done(cur); }
#undef PG8_KIND
#undef PG8_SA
#undef PG8_SB
#undef PG8_STAGE
#undef PG8_LDA
#undef PG8_LDB
#undef PG8_MMA
#undef PG8_WAIT_V
#undef PG8_WAIT_L
#undef PG8_BAR
#undef PG8_SCHED
}
template <class Epi, class Sched, bool ALIGN_EPI = false, bool SP2 = false>
__device__ __forceinline__ void gemm_phase_gather(PG8_LAS unsigned char* lds, const Gemm g, const int* rowidx, const Sched& S, const Epi& E) {
    const int wid = g.wv, lane = hw_lane(), tid = (wid << 6) | lane,
              wr = wid >> 2, wc = wid & 3, fr = lane & 15, fq = lane >> 4;
    const int K = g.K, nt = K / BK;
    unsigned voffB[2]; int stR[2], stC[2];
#pragma unroll
    for (int i = 0; i < 2; ++i) { int R, C; stage_rc(tid * 16 + i * 8192, R, C); const int Rb = Epi::PERM ? ((R & ~31) + perm32(R & 31)) : R;
        stR[i] = R; stC[i] = C; voffB[i] = (unsigned)(Rb * g.ldb + C) * 2u; }
    unsigned vA0[2], vA1[2], vA0n[2], vA1n[2];
#define PG8_ROWS(pm_, v0, v1) do { _Pragma("unroll") for (int i = 0; i < 2; ++i) { const int s0_ = rowidx[(pm_) * BM + stR[i]], s1_ = rowidx[(pm_) * BM + HALF + stR[i]]; const int r0_ = (s0_ < 0 ? 0 : s0_) >> 1, r1_ = (s1_ < 0 ? 0 : s1_) >> 1;     \
        v0[i] = (unsigned)(r0_ * g.lda + stC[i]) * 2u; v1[i] = (unsigned)(r1_ * g.lda + stC[i]) * 2u; } } while (0)
    const size_t kstep = (size_t)(BK * 2);
    const size_t hstepB = (size_t)HALF * g.ldb * 2;
    const size_t tstepB = 2 * hstepB;
    const unsigned ldsw = (unsigned)wid * 1024u;
    const int aoff = lds_byte(wr * 64 + fr, fq * 8), boff = lds_byte(wc * 32 + fr, fq * 8);
#define PG8_SA(b, h) (((b) * 2 + (h)) * HTB)
#define PG8_SB(b, h) ((4 + (b) * 2 + (h)) * HTB)
#define PG8_STAGE(bufoff, gbase, voff) do { _Pragma("unroll") for (int _i = 0; _i < 2; ++_i) \
        __builtin_amdgcn_global_load_lds((const unsigned*)((const char*)(gbase) + (voff)[_i]), (PG8_LAS unsigned*)(lds + (bufoff) + ldsw + _i * 8192), 16, 0, 0); } while (0)
#define PG8_LDA(dst, b, h) do { _Pragma("unroll") for (int m = 0; m < 4; ++m) _Pragma("unroll") for (int k = 0; k < 2; ++k) dst[m][k] = *(const PG8_LAS bf16x8*)(lds + PG8_SA(b, h) + aoff + m * 2048 + k * 1024); } while (0)
#define PG8_LDB(dst, b, h) do { _Pragma("unroll") for (int n = 0; n < 2; ++n) _Pragma("unroll") for (int k = 0; k < 2; ++k) dst[n][k] = *(const PG8_LAS bf16x8*)(lds + PG8_SB(b, h) + boff + n * 2048 + k * 1024); } while (0)
#define PG8_MMA(ai, bj, At, Bt) do { __builtin_amdgcn_s_setprio(1); _Pragma("unroll") for (int m = 0; m < 4; ++m) _Pragma("unroll") for (int n = 0; n < 2; ++n) _Pragma("unroll") for (int k = 0; k < 2; ++k) \
        acc[ai][bj][m][n] = __builtin_amdgcn_mfma_f32_16x16x32_bf16(Bt[n][k], At[m][k], acc[ai][bj][m][n], 0, 0, 0); __builtin_amdgcn_s_setprio(0); } while (0)
#define PG8_WAIT_V(n) asm volatile("s_waitcnt vmcnt(" #n ")" ::: "memory")
#define PG8_WAIT_L(n) asm volatile("s_waitcnt lgkmcnt(" #n ")" ::: "memory")
#define PG8_BAR __builtin_amdgcn_s_barrier()
#define PG8_SCHED __builtin_amdgcn_sched_barrier(0)
    Unit cur, nxt; int ui = 0;
    if (!S.next(0, cur)) return;
    f32x4 acc[2][2][4][2];
#pragma unroll
    for (int a = 0; a < 2; ++a)
#pragma unroll
        for (int b = 0; b < 2; ++b)
#pragma unroll
            for (int m = 0; m < 4; ++m)
#pragma unroll
                for (int n = 0; n < 2; ++n) acc[a][b][m][n] = (f32x4){0.f, 0.f, 0.f, 0.f};
    bf16x8 At[4][2] = {}, B0[2][2] = {}, B1[2][2] = {};
    PG8_ROWS(cur.pm, vA0, vA1);
    const char* cA = (const char*)g.A; const char* cB = (const char*)g.Bt + (size_t)cur.pn * tstepB;
    S.a_ready(cur);
    if constexpr (SP2) {
        PG8_STAGE(PG8_SB(0, 0), cB, voffB); PG8_STAGE(PG8_SB(0, 1), cB + hstepB, voffB); PG8_STAGE(PG8_SA(0, 0), cA, vA0); PG8_STAGE(PG8_SA(0, 1), cA, vA1);
        if (wr == 1) PG8_BAR;
        PG8_WAIT_V(2); PG8_BAR;
        PG8_STAGE(PG8_SB(1, 0), cB + kstep, voffB); PG8_STAGE(PG8_SA(1, 0), cA + kstep, vA0); PG8_STAGE(PG8_SB(1, 1), cB + hstepB + kstep, voffB);
        PG8_WAIT_V(6); PG8_BAR;
    } else {
        PG8_STAGE(PG8_SB(0, 0), cB, voffB); PG8_STAGE(PG8_SA(0, 0), cA, vA0); PG8_STAGE(PG8_SB(0, 1), cB + hstepB, voffB); PG8_STAGE(PG8_SA(0, 1), cA, vA1);
        if (wr == 1) PG8_BAR;
        PG8_WAIT_V(4); PG8_BAR;
        PG8_STAGE(PG8_SB(1, 0), cB + kstep, voffB); PG8_STAGE(PG8_SA(1, 0), cA + kstep, vA0); PG8_STAGE(PG8_SB(1, 1), cB + hstepB + kstep, voffB);
        PG8_WAIT_V(6); PG8_BAR;
    }
    for (;;) {
        const bool has_next = S.next(ui + 1, nxt);
        PG8_ROWS((has_next ? nxt.pm : cur.pm), vA0n, vA1n);
        const char* nA = cA; const char* nB = has_next ? (const char*)g.Bt + (size_t)nxt.pn * tstepB : cB;
        if constexpr (Epi::PREFETCH) E.prefetch(cur, lds + STAGE_BYTES + 16384 + 13312 + wid * 256, wid, lane);
        for (int t = 0; t < nt; t += 2) {
            const bool last = (t == nt - 2);
            const char* a1 = cA + (size_t)(t + 1) * kstep;
            const char* a2 = last ? nA : cA + (size_t)(t + 2) * kstep; const char* b2 = last ? nB : cB + (size_t)(t + 2) * kstep;
            const char* a3 = a2 + kstep; const char* b3 = b2 + kstep;
            unsigned wA0[2], wA1[2];
#pragma unroll
            for (int i = 0; i < 2; ++i) { wA0[i] = last ? vA0n[i] : vA0[i]; wA1[i] = last ? vA1n[i] : vA1[i]; }
            if (last && has_next) S.a_ready(nxt);
            if constexpr (SP2) {
            PG8_LDB(B0, 0, 0); PG8_LDB(B1, 0, 1); PG8_SCHED; PG8_LDA(At, 0, 0); PG8_STAGE(PG8_SA(1, 1), a1, vA1);
            PG8_WAIT_V(8); PG8_WAIT_L(0); PG8_BAR; PG8_MMA(0, 0, At, B0); PG8_MMA(0, 1, At, B1); PG8_BAR; PG8_SCHED;
            PG8_LDA(At, 0, 1); PG8_STAGE(PG8_SB(0, 0), b2, voffB); PG8_STAGE(PG8_SB(0, 1), b2 + hstepB, voffB); PG8_STAGE(PG8_SA(0, 0), a2, wA0);
            PG8_WAIT_V(8); PG8_WAIT_L(0); PG8_BAR; PG8_MMA(1, 0, At, B0); PG8_MMA(1, 1, At, B1); PG8_BAR; PG8_SCHED;
            PG8_LDB(B0, 1, 0); PG8_LDB(B1, 1, 1); PG8_SCHED; PG8_LDA(At, 1, 0); PG8_STAGE(PG8_SA(0, 1), a2, wA1);
            PG8_WAIT_V(8); PG8_WAIT_L(0); PG8_BAR; PG8_MMA(0, 0, At, B0); PG8_MMA(0, 1, At, B1); PG8_BAR; PG8_SCHED;
            PG8_LDA(At, 1, 1); PG8_STAGE(PG8_SB(1, 0), b3, voffB); PG8_STAGE(PG8_SB(1, 1), b3 + hstepB, voffB); PG8_STAGE(PG8_SA(1, 0), a3, wA0);
            PG8_WAIT_V(8); PG8_WAIT_L(0); PG8_BAR; PG8_MMA(1, 0, At, B0); PG8_MMA(1, 1, At, B1); PG8_BAR; PG8_SCHED;
            } else {
            PG8_LDB(B0, 0, 0); PG8_SCHED; PG8_LDA(At, 0, 0); PG8_STAGE(PG8_SA(1, 1), a1, vA1);
            PG8_WAIT_L(8); PG8_BAR; PG8_WAIT_L(0); PG8_MMA(0, 0, At, B0); PG8_BAR; PG8_SCHED;
            PG8_LDB(B1, 0, 1); PG8_STAGE(PG8_SB(0, 0), b2, voffB);
            PG8_BAR; PG8_WAIT_L(0); PG8_MMA(0, 1, At, B1); PG8_BAR;
            PG8_LDA(At, 0, 1); PG8_STAGE(PG8_SA(0, 0), a2, wA0);
            PG8_BAR; PG8_WAIT_L(0); PG8_MMA(1, 0, At, B0); PG8_BAR; PG8_SCHED;
            PG8_STAGE(PG8_SB(0, 1), b2 + hstepB, voffB);
            PG8_WAIT_V(6); PG8_BAR; PG8_MMA(1, 1, At, B1); PG8_BAR;
            PG8_LDB(B0, 1, 0); PG8_SCHED; PG8_LDA(At, 1, 0); PG8_STAGE(PG8_SA(0, 1), a2, wA1);
            PG8_WAIT_L(8); PG8_BAR; PG8_WAIT_L(0); PG8_MMA(0, 0, At, B0); PG8_BAR; PG8_SCHED;
            PG8_LDB(B1, 1, 1); PG8_STAGE(PG8_SB(1, 0), b3, voffB);
            PG8_BAR; PG8_WAIT_L(0); PG8_MMA(0, 1, At, B1); PG8_BAR;
            PG8_LDA(At, 1, 1); PG8_STAGE(PG8_SA(1, 0), a3, wA0);
            PG8_BAR; PG8_WAIT_L(0); PG8_MMA(1, 0, At, B0); PG8_BAR; PG8_SCHED;
            PG8_STAGE(PG8_SB(1, 1), b3 + hstepB, voffB);
            PG8_WAIT_V(6); PG8_BAR; PG8_MMA(1, 1, At, B1); PG8_BAR;
            }
        }
        if constexpr (ALIGN_EPI) { if (wr == 0) PG8_BAR; }
        if constexpr (!Epi::AFTER_DRAIN) { E(acc, cur, wr, wc, fr, fq); S.done(cur); }
        if (!has_next) break;
#pragma unroll
        for (int a = 0; a < 2; ++a)
#pragma unroll
            for (int b = 0; b < 2; ++b)
#pragma unroll
                for (int m = 0; m < 4; ++m)
#pragma unroll
                    for (int n = 0; n < 2; ++n) acc[a][b][m][n] = (f32x4){0.f, 0.f, 0.f, 0.f};
        cur = nxt; cA = nA; cB = nB; ++ui;
#pragma unroll
        for (int i = 0; i < 2; ++i) { vA0[i] = vA0n[i]; vA1[i] = vA1n[i]; }
        if constexpr (ALIGN_EPI) { if (wr == 1) PG8_BAR; }
    }
    PG8_WAIT_V(0);
    if constexpr (!ALIGN_EPI) { if (wr == 0) PG8_BAR; }
    PG8_BAR;
    if constexpr (Epi::AFTER_DRAIN) { E.fused(acc, cur, wr, wc, fr, fq, lds, wid, lane); S.done(cur); }
#undef PG8_ROWS
#undef PG8_SA
#undef PG8_SB
#undef PG8_STAGE
#undef PG8_LDA
#undef PG8_LDB
#undef PG8_MMA
#undef PG8_WAIT_V
#undef PG8_WAIT_L
#undef PG8_BAR
#undef PG8_SCHED
}
}

typedef unsigned short bf16;
typedef unsigned u32x4 __attribute__((ext_vector_type(4)));
typedef unsigned u32x2 __attribute__((ext_vector_type(2)));
typedef float f32x4 __attribute__((ext_vector_type(4)));
typedef float f32x2 __attribute__((ext_vector_type(2)));
typedef float f32x16 __attribute__((ext_vector_type(16)));
typedef short bf16x8 __attribute__((ext_vector_type(8)));
typedef short s16x4 __attribute__((ext_vector_type(4)));
#define LAS __attribute__((address_space(3)))

constexpr int NT = 512, NW = 8;
constexpr int T = 32768, D = 1024, SEQ = 2048, NB = 16;
constexpr int IN_COLS = 6944;
constexpr float EPS = 1e-6f;
constexpr float LOG2E = 1.4426950408889634f;
constexpr float SC_HD = 0.125f * LOG2E;
constexpr float SC_MLA = 0.10206207261596575f * LOG2E;
constexpr int XS_ROWS = 73728;

constexpr size_t MiB = 1u << 20;
constexpr size_t OFF_MOD = 64 * 1024, OFF_WRT = 1 * MiB, OFF_RE = 3 * MiB / 2, OFF_RG = 7 * MiB / 4, OFF_RD = 2 * MiB, OFF_BCNT = 9 * MiB / 4, OFF_LSE = 5 * MiB / 2;
constexpr size_t WS_WIN = 4 * MiB, WS_WUQ = 18 * MiB, WS_WUKV = WS_WUQ + 3 * MiB / 4, WS_WBM = WS_WUKV + MiB / 2, WS_WBD = WS_WBM + MiB, WS_WBW = WS_WBD + MiB / 2, WS_WOUT = WS_WBW + MiB;
constexpr size_t WS_W13 = 24 * MiB, WS_W2 = 72 * MiB;
constexpr size_t WS_XN = 96 * MiB, WS_CLAT = 160 * MiB, WS_QKV = 224 * MiB, WS_QM = 416 * MiB, WS_KVM = 464 * MiB, WS_END = 528 * MiB;
static_assert(WS_WOUT + 2 * MiB <= WS_W13, "weight map");
constexpr int LDS_BYTES = 163840, MISC_OFF = 147456;

struct Params {
    const float *x, *c; const int* pos;
    const float *w_ada, *b_ada, *g_norm1, *w_in, *g_cq, *w_uq, *g_ckv, *w_ukv, *g_q_mla, *g_k_mla, *g_q_dil, *g_k_dil, *g_q_win, *g_k_win, *sink_win;
    const float *w_br_mla, *w_br_dil, *w_br_win, *w_out, *g_norm2, *w_gr, *b_gr, *w_er, *b_er, *w1, *w3, *w2;
    float* out; unsigned char* ws;
};

typedef const __attribute__((address_space(4))) Params* KP;
__device__ __forceinline__ KP kparams() { KP k = (KP)__builtin_amdgcn_kernarg_segment_ptr(); asm volatile("" : "+s"(k)); return k; }
__device__ __forceinline__ int otid(int wv) { return (wv << 6) | pg8::hw_lane(); }
#define WAVE_IDS() const int tid = otid(wv), lane = tid & 63, wave = wv, gw = (int)blockIdx.x * NW + wave, NGW = (int)gridDim.x * NW; (void)gw; (void)NGW; (void)lane; (void)wave
__device__ __forceinline__ unsigned f2bf(float f) { unsigned u = __builtin_bit_cast(unsigned, f); return (u + 0x7fffu + ((u >> 16) & 1u)) >> 16; }
__device__ __forceinline__ unsigned pk2(float lo, float hi) { return pg8::cvt_pk_bf16(lo, hi); }
__device__ __forceinline__ float bflo(unsigned w) { return __uint_as_float(w << 16); }
__device__ __forceinline__ float bfhi(unsigned w) { return __uint_as_float(w & 0xffff0000u); }
__device__ __forceinline__ float shflx(float v, int m, int lane) { return __builtin_bit_cast(float, __builtin_amdgcn_ds_bpermute((lane ^ m) << 2, __builtin_bit_cast(int, v))); }
__device__ __forceinline__ float wave_sum(float v, int lane) {
#pragma unroll
    for (int o = 1; o < 64; o <<= 1) v += shflx(v, o, lane);
    return v;
}
__device__ __forceinline__ float sum8(float v, int lane) { v += shflx(v, 1, lane); v += shflx(v, 2, lane); v += shflx(v, 4, lane); return v; }
__device__ __forceinline__ void unpack8(const u32x4 w, float (&f)[8]) { f[0] = bflo(w.x); f[1] = bfhi(w.x); f[2] = bflo(w.y); f[3] = bfhi(w.y); f[4] = bflo(w.z); f[5] = bfhi(w.z); f[6] = bflo(w.w); f[7] = bfhi(w.w); }
__device__ __forceinline__ u32x4 pack8(const float (&f)[8]) { u32x4 w; w.x = pk2(f[0], f[1]); w.y = pk2(f[2], f[3]); w.z = pk2(f[4], f[5]); w.w = pk2(f[6], f[7]); return w; }
__device__ __forceinline__ float rope_inv_freq(int i, int half) { return __builtin_amdgcn_exp2f(-(float)i / (float)half * 13.287712379549449f); }

#define XB_TMO      128
#define XB_XCNT(j)  (256  + 64 * (j))
#define XB_XSUB(j)  (1280 + 64 * (j))
#define XB_XGEN(j)  (2304 + 64 * (j))
#define XB_TOP      3328
#define XB_TOPGEN   3392
#define XCD_BAR_WORDS 3456
#define XB_SPIN_CAP (1u << 18)

__device__ __forceinline__ unsigned xb_ld(unsigned* p)              { return __hip_atomic_load(p, __ATOMIC_RELAXED, __HIP_MEMORY_SCOPE_AGENT); }
__device__ __forceinline__ unsigned xb_add(unsigned* p, unsigned v) { return __hip_atomic_fetch_add(p, v, __ATOMIC_RELAXED, __HIP_MEMORY_SCOPE_AGENT); }
__device__ __forceinline__ unsigned xb_xcc_id() { return (unsigned)__builtin_amdgcn_s_getreg((3 << 11) | 20) & 0xFu; }
#define XB_SPIN(cond, bar) do { unsigned _sp = 0; while (cond) { __builtin_amdgcn_s_sleep(1); \
    if ((++_sp & 255u) == 0u) { if (xb_ld(&(bar)[XB_TMO])) break; if (_sp > XB_SPIN_CAP) { atomicAdd(&(bar)[XB_TMO], 1u); break; } } } } while (0)

struct XcdBarrier {
    int wv;
    unsigned* bar; unsigned x;
    volatile LAS unsigned* st;
};

__device__ __forceinline__ XcdBarrier xcd_barrier_post(unsigned* bar, volatile LAS unsigned* st, int wv) {
    XcdBarrier b; b.wv = wv; b.bar = bar; b.x = xb_xcc_id(); b.st = st;
    if (wv == 0 && pg8::hw_lane() == 0) (void)xb_add(&bar[XB_XCNT(b.x)], 1u);
    return b;
}
__device__ __forceinline__ void xcd_barrier_complete(unsigned* bar, unsigned x, unsigned& nloc, unsigned& nx) {
    const unsigned G = gridDim.x * gridDim.y * gridDim.z;
    unsigned sum, cnt, mine, sp = 0u;
    for (;;) {
        sum = 0u; cnt = 0u; mine = 0u;
#pragma unroll
        for (unsigned j = 0; j < 16; ++j) { const unsigned c = xb_ld(&bar[XB_XCNT(j)]); sum += c; cnt += (c > 0u) ? 1u : 0u; mine = (j == x) ? c : mine; }
        if (sum == G) break;
        __builtin_amdgcn_s_sleep(1);
        if ((++sp & 255u) == 0u) { if (xb_ld(&bar[XB_TMO])) break; if (sp > XB_SPIN_CAP) { atomicAdd(&bar[XB_TMO], 1u); break; } }
    }
    nloc = mine > 0u ? mine : 1u; nx = cnt > 0u ? cnt : 1u;
}

__device__ __forceinline__ void xcd_barrier(const XcdBarrier& b) {
    asm volatile("s_waitcnt vmcnt(0)" ::: "memory");
    __syncthreads();
    if (b.wv == 0 && pg8::hw_lane() == 0) {
        unsigned* bar = b.bar;
        __builtin_amdgcn_s_waitcnt(0);
        unsigned nloc = b.st[0], nx = b.st[1];
        if (nloc == 0u) { xcd_barrier_complete(bar, b.x, nloc, nx); b.st[0] = nloc; b.st[1] = nx; }
        const unsigned old = xb_add(&bar[XB_XSUB(b.x)], 1u);
        const unsigned gen = old / nloc;
        if (old + 1u == (gen + 1u) * nloc) {
            __builtin_amdgcn_fence(__ATOMIC_RELEASE, "agent");
            asm volatile("s_waitcnt vmcnt(0)" ::: "memory");
            const unsigned og = xb_add(&bar[XB_TOP], 1u);
            const unsigned tg = og / nx;
            if (og + 1u == (tg + 1u) * nx) xb_add(&bar[XB_TOPGEN], 1u);
            else XB_SPIN(xb_ld(&bar[XB_TOPGEN]) == tg, bar);
            __builtin_amdgcn_fence(__ATOMIC_ACQUIRE, "agent");
            xb_add(&bar[XB_XGEN(b.x)], 1u);
            asm volatile("s_waitcnt vmcnt(0)" ::: "memory");
        } else {
            XB_SPIN(xb_ld(&bar[XB_XGEN(b.x)]) == gen, bar);
            __builtin_amdgcn_fence(__ATOMIC_ACQUIRE, "agent");
            asm volatile("s_waitcnt vmcnt(0)" ::: "memory");
        }
    }
    __syncthreads();
}


__device__ __forceinline__ void phase_mod(KP p, LAS unsigned char* lds, int wv) {
    LAS float* cond = (LAS float*)lds;
    LAS float* red = (LAS float*)(lds + 65536);
    const int tid = otid(wv);
    float* mod = (float*)(p->ws + OFF_MOD);
    if ((int)blockIdx.x < 192) {
        for (int i = tid; i < NB * D; i += NT) { const float v = p->c[i]; cond[i] = v / (1.0f + __expf(-v)); }
        __syncthreads();
        for (int u = blockIdx.x; u < 192; u += gridDim.x) {
            const int l = u / 96, n0 = (u % 96) * 64, col = tid & 63, ks = wv;
            float acc[NB];
#pragma unroll
            for (int b = 0; b < NB; ++b) acc[b] = 0.f;
            const float* w = p->w_ada + (size_t)l * D * 6144 + n0;
#pragma unroll 1
            for (int k = ks * 128; k < ks * 128 + 128; k += 16) { float wr[16]; int kl = k; asm volatile("" : "+v"(kl));
#pragma unroll
                for (int i = 0; i < 16; ++i) { const float* wk = w + (size_t)(k + i) * 6144; wr[i] = wk[col]; }
#pragma unroll
                for (int i = 0; i < 16; i += 4) {
#pragma unroll
                    for (int b = 0; b < NB; ++b) { const f32x4 c4 = *(const LAS f32x4*)(cond + b * D + kl + i); acc[b] += (c4.x * wr[i] + c4.y * wr[i + 1]) + (c4.z * wr[i + 2] + c4.w * wr[i + 3]); } } }
#pragma unroll
            for (int b = 0; b < NB; ++b) red[(ks * NB + b) * 64 + col] = acc[b];
            __syncthreads();
            for (int i = tid; i < NB * 64; i += NT) { const int b = i >> 6, cc = i & 63; float s = 0.f;
#pragma unroll
                for (int k8 = 0; k8 < 8; ++k8) s += red[(k8 * NB + b) * 64 + cc];
                mod[(size_t)(l * NB + b) * 6144 + n0 + cc] = s + p->b_ada[l * 6144 + n0 + cc]; }
            __syncthreads();
        }
    }
}
struct CItem { const float* W; int ldw, k0, n0; bf16* WT; int ldt, drow; const float* gk; };
__device__ __forceinline__ CItem conv_decode(KP p, int l, unsigned char* ws, int it) {
    constexpr int I_IN = 16 * 217, I_UQ = 8 * 24, I_UKV = 4 * 32, I_BM = 8 * 32, I_BD = 4 * 32, I_BW = 8 * 32, I_OUT = 16 * 32, I_E1 = 32 * 16 * 12;
    CItem c; c.gk = nullptr; int r = it;
    if (r < I_IN) { const int kb = r / 217, nb = r % 217, n0 = nb * 32; int drow; if (n0 < 800) drow = 3072 + n0; else if (n0 < 3872) { const int c0 = n0 - 800, hq = c0 >> 6, dh = (c0 >> 5) & 1; drow = 256 * (hq >> 2) + 128 * dh + 32 * (hq & 3); } else drow = 4096 + n0 - 3872;
        c.W = p->w_in + (size_t)l * D * IN_COLS; c.ldw = IN_COLS; c.k0 = kb * 64; c.n0 = n0; c.WT = (bf16*)(ws + WS_WIN); c.ldt = 1024; c.drow = drow; return c; } r -= I_IN;
    if (r < I_UQ) { const int nb = r % 24, h = nb / 3, part = nb % 3;
        c.W = p->w_uq + (size_t)l * 512 * 768; c.ldw = 768; c.k0 = (r / 24) * 64; c.n0 = nb * 32; c.WT = (bf16*)(ws + WS_WUQ); c.ldt = 512; c.gk = p->g_cq + l * 512;
        c.drow = part < 2 ? 256 * (h >> 2) + 128 * part + 32 * (h & 3) : 512 + 128 * (h & 1) + 32 * (h >> 1); return c; } r -= I_UQ;
    if (r < I_UKV) { const int nb = r % 32, h16 = nb >> 1, dh = nb & 1;
        c.W = p->w_ukv + (size_t)l * 256 * 1024; c.ldw = 1024; c.k0 = (r / 32) * 64; c.n0 = nb * 32; c.WT = (bf16*)(ws + WS_WUKV); c.ldt = 256; c.gk = p->g_ckv + l * 256; c.drow = 256 * (h16 >> 2) + 128 * dh + 32 * (h16 & 3); return c; } r -= I_UKV;
    if (r < I_BM) { c.W = p->w_br_mla + (size_t)l * 512 * 1024; c.ldw = 1024; c.k0 = (r / 32) * 64; c.n0 = (r % 32) * 32; c.WT = (bf16*)(ws + WS_WBM); c.ldt = 512; c.drow = c.n0; return c; } r -= I_BM;
    if (r < I_BD) { c.W = p->w_br_dil + (size_t)l * 256 * 1024; c.ldw = 1024; c.k0 = (r / 32) * 64; c.n0 = (r % 32) * 32; c.WT = (bf16*)(ws + WS_WBD); c.ldt = 256; c.drow = c.n0; return c; } r -= I_BD;
    if (r < I_BW) { c.W = p->w_br_win + (size_t)l * 512 * 1024; c.ldw = 1024; c.k0 = (r / 32) * 64; c.n0 = (r % 32) * 32; c.WT = (bf16*)(ws + WS_WBW); c.ldt = 512; c.drow = c.n0; return c; } r -= I_BW;
    if (r < I_OUT) { c.W = p->w_out + (size_t)l * 1024 * 1024; c.ldw = 1024; c.k0 = (r / 32) * 64; c.n0 = (r % 32) * 32; c.WT = (bf16*)(ws + WS_WOUT); c.ldt = 1024; c.drow = c.n0; return c; } r -= I_OUT;
    if (r < 2 * I_E1) { const int which = r / I_E1; r -= which * I_E1; const int e = r / 192, q = r % 192, kb = q / 12, nb = q % 12, n0 = nb * 32;
        c.W = (which ? p->w3 : p->w1) + ((size_t)l * 32 + e) * 1024 * 384; c.ldw = 384; c.k0 = kb * 64; c.n0 = n0; c.WT = (bf16*)(ws + WS_W13); c.ldt = 1024; c.drow = e * 768 + 256 * (n0 >> 7) + which * 128 + (n0 & 127); return c; } r -= 2 * I_E1;
    { const int e = r / 192, q = r % 192, kb = q / 32, nb = q % 32;
      c.W = p->w2 + ((size_t)l * 32 + e) * 384 * 1024; c.ldw = 1024; c.k0 = kb * 64; c.n0 = nb * 32; c.WT = (bf16*)(ws + WS_W2); c.ldt = 384; c.drow = e * 1024 + nb * 32; return c; }
}
__device__ __forceinline__ void conv_load(const CItem& c, int lane, float (&wv)[32]) {
#pragma unroll
    for (int i = 0; i < 32; ++i) wv[i] = c.W[(size_t)(c.k0 + 2 * i + (lane >> 5)) * c.ldw + c.n0 + (lane & 31)];
}
__device__ __forceinline__ void conv_finish(const CItem& c, float (&wv)[32], LAS float* scr, int lane) {
    if (c.gk) {
#pragma unroll
        for (int i = 0; i < 32; ++i) wv[i] *= c.gk[c.k0 + 2 * i + (lane >> 5)]; }
#pragma unroll
    for (int i = 0; i < 32; ++i) scr[(2 * i + (lane >> 5)) * 33 + (lane & 31)] = wv[i];
    asm volatile("s_waitcnt lgkmcnt(0)" ::: "memory");
    const int cidx = lane & 7;
#pragma unroll
    for (int j = 0; j < 4; ++j) { const int n = (lane >> 3) + 8 * j; const LAS float* s = scr + (8 * cidx) * 33 + n;
        u32x4 o; o.x = pk2(s[0 * 33], s[1 * 33]); o.y = pk2(s[2 * 33], s[3 * 33]); o.z = pk2(s[4 * 33], s[5 * 33]); o.w = pk2(s[6 * 33], s[7 * 33]);
        *(u32x4*)(c.WT + (size_t)(c.drow + n) * c.ldt + c.k0 + 8 * cidx) = o; }
    asm volatile("s_waitcnt lgkmcnt(0)" ::: "memory");
}
constexpr int CONV_NONMOE = 16 * 217 + 8 * 24 + 4 * 32;
__device__ __forceinline__ void phase_convert(KP p, int l, LAS unsigned char* lds, int wv, const bool moe, const int cgw = -1, const int cngw = 0) {
    WAVE_IDS();
    const int GW = cgw < 0 ? gw : cgw, NG = cgw < 0 ? NGW : cngw;
    LAS float* scr = (LAS float*)(lds + wave * 16384);
    unsigned char* ws = p->ws;
    constexpr int NITEMS = 16 * 217 + 8 * 24 + 4 * 32 + 8 * 32 + 4 * 32 + 8 * 32 + 16 * 32 + 2 * 32 * 16 * 12 + 32 * 6 * 32;
    const int IT1 = moe ? NITEMS : CONV_NONMOE;
    int it = (moe ? CONV_NONMOE : 0) + GW; float va[32], vb[32]; CItem ca, cb;
    if (it < IT1) { ca = conv_decode(p, l, ws, it); conv_load(ca, lane, va); }
    while (it < IT1) {
        const int itb = it + NG; if (itb < IT1) { cb = conv_decode(p, l, ws, itb); conv_load(cb, lane, vb); }
        conv_finish(ca, va, scr, lane);
        if (itb >= IT1) break;
        const int ita = itb + NG; if (ita < IT1) { ca = conv_decode(p, l, ws, ita); conv_load(ca, lane, va); }
        conv_finish(cb, vb, scr, lane);
        it = ita;
    }
    if (moe) return;
    { u32x4* z = (u32x4*)((bf16*)(ws + WS_WIN) + (size_t)3872 * 1024); const u32x4 zero = {0u, 0u, 0u, 0u};
      for (int i = GW * 64 + lane; i < 224 * 128; i += NG * 64) z[i] = zero; }
    { float* wrt = (float*)(ws + OFF_WRT) + (size_t)l * 36 * 1024;
      for (int i = GW * 64 + lane; i < 36 * 1024; i += NG * 64) { const int j = i >> 10, k = i & 1023;
          wrt[i] = j < 4 ? p->w_gr[((size_t)l * 1024 + k) * 4 + j] : p->w_er[((size_t)l * 1024 + k) * 32 + (j - 4)]; } }
}

__device__ __forceinline__ void norm_row(const float* xrow, bf16* orow, const float* g, const float* sh, const float* sc, int lane) {
    f32x4 v[4]; float ss = 0.f;
#pragma unroll
    for (int j = 0; j < 4; ++j) { v[j] = *(const f32x4*)(xrow + 4 * lane + 256 * j); ss += (v[j].x * v[j].x + v[j].y * v[j].y) + (v[j].z * v[j].z + v[j].w * v[j].w); }
    const float rstd = __builtin_amdgcn_rsqf(wave_sum(ss, lane) * (1.0f / D) + EPS);
#pragma unroll
    for (int j = 0; j < 4; ++j) { const int cidx = 4 * lane + 256 * j; const f32x4 gg = *(const f32x4*)(g + cidx), s1 = *(const f32x4*)(sc + cidx), s0 = *(const f32x4*)(sh + cidx);
        const f32x4 y = v[j] * rstd * gg * (s1 + 1.0f) + s0;
        u32x2 o; o.x = pk2(y.x, y.y); o.y = pk2(y.z, y.w); *(u32x2*)(orow + cidx) = o; }
}
__device__ __forceinline__ void norm_row2(const float* xa, bf16* oa, const float* xb, bf16* ob, const float* g, const float* moda, const float* modb, int lane) {
    f32x4 va[4], vb[4]; float sa = 0.f, sb = 0.f;
#pragma unroll
    for (int j = 0; j < 4; ++j) { va[j] = *(const f32x4*)(xa + 4 * lane + 256 * j); vb[j] = *(const f32x4*)(xb + 4 * lane + 256 * j); }
#pragma unroll
    for (int j = 0; j < 4; ++j) { sa += (va[j].x * va[j].x + va[j].y * va[j].y) + (va[j].z * va[j].z + va[j].w * va[j].w); sb += (vb[j].x * vb[j].x + vb[j].y * vb[j].y) + (vb[j].z * vb[j].z + vb[j].w * vb[j].w); }
    const float ra = __builtin_amdgcn_rsqf(wave_sum(sa, lane) * (1.0f / D) + EPS), rb = __builtin_amdgcn_rsqf(wave_sum(sb, lane) * (1.0f / D) + EPS);
    f32x4 gg[4], s1a[4], s0a[4], s1b[4], s0b[4];
#pragma unroll
    for (int j = 0; j < 4; ++j) { const int cidx = 4 * lane + 256 * j; gg[j] = *(const f32x4*)(g + cidx); s1a[j] = *(const f32x4*)(moda + 1024 + cidx); s0a[j] = *(const f32x4*)(moda + cidx); s1b[j] = *(const f32x4*)(modb + 1024 + cidx); s0b[j] = *(const f32x4*)(modb + cidx); }
#pragma unroll
    for (int j = 0; j < 4; ++j) { const int cidx = 4 * lane + 256 * j;
        { const f32x4 y = va[j] * ra * gg[j] * (s1a[j] + 1.0f) + s0a[j]; u32x2 o; o.x = pk2(y.x, y.y); o.y = pk2(y.z, y.w); *(u32x2*)(oa + cidx) = o; }
        { const f32x4 y = vb[j] * rb * gg[j] * (s1b[j] + 1.0f) + s0b[j]; u32x2 o; o.x = pk2(y.x, y.y); o.y = pk2(y.z, y.w); *(u32x2*)(ob + cidx) = o; } }
}
__device__ __forceinline__ void phase_norm1(KP p, int l, const float* xin, int wv) {
    WAVE_IDS();
    const float* mod = (const float*)(p->ws + OFF_MOD) + (size_t)l * NB * 6144;
    bf16* XN = (bf16*)(p->ws + WS_XN);
    for (int m = gw; m < T; m += 2 * NGW) {
        const int m1 = m + NGW;
        norm_row2(xin + (size_t)m * D, XN + (size_t)m * D, xin + (size_t)m1 * D, XN + (size_t)m1 * D, p->g_norm1 + l * D, mod + (m >> 11) * 6144, mod + (m1 >> 11) * 6144, lane); }
}
__device__ __forceinline__ void phase_norms_a(KP p, int l, int wv) {
    WAVE_IDS();
    bf16* CLAT = (bf16*)(p->ws + WS_CLAT); bf16* QKV = (bf16*)(p->ws + WS_QKV);
    for (int m = gw; m < T; m += NGW) {
        bf16* cl = CLAT + (size_t)m * 1024; bf16* qk = QKV + (size_t)m * 3072;
        const int pos = p->pos[m];
        const u32x4 wq = *(const u32x4*)(cl + 8 * lane);
        const u32x2 wkv = *(const u32x2*)(cl + 512 + 4 * lane);
        const bf16 wr = lane < 32 ? cl[768 + lane] : (bf16)0;
        u32x4 wd[3];
#pragma unroll
        for (int it = 0; it < 3; ++it) wd[it] = *(const u32x4*)(qk + it * 512 + 8 * lane);
        const u32x4 ww0 = *(const u32x4*)(qk + 2304 + 8 * lane);
        u32x4 ww1 = {0u, 0u, 0u, 0u}; if (lane < 16) ww1 = *(const u32x4*)(qk + 2816 + 8 * lane);
        { float f[8]; unpack8(wq, f); float ss = 0.f;
#pragma unroll
          for (int i = 0; i < 8; ++i) ss += f[i] * f[i];
          const float rstd = __builtin_amdgcn_rsqf(wave_sum(ss, lane) * (1.0f / 512) + EPS); const float* g = p->g_cq + l * 512 + 8 * lane;
#pragma unroll
          for (int i = 0; i < 8; ++i) f[i] *= rstd * g[i];
          *(u32x4*)(cl + 8 * lane) = pack8(f); }
        { float f0 = bflo(wkv.x), f1 = bfhi(wkv.x), f2 = bflo(wkv.y), f3 = bfhi(wkv.y);
          const float rstd = __builtin_amdgcn_rsqf(wave_sum(f0 * f0 + f1 * f1 + f2 * f2 + f3 * f3, lane) * (1.0f / 256) + EPS); const float* g = p->g_ckv + l * 256 + 4 * lane;
          u32x2 o; o.x = pk2(f0 * rstd * g[0], f1 * rstd * g[1]); o.y = pk2(f2 * rstd * g[2], f3 * rstd * g[3]); *(u32x2*)(cl + 512 + 4 * lane) = o; }
        { const float v = __uint_as_float((unsigned)wr << 16);
          const float rstd = __builtin_amdgcn_rsqf(wave_sum(v * v, lane) * (1.0f / 32) + EPS);
          const float vn = v * rstd * p->g_k_mla[l * 96 + 64 + (lane & 31)];
          const float pr = shflx(vn, 16, lane);
          const float ang = (float)pos * rope_inv_freq(lane & 15, 16); float sn, cs; sincosf(ang, &sn, &cs);
          const float o = (lane & 16) ? (pr * sn + vn * cs) : (vn * cs - pr * sn);
          if (lane < 32) cl[768 + lane] = (bf16)f2bf(o); }
#pragma unroll
        for (int it = 0; it < 3; ++it) { const int col0 = it * 512 + 8 * lane; const bool isq = col0 < 768; const int d0 = col0 & 63;
            float f[8]; unpack8(wd[it], f); float ss = 0.f;
#pragma unroll
            for (int i = 0; i < 8; ++i) ss += f[i] * f[i];
            const float rstd = __builtin_amdgcn_rsqf(sum8(ss, lane) * (1.0f / 64) + EPS) * (isq ? SC_HD : 1.0f);
            const float* g = (isq ? p->g_q_dil : p->g_k_dil) + l * 64 + d0;
#pragma unroll
            for (int i = 0; i < 8; ++i) f[i] *= rstd * g[i];
            *(u32x4*)(qk + col0) = pack8(f); }
        { float f[8]; unpack8(ww0, f); float ss = 0.f;
#pragma unroll
          for (int i = 0; i < 8; ++i) ss += f[i] * f[i];
          const float rstd = __builtin_amdgcn_rsqf(sum8(ss, lane) * (1.0f / 64) + EPS) * SC_HD; const float* g = p->g_q_win + l * 64 + ((8 * lane) & 63);
#pragma unroll
          for (int i = 0; i < 8; ++i) f[i] *= rstd * g[i];
          *(u32x4*)(qk + 2304 + 8 * lane) = pack8(f); }
        { float f[8]; unpack8(ww1, f); float ss = 0.f;
#pragma unroll
          for (int i = 0; i < 8; ++i) ss += f[i] * f[i];
          const float rstd = __builtin_amdgcn_rsqf(sum8(ss, lane) * (1.0f / 64) + EPS); const float* g = p->g_k_win + l * 64 + ((8 * lane) & 63);
#pragma unroll
          for (int i = 0; i < 8; ++i) f[i] *= rstd * g[i];
          if (lane < 16) *(u32x4*)(qk + 2816 + 8 * lane) = pack8(f); }
    }
}
__device__ __forceinline__ void phase_norms_b(KP p, int l, int wv) {
    WAVE_IDS();
    bf16* QM = (bf16*)(p->ws + WS_QM); bf16* KVM = (bf16*)(p->ws + WS_KVM);
    const int h = lane >> 3, j = lane & 7;
    for (int m = gw; m < T; m += NGW) {
        bf16* qn = QM + (size_t)m * 768 + h * 96 + 8 * j; bf16* qr = QM + (size_t)m * 768 + h * 96 + 64 + 4 * j; bf16* kn = KVM + (size_t)m * 1024 + h * 128 + 8 * j;
        const int pos = p->pos[m];
        const u32x4 wn = *(const u32x4*)qn; const u32x2 wr = *(const u32x2*)qr; const u32x4 wk = *(const u32x4*)kn;
        { float f[8]; unpack8(wn, f); float ss = 0.f;
#pragma unroll
          for (int i = 0; i < 8; ++i) ss += f[i] * f[i];
          const float rstd = __builtin_amdgcn_rsqf(sum8(ss, lane) * (1.0f / 64) + EPS) * SC_MLA; const float* g = p->g_q_mla + l * 96 + 8 * j;
#pragma unroll
          for (int i = 0; i < 8; ++i) f[i] *= rstd * g[i];
          *(u32x4*)qn = pack8(f); }
        { float f[4] = {bflo(wr.x), bfhi(wr.x), bflo(wr.y), bfhi(wr.y)};
          const float rstd = __builtin_amdgcn_rsqf(sum8(f[0] * f[0] + f[1] * f[1] + f[2] * f[2] + f[3] * f[3], lane) * (1.0f / 32) + EPS); const float* g = p->g_q_mla + l * 96 + 64 + 4 * j;
          float o[4];
#pragma unroll
          for (int e = 0; e < 4; ++e) { const float vn = f[e] * rstd * g[e]; const float pr = shflx(vn, 4, lane);
              const float ang = (float)pos * rope_inv_freq(4 * (j & 3) + e, 16); float sn, cs; sincosf(ang, &sn, &cs);
              o[e] = ((j & 4) ? (pr * sn + vn * cs) : (vn * cs - pr * sn)) * SC_MLA; }
          u32x2 w; w.x = pk2(o[0], o[1]); w.y = pk2(o[2], o[3]); *(u32x2*)qr = w; }
        { float f[8]; unpack8(wk, f); float ss = 0.f;
#pragma unroll
          for (int i = 0; i < 8; ++i) ss += f[i] * f[i];
          const float rstd = __builtin_amdgcn_rsqf(sum8(ss, lane) * (1.0f / 64) + EPS); const float* g = p->g_k_mla + l * 96 + 8 * j;
#pragma unroll
          for (int i = 0; i < 8; ++i) f[i] *= rstd * g[i];
          *(u32x4*)kn = pack8(f); }
    }
}
__device__ __forceinline__ int crow(int r, int hi) { return (r & 3) + 8 * (r >> 2) + 4 * hi; }
__device__ __forceinline__ s16x4 vtr(const LAS unsigned char* ptr) { return __builtin_bit_cast(s16x4, __builtin_amdgcn_ds_read_tr16_b64_v4i16((LAS s16x4*)ptr)); }
__device__ __forceinline__ unsigned cvtpk(float lo, float hi) { return pg8::cvt_pk_bf16(lo, hi); }

__device__ __forceinline__ float fmax2(float a, float b) { return __builtin_amdgcn_fmed3f(a, b, INFINITY); }
__device__ __forceinline__ float max3f(float a, float b, float c) { float r; asm("v_max3_f32 %0, %1, %2, %3" : "=v"(r) : "v"(a), "v"(b), "v"(c)); return r; }
constexpr float SM_THR = 8.0f;
template <bool MFMA_DIRECT>
__device__ __forceinline__ void softmax_tile(f32x16& s0, f32x16& s1, float& m_run, float& l_run, bool& seen, f32x16& negm, f32x16 (&o)[2], bf16x8 (&pb)[4], int lane) {
    if (MFMA_DIRECT) asm volatile("s_nop 15\n\ts_nop 7" : "+v"(s0), "+v"(s1));
    float ma = max3f(s0[0], s0[1], s1[0]), mb = max3f(s0[2], s0[3], s1[1]); ma = max3f(ma, s1[2], s1[3]);
#pragma unroll
    for (int r = 4; r < 16; r += 4) { ma = max3f(ma, s0[r], s0[r + 1]); mb = max3f(mb, s0[r + 2], s0[r + 3]); ma = max3f(ma, s1[r], s1[r + 1]); mb = max3f(mb, s1[r + 2], s1[r + 3]); }
    const float mh_ = max3f(ma, mb, mb);
    const auto rr_ = __builtin_amdgcn_permlane32_swap(__float_as_uint(mh_), __float_as_uint(mh_), false, false);
    float mx = max3f(__uint_as_float(rr_[0]), __uint_as_float(rr_[1]), mh_);
    const bool has = mx > -INFINITY;
    const bool need = seen ? (mx > SM_THR) : has;
    if (__any(need)) {
        const float delta = seen ? fmax2(mx, 0.f) : (has ? mx : 0.f);
        const float alpha = seen ? __builtin_amdgcn_exp2f(-delta) : 1.0f;
        m_run += delta; l_run *= alpha;
#pragma unroll
        for (int r = 0; r < 16; ++r) { s0[r] -= delta; s1[r] -= delta; o[0][r] *= alpha; o[1][r] *= alpha; negm[r] = -m_run; }
    }
    seen = seen || has;
    float rs0 = 0.f, rs1 = 0.f, rs2 = 0.f, rs3 = 0.f;
#pragma unroll
    for (int r = 0; r < 16; ++r) { s0[r] = __builtin_amdgcn_exp2f(s0[r]); s1[r] = __builtin_amdgcn_exp2f(s1[r]); }
#pragma unroll
    for (int r = 0; r < 16; r += 2) { rs0 += s0[r]; rs1 += s0[r + 1]; rs2 += s1[r]; rs3 += s1[r + 1]; }
    l_run += (rs0 + rs1) + (rs2 + rs3);
#pragma unroll
    for (int ks = 0; ks < 4; ++ks) { u32x4 w;
        if (ks < 2) { const int b = 8 * ks; w.x = cvtpk(s0[b], s0[b + 1]); w.y = cvtpk(s0[b + 2], s0[b + 3]); w.z = cvtpk(s0[b + 4], s0[b + 5]); w.w = cvtpk(s0[b + 6], s0[b + 7]); }
        else { const int b = 8 * (ks - 2); w.x = cvtpk(s1[b], s1[b + 1]); w.y = cvtpk(s1[b + 2], s1[b + 3]); w.z = cvtpk(s1[b + 4], s1[b + 5]); w.w = cvtpk(s1[b + 6], s1[b + 7]); }
        pb[ks] = __builtin_bit_cast(bf16x8, w); }
}
template <bool MFMA_DIRECT>
__device__ __forceinline__ void softmax_tile4(f32x16& s0, f32x16& s1, f32x16& s2, f32x16& s3, float& m_run, float& l_run, bool& seen, f32x16& negm, f32x16 (&o)[2], bf16x8 (&pa)[4], bf16x8 (&pb)[4], int lane) {
    if (MFMA_DIRECT) asm volatile("s_nop 15\n\ts_nop 7" : "+v"(s0), "+v"(s1), "+v"(s2), "+v"(s3));
    float ma = max3f(s0[0], s0[1], s1[0]), mb = max3f(s0[2], s0[3], s1[1]); ma = max3f(ma, s1[2], s1[3]);
#pragma unroll
    for (int r = 4; r < 16; r += 4) { ma = max3f(ma, s0[r], s0[r + 1]); mb = max3f(mb, s0[r + 2], s0[r + 3]); ma = max3f(ma, s1[r], s1[r + 1]); mb = max3f(mb, s1[r + 2], s1[r + 3]); }
#pragma unroll
    for (int r = 0; r < 16; r += 4) { ma = max3f(ma, s2[r], s2[r + 1]); mb = max3f(mb, s2[r + 2], s2[r + 3]); ma = max3f(ma, s3[r], s3[r + 1]); mb = max3f(mb, s3[r + 2], s3[r + 3]); }
    const float mh_ = max3f(ma, mb, mb);
    const auto rr_ = __builtin_amdgcn_permlane32_swap(__float_as_uint(mh_), __float_as_uint(mh_), false, false);
    float mx = max3f(__uint_as_float(rr_[0]), __uint_as_float(rr_[1]), mh_);
    const bool has = mx > -INFINITY;
    const bool need = seen ? (mx > SM_THR) : has;
    if (__any(need)) {
        const float delta = seen ? fmax2(mx, 0.f) : (has ? mx : 0.f);
        const float alpha = seen ? __builtin_amdgcn_exp2f(-delta) : 1.0f;
        m_run += delta; l_run *= alpha;
#pragma unroll
        for (int r = 0; r < 16; ++r) { s0[r] -= delta; s1[r] -= delta; s2[r] -= delta; s3[r] -= delta; o[0][r] *= alpha; o[1][r] *= alpha; negm[r] = -m_run; }
    }
    seen = seen || has;
    float rs0 = 0.f, rs1 = 0.f, rs2 = 0.f, rs3 = 0.f;
#pragma unroll
    for (int r = 0; r < 16; ++r) { s0[r] = __builtin_amdgcn_exp2f(s0[r]); s1[r] = __builtin_amdgcn_exp2f(s1[r]); s2[r] = __builtin_amdgcn_exp2f(s2[r]); s3[r] = __builtin_amdgcn_exp2f(s3[r]); }
#pragma unroll
    for (int r = 0; r < 16; ++r) { rs0 += s0[r]; rs1 += s1[r]; rs2 += s2[r]; rs3 += s3[r]; }
    l_run += (rs0 + rs1) + (rs2 + rs3);
#pragma unroll
    for (int ks = 0; ks < 4; ++ks) { u32x4 w, v;
        if (ks < 2) { const int b = 8 * ks; w.x = cvtpk(s0[b], s0[b + 1]); w.y = cvtpk(s0[b + 2], s0[b + 3]); w.z = cvtpk(s0[b + 4], s0[b + 5]); w.w = cvtpk(s0[b + 6], s0[b + 7]);
                                            v.x = cvtpk(s2[b], s2[b + 1]); v.y = cvtpk(s2[b + 2], s2[b + 3]); v.z = cvtpk(s2[b + 4], s2[b + 5]); v.w = cvtpk(s2[b + 6], s2[b + 7]); }
        else { const int b = 8 * (ks - 2); w.x = cvtpk(s1[b], s1[b + 1]); w.y = cvtpk(s1[b + 2], s1[b + 3]); w.z = cvtpk(s1[b + 4], s1[b + 5]); w.w = cvtpk(s1[b + 6], s1[b + 7]);
                                            v.x = cvtpk(s3[b], s3[b + 1]); v.y = cvtpk(s3[b + 2], s3[b + 3]); v.z = cvtpk(s3[b + 4], s3[b + 5]); v.w = cvtpk(s3[b + 6], s3[b + 7]); }
        pa[ks] = __builtin_bit_cast(bf16x8, w); pb[ks] = __builtin_bit_cast(bf16x8, v); }
}
__device__ __forceinline__ void pv_tile(f32x16 (&o)[2], const LAS unsigned char* vt, int vlane, const bf16x8 (&pb)[4]) {
#pragma unroll
    for (int d0 = 0; d0 < 2; ++d0) { const LAS unsigned char* vb = vt + (d0 ? (vlane ^ 64) : vlane);
#pragma unroll
        for (int ks = 0; ks < 4; ++ks) { const s16x4 lo = vtr(vb + ks * 2048), hi4 = vtr(vb + ks * 2048 + 1024);
            const bf16x8 vf = {lo[0], lo[1], lo[2], lo[3], hi4[0], hi4[1], hi4[2], hi4[3]};
            o[d0] = __builtin_amdgcn_mfma_f32_32x32x16_bf16(vf, pb[ks], o[d0], 0, 0, 0); } }
}
__device__ __forceinline__ void store_o(bf16* orow, const f32x16 (&o)[2], float inv, int hi) {
#pragma unroll
    for (int d0 = 0; d0 < 2; ++d0)
#pragma unroll
        for (int gq = 0; gq < 4; ++gq) { u32x2 w; w.x = pk2(o[d0][4 * gq] * inv, o[d0][4 * gq + 1] * inv); w.y = pk2(o[d0][4 * gq + 2] * inv, o[d0][4 * gq + 3] * inv);
            *(u32x2*)(orow + 32 * d0 + 8 * gq + 4 * hi) = w; }
}

constexpr int MLA_KP = 208;
constexpr int MLA_SK = 128 * MLA_KP, MLA_STAGE = MLA_SK + 128 * 128;
__device__ __forceinline__ void mla_unit(KP p, int b, int h, int qb, LAS unsigned char* lds, int wv) {
    const int tid = otid(wv), lane = tid & 63, wid = tid >> 6, r32 = lane & 31, hi = lane >> 5;
    const bf16* QM = (const bf16*)(p->ws + WS_QM); const bf16* KVM = (const bf16*)(p->ws + WS_KVM); bf16* CLAT = (bf16*)(p->ws + WS_CLAT);
    const size_t row0 = (size_t)b * SEQ;
    const size_t qtok = row0 + qb * 256 + wid * 32 + r32;
    bf16x8 qf[6];
#pragma unroll
    for (int s = 0; s < 6; ++s) qf[s] = *(const bf16x8*)(QM + qtok * 768 + h * 96 + 16 * s + 8 * hi);
    const int skey = tid >> 3, sch = tid & 7, rkey = tid >> 2, rch = tid & 3;
    const bf16* gkn = KVM + (row0 + skey) * 1024 + h * 128 + 8 * sch;
    const bf16* gkr = CLAT + (row0 + rkey) * 1024 + 768 + 8 * rch;
    const int lkn = skey * MLA_KP + 16 * sch, lkr = rkey * MLA_KP + 128 + 16 * rch, lv = MLA_SK + skey * 128 + ((sch ^ (((skey >> 1) & 1) << 2)) * 16);
    const int q4 = (lane & 15) >> 2, p4 = lane & 3, G1 = (lane >> 4) & 1;
    const int vlane = (4 * hi + q4) * 128 + (4 * ((q4 >> 1) & 1) + 2 * G1 + (p4 >> 1)) * 16 + 8 * (p4 & 1);
    const int klane = r32 * MLA_KP + 16 * hi;
    f32x16 o[2]; o[0] = f32x16{}; o[1] = f32x16{};
    float m_run = 0.f, l_run = 0.f; bool seen = false; f32x16 negm = f32x16{};
    u32x4 rk0, rk1, rv0, rv1, rkr;
#define MLA_LOAD(t) do { const size_t adv = (size_t)(t) * 128 * 1024; rk0 = *(const u32x4*)(gkn + adv); rk1 = *(const u32x4*)(gkn + adv + 64 * 1024); rv0 = *(const u32x4*)(gkn + adv + 64); rv1 = *(const u32x4*)(gkn + adv + 64 * 1024 + 64); rkr = *(const u32x4*)(gkr + adv); } while (0)
#define MLA_WRITE(buf) do { LAS unsigned char* B_ = lds + (buf) * MLA_STAGE; *(LAS u32x4*)(B_ + lkn) = rk0; *(LAS u32x4*)(B_ + lkn + 64 * MLA_KP) = rk1; *(LAS u32x4*)(B_ + lv) = rv0; *(LAS u32x4*)(B_ + lv + 64 * 128) = rv1; *(LAS u32x4*)(B_ + lkr) = rkr; } while (0)
    const bool grpB = wv >= 4;
#define PP_BAR() do { __builtin_amdgcn_sched_barrier(0); __syncthreads(); __builtin_amdgcn_sched_barrier(0); } while (0)
    MLA_LOAD(0); MLA_WRITE(0); MLA_LOAD(1);
    constexpr int NS = SEQ / 128;
    PP_BAR();
    if (grpB) PP_BAR();
    bf16x8 pa[4] = {}, pb[4] = {};
    int bc = 0, bn = 1, bp = 2;
    for (int t = 0; t < NS; ++t) {
        if (t + 1 < NS) MLA_WRITE(bn);
        if (t + 2 < NS) MLA_LOAD(t + 2);
        const LAS unsigned char* Kb = lds + bc * MLA_STAGE; const LAS unsigned char* Vp = lds + bp * MLA_STAGE + MLA_SK;
        if (t > 0) { pv_tile(o, Vp, vlane, pa); pv_tile(o, Vp + 64 * 128, vlane, pb); }
        f32x16 s0 = negm, s1 = negm, s2 = negm, s3 = negm;
#pragma unroll
        for (int s = 0; s < 6; ++s) { const bf16x8 a0 = *(const LAS bf16x8*)(Kb + klane + 32 * s), a1 = *(const LAS bf16x8*)(Kb + klane + 32 * MLA_KP + 32 * s);
            const bf16x8 a2 = *(const LAS bf16x8*)(Kb + klane + 64 * MLA_KP + 32 * s), a3 = *(const LAS bf16x8*)(Kb + klane + 96 * MLA_KP + 32 * s);
            s0 = __builtin_amdgcn_mfma_f32_32x32x16_bf16(a0, qf[s], s0, 0, 0, 0); s1 = __builtin_amdgcn_mfma_f32_32x32x16_bf16(a1, qf[s], s1, 0, 0, 0);
            s2 = __builtin_amdgcn_mfma_f32_32x32x16_bf16(a2, qf[s], s2, 0, 0, 0); s3 = __builtin_amdgcn_mfma_f32_32x32x16_bf16(a3, qf[s], s3, 0, 0, 0); }
        PP_BAR();
        softmax_tile4<true>(s0, s1, s2, s3, m_run, l_run, seen, negm, o, pa, pb, lane);
        PP_BAR();
        const int tmp = bp; bp = bc; bc = bn; bn = tmp;
    }
    { const LAS unsigned char* Vp = lds + bp * MLA_STAGE + MLA_SK; pv_tile(o, Vp, vlane, pa); pv_tile(o, Vp + 64 * 128, vlane, pb); }
    if (!grpB) PP_BAR();
#undef PP_BAR
#undef MLA_LOAD
#undef MLA_WRITE
    l_run += shflx(l_run, 32, lane);
    store_o(CLAT + qtok * 1024 + h * 64, o, 1.0f / l_run, hi);
    __syncthreads();
}
__device__ __forceinline__ int conv_group() { return (int)((blockIdx.x >> 3) % 6u); }
__device__ __forceinline__ void phase_attn_mla(KP p, int l, LAS unsigned char* lds, int wv) {
    const int G = gridDim.x, bx = blockIdx.x; const int vcu = (G % 8 == 0) ? (bx % 8) * (G / 8) + bx / 8 : bx;
    const int grp = conv_group(); int k = 0;
    for (int u = vcu; u < NB * 8 * 8; u += G, ++k) { if (k == grp) { phase_convert(p, l, lds, wv, true); __syncthreads(); } mla_unit(p, u >> 6, (u >> 3) & 7, u & 7, lds, wv); }
    if (k <= grp && grp < 4) { phase_convert(p, l, lds, wv, true); __syncthreads(); }
}

constexpr int W_KP = 144;
constexpr int W_TILE = 64 * W_KP + 64 * 128 + 256;
struct WinDesc {
    int ntile, dil, Lsub, tokbase, kcol, vcol;
    int kind, sbase, rbase;
    int qsub, posq, tlo, tn, ksub_lo, radius;
    float slope2, sink2; bool sink; bf16* qrow; float* lse_out;
    __device__ __forceinline__ int sub0(int t) const { return kind == 0 ? sbase + 64 * t : 64 * (t & 1); }
    __device__ __forceinline__ int res(int t) const { return kind == 0 ? rbase : rbase + (t >> 1); }
    __device__ __forceinline__ bool on(int t) const { const int s0 = sub0(t); return t < ntile && s0 >= 0 && s0 < Lsub; }
};
__device__ __forceinline__ void win_make_desc(KP p, int l, int u, int wid, int r32, WinDesc& D) {
    bf16* QKV = (bf16*)(p->ws + WS_QKV); float* LSE = (float*)(p->ws + OFF_LSE);
    if (u < 1536) {
        const int g = u >> 9, v = u & 511, b = v >> 5, h = (v >> 3) & 3, w8 = v & 7;
        const int dil = g == 0 ? 1 : (g == 1 ? 4 : 16);
        D.dil = dil; D.Lsub = SEQ / dil; D.tokbase = b * SEQ; D.kcol = 768 + g * 256 + h * 64; D.vcol = 1536 + g * 256 + h * 64;
        int rq, qs0;
        if (g == 0) { D.ntile = 6; D.kind = 0; D.sbase = 256 * w8 - 64; D.rbase = 0; rq = 0; qs0 = 256 * w8 + 32 * wid; D.tlo = wid >> 1; D.tn = 3; D.ksub_lo = 256 * w8 - 64 + 64 * D.tlo; }
        else if (g == 1) { const int rr = w8 >> 1, uu = w8 & 1; D.ntile = 6; D.kind = 0; D.sbase = 256 * uu - 64; D.rbase = rr; rq = rr; qs0 = 256 * uu + 32 * wid; D.tlo = wid >> 1; D.tn = 3; D.ksub_lo = 256 * uu - 64 + 64 * D.tlo; }
        else { D.ntile = 4; D.kind = 1; D.sbase = 0; D.rbase = 2 * w8; rq = 2 * w8 + (wid >> 2); qs0 = 32 * (wid & 3); D.tlo = 2 * (wid >> 2); D.tn = 2; D.ksub_lo = 0; }
        D.qsub = qs0 + r32; const size_t tok = (size_t)b * SEQ + (size_t)D.qsub * dil + rq;
        D.qrow = QKV + tok * 3072 + g * 256 + h * 64; D.posq = p->pos[tok]; D.radius = 64;
        D.slope2 = __builtin_amdgcn_exp2f(-8.0f * (float)(4 * g + h + 1) / 12.0f) * LOG2E; D.sink2 = 0.f; D.sink = false;
        D.lse_out = LSE + tok * 12 + g * 4 + h;
    } else {
        const int v = u - 1536, b = v >> 6, kvh = (v >> 5) & 1, blk = v & 31;
        D.dil = 1; D.Lsub = SEQ; D.tokbase = b * SEQ; D.kcol = 2816 + kvh * 64; D.vcol = 2944 + kvh * 64; D.ntile = 5; D.kind = 0; D.sbase = 64 * blk - 128; D.rbase = 0;
        const int rep = wid >> 1, head = kvh * 4 + rep;
        D.qsub = 64 * blk + 32 * (wid & 1) + r32; const size_t tok = (size_t)b * SEQ + D.qsub;
        D.qrow = QKV + tok * 3072 + 2304 + head * 64; D.posq = p->pos[tok]; D.radius = 128; D.tlo = 0; D.tn = 5; D.ksub_lo = 64 * blk - 128;
        D.slope2 = __builtin_amdgcn_exp2f(-(float)(head + 1)) * LOG2E; D.sink2 = p->sink_win[l * 8 + head] * LOG2E; D.sink = true; D.lse_out = nullptr;
    }
}
struct WinRegs { u32x4 rk[6], rv[6]; int rp[6]; bf16x8 qf[4]; };
__device__ __forceinline__ void win_issue(KP p, const WinDesc& D, int tid, int hi, WinRegs& R) {
    const bf16* QKV = (const bf16*)(p->ws + WS_QKV); const int key = tid >> 3, ch = tid & 7;
#pragma unroll
    for (int t = 0; t < 6; ++t) { if (D.on(t)) { const size_t tok = (size_t)D.tokbase + (size_t)(D.sub0(t) + key) * D.dil + D.res(t);
            R.rk[t] = *(const u32x4*)(QKV + tok * 3072 + D.kcol + 8 * ch); R.rv[t] = *(const u32x4*)(QKV + tok * 3072 + D.vcol + 8 * ch);
            R.rp[t] = (tid < 64) ? p->pos[(size_t)D.tokbase + (size_t)(D.sub0(t) + tid) * D.dil + D.res(t)] : 0; } }
#pragma unroll
    for (int s = 0; s < 4; ++s) R.qf[s] = *(const bf16x8*)(D.qrow + 16 * s + 8 * hi);
}
__device__ __forceinline__ void win_write(LAS unsigned char* lds, const WinDesc& D, int tid, const WinRegs& R) {
    const int key = tid >> 3, ch = tid & 7;
#pragma unroll
    for (int t = 0; t < 6; ++t) { if (D.on(t)) { LAS unsigned char* Kt = lds + t * W_TILE;
            *(LAS u32x4*)(Kt + key * W_KP + 16 * ch) = R.rk[t];
            *(LAS u32x4*)(Kt + 64 * W_KP + key * 128 + ((ch ^ (((key >> 1) & 1) << 2)) * 16)) = R.rv[t];
            if (tid < 64) *(LAS float*)(Kt + 64 * W_KP + 64 * 128 + 4 * tid) = (float)R.rp[t]; } }
}
template <bool SINK>
__device__ __forceinline__ void win_wave(LAS unsigned char* lds, const WinDesc& D, const bf16x8 (&qf)[4], int lane) {
    const int r32 = lane & 31, hi = lane >> 5;
    const int q4 = (lane & 15) >> 2, p4 = lane & 3, G1 = (lane >> 4) & 1;
    const int vlane = (4 * hi + q4) * 128 + (4 * ((q4 >> 1) & 1) + 2 * G1 + (p4 >> 1)) * 16 + 8 * (p4 & 1);
    const int klane = r32 * W_KP + 16 * hi;
    f32x16 o[2]; o[0] = f32x16{}; o[1] = f32x16{};
    float m_run = SINK ? D.sink2 : 0.f, l_run = SINK ? (hi == 0 ? 1.0f : 0.0f) : 0.f; bool seen = SINK; f32x16 negm;
#pragma unroll
    for (int r = 0; r < 16; ++r) negm[r] = -m_run;
    const int qsub = D.qsub, radius = D.radius; const float slope2 = D.slope2, posqf = (float)D.posq;
    for (int tt = 0; tt < D.tn; ++tt) {
        const int ks0 = D.ksub_lo + 64 * tt;
        if (ks0 < 0 || ks0 >= D.Lsub) continue;
        const LAS unsigned char* Kt = lds + (D.tlo + tt) * W_TILE; const LAS unsigned char* Vt = Kt + 64 * W_KP; const LAS float* pkf = (const LAS float*)(Vt + 64 * 128);
        f32x16 s0 = negm, s1 = negm;
#pragma unroll
        for (int s = 0; s < 4; ++s) { const bf16x8 a0 = *(const LAS bf16x8*)(Kt + klane + 32 * s), a1 = *(const LAS bf16x8*)(Kt + klane + 32 * W_KP + 32 * s);
            s0 = __builtin_amdgcn_mfma_f32_32x32x16_bf16(a0, qf[s], s0, 0, 0, 0); s1 = __builtin_amdgcn_mfma_f32_32x32x16_bf16(a1, qf[s], s1, 0, 0, 0); }
        const int c0 = ks0 - qsub + 4 * hi + radius; const unsigned lim = 2u * (unsigned)radius;
#pragma unroll
        for (int gq = 0; gq < 4; ++gq) { const f32x4 pa = *(const LAS f32x4*)(pkf + 8 * gq + 4 * hi), pb4 = *(const LAS f32x4*)(pkf + 32 + 8 * gq + 4 * hi);
#pragma unroll
            for (int e = 0; e < 4; ++e) { const int r = 4 * gq + e;
                s0[r] = (unsigned)(c0 + 8 * gq + e) <= lim ? s0[r] - slope2 * fabsf(posqf - pa[e]) : -INFINITY;
                s1[r] = (unsigned)(c0 + 8 * gq + e + 32) <= lim ? s1[r] - slope2 * fabsf(posqf - pb4[e]) : -INFINITY; } }
        bf16x8 pb[4];
        softmax_tile<false>(s0, s1, m_run, l_run, seen, negm, o, pb, lane);
        pv_tile(o, Vt, vlane, pb);
    }
    l_run += shflx(l_run, 32, lane);
    store_o(D.qrow, o, 1.0f / l_run, hi);
    if (!SINK && hi == 0) *D.lse_out = m_run + __log2f(l_run);
}
__device__ __forceinline__ void phase_attn_win(KP p, int l, LAS unsigned char* lds, int wv) {
    const int tid = otid(wv), lane = tid & 63, wid = wv, r32 = lane & 31, hi = lane >> 5;
    const int G = gridDim.x, bx = blockIdx.x;
    int u = (G % 8 == 0) ? (bx % 8) * (G / 8) + bx / 8 : bx;
    WinDesc Dn; WinRegs Rn;
    if (u < 2560) { win_make_desc(p, l, u, wid, r32, Dn); win_issue(p, Dn, tid, hi, Rn); }
    for (; u < 2560; u += G) {
        const WinDesc D = Dn;
        __syncthreads();
        win_write(lds, D, tid, Rn);
        bf16x8 qf[4];
#pragma unroll
        for (int s = 0; s < 4; ++s) qf[s] = Rn.qf[s];
        __syncthreads();
        if (u + G < 2560) { win_make_desc(p, l, u + G, wid, r32, Dn); win_issue(p, Dn, tid, hi, Rn); }
        if (wv >= 4) __builtin_amdgcn_s_sleep(12);
        if (D.sink) win_wave<true>(lds, D, qf, lane); else win_wave<false>(lds, D, qf, lane);
    }
    __syncthreads();
}
__device__ __forceinline__ void phase_dil_combine(KP p, int wv) {
    WAVE_IDS();
    const bf16* QKV = (const bf16*)(p->ws + WS_QKV); const float* LSE = (const float*)(p->ws + OFF_LSE); bf16* CLAT = (bf16*)(p->ws + WS_CLAT);
    const int h = lane >> 4, d0 = (lane & 15) * 4;
    for (int m0 = gw; m0 < T; m0 += 4 * NGW) {
        float ls[4][3]; u32x2 w[4][3];
#pragma unroll
        for (int q = 0; q < 4; ++q) { const int m = m0 + q * NGW;
#pragma unroll
            for (int g = 0; g < 3; ++g) { ls[q][g] = LSE[(size_t)m * 12 + g * 4 + h]; w[q][g] = *(const u32x2*)(QKV + (size_t)m * 3072 + g * 256 + h * 64 + d0); } }
#pragma unroll
        for (int q = 0; q < 4; ++q) { const int m = m0 + q * NGW;
            const float mx = fmaxf(ls[q][0], fmaxf(ls[q][1], ls[q][2]));
            float e[3], es = 0.f;
#pragma unroll
            for (int g = 0; g < 3; ++g) { e[g] = __builtin_amdgcn_exp2f(ls[q][g] - mx); es += e[g]; }
            const float inv = 1.0f / es; float o[4] = {0.f, 0.f, 0.f, 0.f};
#pragma unroll
            for (int g = 0; g < 3; ++g) { const float wg = e[g] * inv; o[0] += wg * bflo(w[q][g].x); o[1] += wg * bfhi(w[q][g].x); o[2] += wg * bflo(w[q][g].y); o[3] += wg * bfhi(w[q][g].y); }
            u32x2 ow; ow.x = pk2(o[0], o[1]); ow.y = pk2(o[2], o[3]);
            *(u32x2*)(CLAT + (size_t)m * 1024 + 512 + h * 64 + d0) = ow; }
    }
}
__device__ __forceinline__ void split3(const f32x4 w, u32x2& hi, u32x2& mid, u32x2& lo) {
    hi.x = pg8::cvt_pk_bf16(w.x, w.y); hi.y = pg8::cvt_pk_bf16(w.z, w.w);
    const f32x4 r1 = {w.x - bflo(hi.x), w.y - bfhi(hi.x), w.z - bflo(hi.y), w.w - bfhi(hi.y)};
    mid.x = pg8::cvt_pk_bf16(r1.x, r1.y); mid.y = pg8::cvt_pk_bf16(r1.z, r1.w);
    const f32x4 r2 = {r1.x - bflo(mid.x), r1.y - bfhi(mid.x), r1.z - bflo(mid.y), r1.w - bfhi(mid.y)};
    lo.x = pg8::cvt_pk_bf16(r2.x, r2.y); lo.y = pg8::cvt_pk_bf16(r2.z, r2.w);
}
__device__ __forceinline__ void phase_norm2_route(KP p, int l, LAS unsigned char* lds, int wv) {
    WAVE_IDS();
    constexpr int WPITCH = 1040;
    constexpr int GS_OFF = 112640, SH_OFF = GS_OFF + 4096, CB_OFF = SH_OFF + 4096, LG_OFF = CB_OFF + 1024;
    static_assert(3 * 36 * WPITCH <= GS_OFF && LG_OFF + 8 * 2304 <= MISC_OFF, "router LDS map");
    const float* mod = (const float*)(p->ws + OFF_MOD) + (size_t)l * NB * 6144;
    const float* wrt = (const float*)(p->ws + OFF_WRT) + (size_t)l * 36 * 1024;
    bf16* XN = (bf16*)(p->ws + WS_XN);
    int* RE = (int*)(p->ws + OFF_RE); float* RG = (float*)(p->ws + OFF_RG); int* BCNT = (int*)(p->ws + OFF_BCNT);
    LAS int* hist = (LAS int*)(lds + MISC_OFF + 4096);
    LAS float* ssl = (LAS float*)(lds + MISC_OFF + 4608) + wave * 16;
    LAS float* lgw = (LAS float*)(lds + LG_OFF) + wave * 16 * 36;
    LAS float* cbp = (LAS float*)(lds + CB_OFF);
    { int* tokidx = (int*)(p->ws + OFF_LSE); for (int i = (int)blockIdx.x * NT + tid; i < XS_ROWS; i += (int)gridDim.x * NT) tokidx[i] = -1; }
    for (int chunk = blockIdx.x; chunk < T / 128; chunk += gridDim.x) {
        int tl = tid; asm volatile("" : "+v"(tl));
        const int r = tl & 15, q = (tl >> 4) & 3;
        const int k4 = tl & 127, j0 = tl >> 7;
        const int b = chunk >> 4;
        const int row = chunk * 128 + wave * 16 + r;
        f32x4 wst[9];
#pragma unroll
        for (int it = 0; it < 9; ++it) wst[it] = *(const f32x4*)(wrt + (j0 + 4 * it) * 1024 + 4 * k4);
        const f32x2 gn = *(const f32x2*)(p->g_norm2 + l * D + 2 * tid), sc = *(const f32x2*)(mod + b * 6144 + 4096 + 2 * tid), sh = *(const f32x2*)(mod + b * 6144 + 3072 + 2 * tid);
        u32x4 xa[32];
        { const bf16* xrow = (const bf16*)(p->ws + WS_CLAT) + (size_t)row * D + 8 * q;
#pragma unroll
          for (int s = 0; s < 32; ++s) xa[s] = *(const u32x4*)(xrow + 32 * s); }
        if (tid < 32) hist[tid] = 0;
        *(LAS f32x2*)(lds + GS_OFF + 8 * tid) = gn * (sc + 1.0f); *(LAS f32x2*)(lds + SH_OFF + 8 * tid) = sh;
        __syncthreads();
        f32x4 acc[3] = {{0.f, 0.f, 0.f, 0.f}, {0.f, 0.f, 0.f, 0.f}, {0.f, 0.f, 0.f, 0.f}}, ssa = {0.f, 0.f, 0.f, 0.f};
#pragma unroll
        for (int h = 0; h < 2; ++h) {
            { const int col = 512 * h + 4 * k4;
              const f32x4 g4 = *(const LAS f32x4*)(lds + GS_OFF + 4 * col), s4 = *(const LAS f32x4*)(lds + SH_OFF + 4 * col);
#pragma unroll
              for (int it = 0; it < 9; ++it) { const int j = j0 + 4 * it; const f32x4 w = wst[it];
                  float cp = (s4.x * w.x + s4.y * w.y) + (s4.z * w.z + s4.w * w.w);
                  cp = wave_sum(cp, lane);
                  if (lane == 0) cbp[(2 * h + (wave & 1)) * 36 + j] = cp + ((h == 0 && (wave & 1) == 0) ? (j < 4 ? p->b_gr[l * 4 + j] : p->b_er[l * 32 + j - 4]) : 0.f);
                  u32x2 hi, mid, lo; split3(w * g4, hi, mid, lo);
                  *(LAS u32x2*)(lds + (0 * 36 + j) * WPITCH + 8 * k4) = hi; *(LAS u32x2*)(lds + (1 * 36 + j) * WPITCH + 8 * k4) = mid; *(LAS u32x2*)(lds + (2 * 36 + j) * WPITCH + 8 * k4) = lo; } }
            __syncthreads();
#pragma unroll
            for (int s2 = 0; s2 < 16; ++s2) { const bf16x8 a = __builtin_bit_cast(bf16x8, xa[16 * h + s2]);
                ssa = __builtin_amdgcn_mfma_f32_16x16x32_bf16(a, a, ssa, 0, 0, 0);
#pragma unroll
                for (int nt = 0; nt < 3; ++nt) { const int jr = (16 * nt + r) < 35 ? (16 * nt + r) : 35;
#pragma unroll
                    for (int t = 0; t < 3; ++t) { const bf16x8 bw = *(const LAS bf16x8*)(lds + (t * 36 + jr) * WPITCH + 64 * s2 + 16 * q);
                        acc[nt] = __builtin_amdgcn_mfma_f32_16x16x32_bf16(a, bw, acc[nt], 0, 0, 0); } }
                __builtin_amdgcn_sched_barrier(0); }
            if (h == 0) {
#pragma unroll
                for (int it = 0; it < 9; ++it) wst[it] = *(const f32x4*)(wrt + (j0 + 4 * it) * 1024 + 512 + 4 * k4); }
            __syncthreads();
        }
#pragma unroll
        for (int nt = 0; nt < 3; ++nt) if (16 * nt + r < 36) {
#pragma unroll
            for (int i = 0; i < 4; ++i) lgw[(4 * q + i) * 36 + 16 * nt + r] = acc[nt][i]; }
        if ((r >> 2) == q) { const int i = r & 3; ssl[r] = i == 0 ? ssa.x : (i == 1 ? ssa.y : (i == 2 ? ssa.z : ssa.w)); }
        asm volatile("s_waitcnt lgkmcnt(0)" ::: "memory");
        const float rstd = __builtin_amdgcn_rsqf(ssl[r] * (1.0f / D) + EPS);
        if (lane < 16) { const int m = row; const LAS float* Lr = lgw + lane * 36;
#define LGT(j) (Lr[j] * rstd + ((cbp[j] + cbp[36 + (j)]) + (cbp[72 + (j)] + cbp[108 + (j)])))
            float Lg[4];
#pragma unroll
            for (int g = 0; g < 4; ++g) Lg[g] = LGT(g);
            float gm = Lg[0]; int gi = 0;
#pragma unroll
            for (int g = 1; g < 4; ++g) if (Lg[g] > gm) { gm = Lg[g]; gi = g; }
            float gs = 0.f;
#pragma unroll
            for (int g = 0; g < 4; ++g) gs += __expf(Lg[g] - gm);
            const float gw_ = 1.0f / gs;
            float el[8]; float em = -INFINITY;
#pragma unroll
            for (int e = 0; e < 8; ++e) { el[e] = LGT(4 + gi * 8 + e); em = fmaxf(em, el[e]); }
#undef LGT
            float es = 0.f;
#pragma unroll
            for (int e = 0; e < 8; ++e) { el[e] = __expf(el[e] - em); es += el[e]; }
            int i1 = 0; float p1 = el[0];
#pragma unroll
            for (int e = 1; e < 8; ++e) if (el[e] > p1) { p1 = el[e]; i1 = e; }
            int i2 = -1; float p2 = -1.f;
#pragma unroll
            for (int e = 0; e < 8; ++e) if (e != i1 && el[e] > p2) { p2 = el[e]; i2 = e; }
            const float inv = gw_ / (p1 + p2);
            const int e1 = gi * 8 + i1, e2 = gi * 8 + i2;
            RE[2 * m] = e1; RE[2 * m + 1] = e2; RG[2 * m] = p1 * inv; RG[2 * m + 1] = p2 * inv;
            __hip_atomic_fetch_add(&hist[e1], 1, __ATOMIC_RELAXED, __HIP_MEMORY_SCOPE_WORKGROUP); __hip_atomic_fetch_add(&hist[e2], 1, __ATOMIC_RELAXED, __HIP_MEMORY_SCOPE_WORKGROUP);
        }
        { bf16* xo = XN + (size_t)row * D + 8 * q;
#pragma unroll
          for (int s = 0; s < 32; ++s) { const int col = 32 * s + 8 * q; const u32x4 w = xa[s];
              const f32x4 g0 = *(const LAS f32x4*)(lds + GS_OFF + 4 * col), g1 = *(const LAS f32x4*)(lds + GS_OFF + 4 * col + 16), h0 = *(const LAS f32x4*)(lds + SH_OFF + 4 * col), h1 = *(const LAS f32x4*)(lds + SH_OFF + 4 * col + 16);
              const f32x4 y0 = (f32x4){bflo(w.x), bfhi(w.x), bflo(w.y), bfhi(w.y)} * rstd * g0 + h0, y1 = (f32x4){bflo(w.z), bfhi(w.z), bflo(w.w), bfhi(w.w)} * rstd * g1 + h1;
              u32x4 o; o.x = pg8::cvt_pk_bf16(y0.x, y0.y); o.y = pg8::cvt_pk_bf16(y0.z, y0.w); o.z = pg8::cvt_pk_bf16(y1.x, y1.y); o.w = pg8::cvt_pk_bf16(y1.z, y1.w);
              *(u32x4*)(xo + 32 * s) = o; __builtin_amdgcn_sched_barrier(0); } }
        __syncthreads();
        if (tid < 32) BCNT[chunk * 32 + tid] = hist[tid];
        __syncthreads();
    }
}
__device__ __forceinline__ void phase_dispatch(KP p, LAS unsigned char* lds, int wv) {
    WAVE_IDS();
    const int* BCNT = (const int*)(p->ws + OFF_BCNT); const int* RE = (const int*)(p->ws + OFF_RE); int* RD = (int*)(p->ws + OFF_RD);
    int* tokidx = (int*)(p->ws + OFF_LSE);
    LAS int* part = (LAS int*)lds;
    LAS int* tot = (LAS int*)(lds + 4096);
    LAS int* earr = (LAS int*)(lds + 8192);
    LAS int* darr = (LAS int*)(lds + 8192 + 1024);
    LAS int* misc = (LAS int*)(lds + MISC_OFF);
    for (int chunk = blockIdx.x; chunk < T / 128; chunk += gridDim.x) {
        { const int e = tid & 31, pt = tid >> 5; int s = 0, sb = 0;
          for (int c = pt * 16; c < pt * 16 + 16; ++c) { const int v = BCNT[c * 32 + e]; s += v; if (c < chunk) sb += v; }
          part[pt * 32 + e] = s; part[512 + pt * 32 + e] = sb; }
        if (tid < 256) earr[tid] = RE[chunk * 256 + tid];
        __syncthreads();
        if (tid < 32) { int s = 0, sb = 0;
            for (int pt = 0; pt < 16; ++pt) { s += part[pt * 32 + tid]; sb += part[512 + pt * 32 + tid]; }
            tot[tid] = s; tot[32 + tid] = sb; }
        __syncthreads();
        if (tid < 32) { int base = 0; for (int e = 0; e < tid; ++e) base += (tot[e] + 255) & ~255; tot[64 + tid] = base; }
        __syncthreads();
        if (tid == 256) { int nt = 0; for (int e = 0; e < 32; ++e)     { const int k = (tot[e] + 255) >> 8; for (int i = 0; i < k; ++i) misc[16 + nt + i] = e; nt += k; } misc[0] = nt; }
        if (tid < 256) { const int e = earr[tid]; int rank = 0; for (int a = 0; a < tid; ++a) rank += (earr[a] == e) ? 1 : 0;
            const int dest = tot[64 + e] + tot[32 + e] + rank; darr[tid] = dest; RD[chunk * 256 + tid] = dest; }
        __syncthreads();
        if (tid < 256) tokidx[darr[tid]] = chunk * 256 + tid;
        __syncthreads();
    }
}
template <int NJ> struct MoeOrder {
    const LAS int* misc; int G, c;
    __device__ __forceinline__ bool next(int i, pg8::Unit& u) const {
        const int L = i * G + c; const int nt = misc[0];
        if (L >= nt * NJ) return false;
        const int tile = L / NJ, j = L - tile * NJ; u.pm = tile; u.pn = misc[16 + tile] * NJ + j; return true;
    }
    __device__ __forceinline__ void a_ready(const pg8::Unit&) const {}
    __device__ __forceinline__ void done(const pg8::Unit&) const {}
};
__device__ __forceinline__ void phase_combine(KP p, int l, bool next_norm, int wv) {
    WAVE_IDS();
    const float* mod = (const float*)(p->ws + OFF_MOD) + (size_t)l * NB * 6144;
    const float* modn = (const float*)(p->ws + OFF_MOD) + (size_t)(l + 1) * NB * 6144;
    const int* RD = (const int*)(p->ws + OFF_RD); const float* RG = (const float*)(p->ws + OFF_RG);
    const bf16* Y = (const bf16*)(p->ws + WS_QKV); bf16* XN = (bf16*)(p->ws + WS_XN);
    for (int m0 = gw; m0 < T; m0 += 2 * NGW) {
        int dd[2][2]; float gg[2][2];
#pragma unroll
        for (int q = 0; q < 2; ++q) { const int m = m0 + q * NGW; dd[q][0] = 2 * m; dd[q][1] = 2 * m + 1;
            gg[q][0] = RG[2 * m]; gg[q][1] = RG[2 * m + 1];
        }
        f32x4 xv[2][4]; u32x2 y0[2][4], y1[2][4];
#pragma unroll
        for (int q = 0; q < 2; ++q) { const int m = m0 + q * NGW; const bf16* xrow = (const bf16*)(p->ws + WS_CLAT) + (size_t)m * D;
#pragma unroll
            for (int j = 0; j < 4; ++j) { const int cidx = 4 * lane + 256 * j; { const u32x2 w = *(const u32x2*)(xrow + cidx); xv[q][j] = (f32x4){bflo(w.x), bfhi(w.x), bflo(w.y), bfhi(w.y)}; }
                y0[q][j] = *(const u32x2*)(Y + (size_t)dd[q][0] * D + cidx); y1[q][j] = *(const u32x2*)(Y + (size_t)dd[q][1] * D + cidx); } }
        f32x4 gtv[2][4], gnv[4], s1v[2][4], s0v[2][4];
#pragma unroll
        for (int q = 0; q < 2; ++q) { const int b = (m0 + q * NGW) >> 11;
#pragma unroll
            for (int j = 0; j < 4; ++j) { const int cidx = 4 * lane + 256 * j; gtv[q][j] = *(const f32x4*)(mod + b * 6144 + 5120 + cidx);
                if (next_norm) { s1v[q][j] = *(const f32x4*)(modn + b * 6144 + 1024 + cidx); s0v[q][j] = *(const f32x4*)(modn + b * 6144 + cidx); if (q == 0) gnv[j] = *(const f32x4*)(p->g_norm1 + (l + 1) * D + cidx); } } }
#pragma unroll
        for (int q = 0; q < 2; ++q) { const int m = m0 + q * NGW; float* xrow = p->out + (size_t)m * D; bf16* xrow16 = (bf16*)p->out + (size_t)m * D; const float g0 = gg[q][0], g1 = gg[q][1]; f32x4 v[4]; float ss = 0.f;
#pragma unroll
            for (int j = 0; j < 4; ++j) { const int cidx = 4 * lane + 256 * j; const f32x4 gt = gtv[q][j];
                f32x4 yy; yy.x = g0 * bflo(y0[q][j].x) + g1 * bflo(y1[q][j].x); yy.y = g0 * bfhi(y0[q][j].x) + g1 * bfhi(y1[q][j].x); yy.z = g0 * bflo(y0[q][j].y) + g1 * bflo(y1[q][j].y); yy.w = g0 * bfhi(y0[q][j].y) + g1 * bfhi(y1[q][j].y);
                v[j] = xv[q][j] + gt * yy;
                if (next_norm) { u32x2 o; o.x = pk2(v[j].x, v[j].y); o.y = pk2(v[j].z, v[j].w); *(u32x2*)(xrow16 + cidx) = o; }
                else *(f32x4*)(xrow + cidx) = v[j];
                ss += (v[j].x * v[j].x + v[j].y * v[j].y) + (v[j].z * v[j].z + v[j].w * v[j].w); }
            if (next_norm) { const float rstd = __builtin_amdgcn_rsqf(wave_sum(ss, lane) * (1.0f / D) + EPS);
#pragma unroll
                for (int j = 0; j < 4; ++j) { const int cidx = 4 * lane + 256 * j;
                    const f32x4 y = v[j] * rstd * gnv[j] * (s1v[q][j] + 1.0f) + s0v[q][j]; u32x2 o; o.x = pk2(y.x, y.y); o.y = pk2(y.z, y.w); *(u32x2*)(XN + (size_t)m * D + cidx) = o; } } }
    }
}

#ifndef ALIGN_SMALLK
#define ALIGN_SMALLK true
#endif
template <int l> __device__ __forceinline__ void layer_body(LAS unsigned char* lds, const XcdBarrier& xbar, int wv) {
    const int G = gridDim.x, bx = blockIdx.x;
    unsigned char* ws = kparams()->ws;
    bf16* XN = (bf16*)(ws + WS_XN); bf16* CLAT = (bf16*)(ws + WS_CLAT); bf16* QKV = (bf16*)(ws + WS_QKV); bf16* QM = (bf16*)(ws + WS_QM); bf16* KVM = (bf16*)(ws + WS_KVM);
    const float* modall = (const float*)(ws + OFF_MOD);
    const bf16* Win_t = (const bf16*)(ws + WS_WIN);
    {
        const float* xin = l == 0 ? kparams()->x : kparams()->out;
        { pg8::Gemm g{XN, Win_t, 1024, 1024, 1024, wv}; pg8::StaticOrder S; S.init(T, 4096, G, bx);
          KP p = kparams();
          pg8::EpiProj E{QKV, CLAT, (float*)(ws + OFF_LSE), p->pos, p->g_q_dil + l * 64, p->g_k_dil + l * 64, p->g_q_win + l * 64, p->g_k_win + l * 64, p->g_k_mla + l * 96 + 64, SC_HD};
          pg8::gemm_phase<pg8::EpiProj, pg8::StaticOrder, true, true>(lds, g, S, E); }
        xcd_barrier(xbar);
        { pg8::Gemm g{CLAT, (const bf16*)(ws + WS_WUQ), 1024, 512, 512, wv}; pg8::StaticOrder S; S.init(T, 768, G, bx);
          KP p = kparams();
          pg8::EpiQ E{QM, (const float*)(ws + OFF_LSE), p->pos, p->g_q_mla + l * 96, SC_MLA};
          pg8::gemm_phase<pg8::EpiQ, pg8::StaticOrder, ALIGN_SMALLK, true>(lds, g, S, E); }
        { pg8::Gemm g{CLAT + 512, (const bf16*)(ws + WS_WUKV), 1024, 256, 256, wv}; pg8::StaticOrder S; S.init(T, 1024, G, bx);
          KP p = kparams();
          pg8::EpiKV E{KVM, (const float*)(ws + OFF_LSE), p->g_k_mla + l * 96};
          pg8::gemm_phase<pg8::EpiKV, pg8::StaticOrder, ALIGN_SMALLK, true>(lds, g, S, E); }
        xcd_barrier(xbar);
        phase_attn_mla(kparams(), l, lds, wv);
        if (conv_group() == 4) { phase_convert(kparams(), l, lds, wv, true); __syncthreads(); }
        phase_attn_win(kparams(), l, lds, wv);
        if (conv_group() == 5) { phase_convert(kparams(), l, lds, wv, true); }
        xcd_barrier(xbar);
        phase_dil_combine(kparams(), wv);
        xcd_barrier(xbar);
        { unsigned char* G8 = ws + WS_KVM; bf16* MERGED = QKV + 1024;
          pg8::GemmM g{XN, Win_t + (size_t)4096 * 1024, CLAT, CLAT + 512, QKV + 2304, (const bf16*)(ws + WS_WBM), (const bf16*)(ws + WS_WBD), (const bf16*)(ws + WS_WBW), 1024, 1024, 3072, 512, 256, 512, wv};
          pg8::MultiOrder<6> S; S.S.init(T, 1024, G, bx); pg8::EpiGateBranch E{G8, MERGED, 3072};
          pg8::gemm_phase_multi<pg8::EpiGateBranch, pg8::MultiOrder<6>, true, true>(lds, g, S, E); }
        xcd_barrier(xbar);
        { pg8::Gemm g{QKV + 1024, (const bf16*)(ws + WS_WOUT), 3072, 1024, 1024, wv}; pg8::StaticOrder S; S.init(T, 1024, G, bx);
          pg8::EpiResidual<l == 0> E{kparams()->x, (const bf16*)kparams()->out, CLAT, modall + (size_t)l * NB * 6144 + 2048};
          pg8::gemm_phase<pg8::EpiResidual<l == 0>, pg8::StaticOrder, true, true>(lds, g, S, E); }
        xcd_barrier(xbar);
        phase_norm2_route(kparams(), l, lds, wv);
        xcd_barrier(xbar);
        phase_dispatch(kparams(), lds, wv);
        xcd_barrier(xbar);
        { pg8::Gemm g{XN, (const bf16*)(ws + WS_W13), 1024, 1024, 1024, wv}; MoeOrder<3> S{(const LAS int*)(lds + MISC_OFF), G, (G % 8 == 0) ? (bx % 8) * (G / 8) + bx / 8 : bx};
          pg8::EpiSwiGLU E{KVM};
          pg8::gemm_phase_gather<pg8::EpiSwiGLU, MoeOrder<3>, true, true>(lds, g, (const int*)(ws + OFF_LSE), S, E); }
        xcd_barrier(xbar);
        { pg8::Gemm g{KVM, (const bf16*)(ws + WS_W2), 384, 384, 384, wv}; MoeOrder<4> S{(const LAS int*)(lds + MISC_OFF), G, (G % 8 == 0) ? (bx % 8) * (G / 8) + bx / 8 : bx};
          pg8::EpiScatterY E{QKV, (const int*)(ws + OFF_LSE)};
          pg8::gemm_phase<pg8::EpiScatterY, MoeOrder<4>, true, true>(lds, g, S, E); }
        xcd_barrier(xbar);
        phase_combine(kparams(), l, l == 0, wv);
        if (l == 0) phase_convert(kparams(), 1, lds, wv, false);
        xcd_barrier(xbar);
    }
}

__global__ void __launch_bounds__(NT, 2) mega_fwd(Params p_unused) {
    extern __shared__ __attribute__((aligned(16))) unsigned char lds_raw[];
    LAS unsigned char* lds = (LAS unsigned char*)lds_raw;
    cg::grid_group grid = cg::this_grid();
    const int wv = __builtin_amdgcn_readfirstlane(threadIdx.x >> 6);
    { volatile LAS unsigned* st = (volatile LAS unsigned*)(lds + MISC_OFF + 12288); const int t0_ = otid(wv); if (t0_ < 4) st[t0_] = 0u; }
    __syncthreads();
    const XcdBarrier xbar = xcd_barrier_post((unsigned*)kparams()->ws, (volatile LAS unsigned*)(lds + MISC_OFF + 12288), wv);

    phase_mod(kparams(), lds, wv);
    if ((int)gridDim.x >= 224) { if ((int)blockIdx.x >= 192) phase_convert(kparams(), 0, lds, wv, false, ((int)blockIdx.x - 192) * NW + wv, ((int)gridDim.x - 192) * NW); }
    else phase_convert(kparams(), 0, lds, wv, false);
    if (gridDim.x == 0x7fffff) grid.sync();
    xcd_barrier(xbar);
    phase_norm1(kparams(), 0, kparams()->x, wv);
    xcd_barrier(xbar);
    layer_body<0>(lds, xbar, wv);
    layer_body<1>(lds, xbar, wv);
}

extern "C" void kernel_launch(void* const* d_in, const int* in_sizes, int n_in, void* d_out, int out_size, void* d_ws, size_t ws_size, hipStream_t stream) {
    static int grid = 0;
    if (grid == 0) {
        int dev = 0, cus = 0, per_cu = 0;
        (void)hipGetDevice(&dev);
        (void)hipDeviceGetAttribute(&cus, hipDeviceAttributeMultiprocessorCount, dev);
        (void)hipFuncSetAttribute((const void*)mega_fwd, hipFuncAttributeMaxDynamicSharedMemorySize, LDS_BYTES);
        (void)hipOccupancyMaxActiveBlocksPerMultiprocessor(&per_cu, (const void*)mega_fwd, NT, LDS_BYTES);
        grid = cus;
        if (per_cu < 1 || n_in != 30 || out_size != T * D || ws_size < WS_END) { fprintf(stderr, "kernel_launch: per_cu %d n_in %d out %d ws %zu (need %zu)\n", per_cu, n_in, out_size, ws_size, (size_t)WS_END); }
        if (ws_size < WS_END) grid = -1;
    }
    if (grid < 0) return;
    Params hp{};
    const float** fp = (const float**)&hp;
    for (int i = 0; i < 30; ++i) fp[i] = (const float*)d_in[i];
    hp.out = (float*)d_out; hp.ws = (unsigned char*)d_ws;
    (void)hipMemsetAsync(d_ws, 0, 16384, stream);
    void* args[] = {&hp};
    hipError_t e = hipLaunchCooperativeKernel((const void*)mega_fwd, dim3(grid), dim3(NT), args, LDS_BYTES, stream);
    if (e != hipSuccess) fprintf(stderr, "cooperative launch failed: %s (grid %d)\n", hipGetErrorString(e), grid);
}
```
